# Optimizing an MI355X kernel written in HIP

```python
import math
import jax, jax.numpy as jnp
from jax import lax
import numpy as np

D_MODEL = 1024
BATCH = 8
SEQ = 4096
DEPTH = 1

RW_HEADS = 8
RW_HEAD_DIM = 64
RW_DIM = RW_HEADS * RW_HEAD_DIM
RW_DECAY_LORA = 64
RW_A_LORA = 64
RW_GATE_LORA = 128
RW_SIZES = (RW_DIM, RW_DIM, RW_DIM, RW_DECAY_LORA, RW_A_LORA, RW_GATE_LORA)
RW_COLS = 3 * RW_DIM + RW_DECAY_LORA + RW_A_LORA + RW_GATE_LORA
RW_GN_EPS = 64e-5

DSA_HEADS = 8
DSA_LATENT = 128
DSA_Q_DIM = DSA_HEADS * DSA_LATENT
IDX_HEADS = 4
IDX_DIM = 64
TOPK_MAX = 256
Q_BLOCK = 128

REL_BUCKETS = 32
REL_MAX_DIST = 128

IN_SIZES = (RW_COLS, DSA_Q_DIM, DSA_LATENT, IDX_HEADS * IDX_DIM, IDX_DIM, IDX_HEADS, D_MODEL, D_MODEL)
IN_COLS = RW_COLS + DSA_Q_DIM + DSA_LATENT + IDX_HEADS * IDX_DIM + IDX_DIM + IDX_HEADS + 2 * D_MODEL

PEER_HEADS = 8
PEER_N_KEYS = 128
PEER_N_EXPERTS = PEER_N_KEYS * PEER_N_KEYS
PEER_KEY_DIM = 128
PEER_HALF = PEER_KEY_DIM // 2
PEER_TOPK = 16
PEER_CHUNK = 128

LN_EPS = 1e-5
DEEPNORM_ALPHA = (2.0 * DEPTH) ** 0.25
DEEPNORM_BETA = (8.0 * DEPTH) ** -0.25

kernel_name = "rwkv7_dsa_peer_hybrid_block"


def _split_points(sizes):
    return np.cumsum(sizes)[:-1].tolist()


def _layer_norm(x, g, b):
    xf = x.astype(jnp.float32)
    mu = jnp.mean(xf, -1, keepdims=True)
    var = jnp.mean(jnp.square(xf - mu), -1, keepdims=True)
    return ((xf - mu) * lax.rsqrt(var + LN_EPS)).astype(x.dtype) * g + b


def _rms_norm(x, g):
    xf = x.astype(jnp.float32)
    ms = jnp.mean(jnp.square(xf), -1, keepdims=True)
    return (xf * lax.rsqrt(ms + LN_EPS)).astype(x.dtype) * g


def _heads(t, n_heads):
    return t.reshape(*t.shape[:-1], n_heads, t.shape[-1] // n_heads)


def _token_shift(z):
    return jnp.pad(z, ((0, 0), (1, 0), (0, 0)))[:, :-1]


def _t5_bucket(n):
    n = jnp.maximum(n, 0)
    max_exact = REL_BUCKETS // 2
    nf = jnp.maximum(n, 1).astype(jnp.float32)
    large = max_exact + (jnp.log(nf / max_exact) / math.log(REL_MAX_DIST / max_exact)
                         * (REL_BUCKETS - max_exact)).astype(jnp.int32)
    large = jnp.minimum(large, REL_BUCKETS - 1)
    return jnp.where(n < max_exact, n, large)


def _rwkv7_time_mix(z_rw, mu, w0, w2, a0, a2, g2, k_k, k_a, r_k, gn_g, gn_b):
    B, S, _ = z_rw.shape
    zs = z_rw + (_token_shift(z_rw) - z_rw) * mu
    r, k, v, wl, al, gl = jnp.split(zs, _split_points(RW_SIZES), axis=-1)
    log_w = -jax.nn.softplus(-(w0 + jnp.tanh(wl) @ w2)) - 0.5
    decay = jnp.exp(-jnp.exp(log_w))
    a = jax.nn.sigmoid(a0 + al @ a2)
    g = jax.nn.sigmoid(gl) @ g2
    kk = _heads(k * k_k, RW_HEADS)
    kk = kk * lax.rsqrt(jnp.maximum(jnp.sum(kk * kk, -1, keepdims=True), 1e-24))
    k = k * (1 + (a - 1) * k_a)
    rh, kh, vh, dh, ah = [_heads(t, RW_HEADS) for t in (r, k, v, decay, a)]
    a_vec = -kk
    b_vec = kk * ah

    def step(state, inp):
        r_t, w_t, k_t, v_t, a_t, b_t = inp
        sa = jnp.einsum('bhvk,bhk->bhv', state, a_t)
        state = (state * w_t[:, :, None, :] + sa[..., None] * b_t[:, :, None, :]
                 + v_t[..., None] * k_t[:, :, None, :])
        return state, jnp.einsum('bhvk,bhk->bhv', state, r_t)

    seq = tuple(jnp.moveaxis(t.astype(jnp.float32), 1, 0) for t in (rh, dh, kh, vh, a_vec, b_vec))
    state0 = jnp.zeros((B, RW_HEADS, RW_HEAD_DIM, RW_HEAD_DIM), jnp.float32)
    _, y = lax.scan(step, state0, seq)
    y = jnp.moveaxis(y, 0, 1)
    mean = jnp.mean(y, -1, keepdims=True)
    var = jnp.mean(jnp.square(y - mean), -1, keepdims=True)
    y = ((y - mean) * lax.rsqrt(var + RW_GN_EPS)).reshape(B, S, RW_DIM).astype(z_rw.dtype) * gn_g + gn_b
    bonus = (jnp.sum(rh * kh * r_k, -1, keepdims=True) * vh).reshape(B, S, RW_DIM)
    return (y + bonus) * g


def _dsa_attention(z_q, z_kv, z_qi, z_ki, z_wi, kv_g, idx_k_g, idx_k_b, rel_bias):
    B, S, _ = z_q.shape
    c_kv = _rms_norm(z_kv, kv_g)
    k_idx = _layer_norm(z_ki, idx_k_g, idx_k_b)
    q = _heads(z_q, DSA_HEADS)
    q_idx = _heads(z_qi, IDX_HEADS)
    w_idx = z_wi * (IDX_HEADS ** -0.5)
    topk = min(TOPK_MAX, S // 4)
    nb = S // Q_BLOCK

    def blockify(t):
        return jnp.swapaxes(t.reshape(B, nb, Q_BLOCK, *t.shape[2:]), 0, 1)

    q_pos = jnp.arange(S, dtype=jnp.int32).reshape(nb, Q_BLOCK)
    key_pos = jnp.arange(S, dtype=jnp.int32)

    def one_block(args):
        qb, qib, wb, tpos = args
        dots = jnp.einsum('bqhd,bsd->bqhs', qib, k_idx) * (IDX_DIM ** -0.5)
        score = jnp.einsum('bqh,bqhs->bqs', wb, jax.nn.relu(dots))
        causal = key_pos[None, :] <= tpos[:, None]
        score = jnp.where(causal[None], score, -jnp.inf)
        _, sel = lax.top_k(score, topk)
        valid = sel <= tpos[None, :, None]
        kv_sel = jax.vmap(lambda cb, ib: cb[ib])(c_kv, sel)
        logits = jnp.einsum('bqhd,bqkd->bqhk', qb, kv_sel) * (DSA_LATENT ** -0.5)
        bias = rel_bias[_t5_bucket(tpos[None, :, None] - sel)]
        logits = logits + jnp.transpose(bias, (0, 1, 3, 2))
        logits = jnp.where(valid[:, :, None, :], logits, -jnp.inf)
        p = jax.nn.softmax(logits.astype(jnp.float32), axis=-1).astype(kv_sel.dtype)
        return jnp.einsum('bqhk,bqkd->bqhd', p, kv_sel)

    out = lax.map(one_block, (blockify(q), blockify(q_idx), blockify(w_idx), q_pos))
    return jnp.swapaxes(out, 0, 1).reshape(B, S, DSA_Q_DIM)


def _peer(h, w_pq, sub_keys, u_tab, v_tab):
    B, S, D = h.shape
    T = B * S
    ht = h.reshape(T, D)
    q = (ht @ w_pq).reshape(T, PEER_HEADS, 2, PEER_HALF)
    s = jnp.einsum('thcd,hcnd->thcn', q, sub_keys)
    s1, i1 = lax.top_k(s[:, :, 0], PEER_TOPK)
    s2, i2 = lax.top_k(s[:, :, 1], PEER_TOPK)
    cand = (s1[..., :, None] + s2[..., None, :]).reshape(T, PEER_HEADS, PEER_TOPK * PEER_TOPK)
    cand_idx = (i1[..., :, None] * PEER_N_KEYS + i2[..., None, :]).reshape(T, PEER_HEADS, PEER_TOPK * PEER_TOPK)
    top_s, pos = lax.top_k(cand, PEER_TOPK)
    experts = jnp.take_along_axis(cand_idx, pos, axis=-1)
    gates = jax.nn.softmax(top_s.astype(jnp.float32), axis=-1).astype(h.dtype)
    n_chunks = T // PEER_CHUNK

    def chunk(args):
        hc, ec, gc = args
        act = jax.nn.gelu(jnp.einsum('cd,chkd->chk', hc, u_tab[ec]), approximate=False) * gc
        return jnp.einsum('chk,chkd->cd', act, v_tab[ec])

    out = lax.map(chunk, (ht.reshape(n_chunks, PEER_CHUNK, D),
                          experts.reshape(n_chunks, PEER_CHUNK, PEER_HEADS, PEER_TOPK),
                          gates.reshape(n_chunks, PEER_CHUNK, PEER_HEADS, PEER_TOPK)))
    return out.reshape(B, S, D)


def setup_inputs(seed: int = 0) -> dict:
    key = jax.random.key(seed)
    ks = iter(jax.random.split(key, 40))
    L, D = DEPTH, D_MODEL

    def nrm(shape, std):
        return jax.random.normal(next(ks), shape, jnp.float32) * std

    def unif(shape, lo, hi):
        return jax.random.uniform(next(ks), shape, jnp.float32, lo, hi)

    col_scale = jnp.concatenate([jnp.ones((2 * RW_DIM,), jnp.float32),
                                 jnp.full((RW_DIM,), DEEPNORM_BETA, jnp.float32),
                                 jnp.ones((IN_COLS - 3 * RW_DIM,), jnp.float32)])
    return {
        "x": nrm((BATCH, SEQ, D), 1.0),
        "c": nrm((BATCH, D), 1.0),
        "w_ada": nrm((L, D, 6 * D), D ** -0.5),
        "b_ada": nrm((L, 6 * D), 0.02),
        "w_in": nrm((L, D, IN_COLS), D ** -0.5) * col_scale,
        "rw_mu": unif((L, RW_COLS), 0.0, 1.0),
        "rw_w0": unif((L, RW_DIM), -4.0, 0.0),
        "rw_w2": nrm((L, RW_DECAY_LORA, RW_DIM), 0.5 * RW_DECAY_LORA ** -0.5),
        "rw_a0": nrm((L, RW_DIM), 0.1),
        "rw_a2": nrm((L, RW_A_LORA, RW_DIM), 0.5 * RW_A_LORA ** -0.5),
        "rw_g2": nrm((L, RW_GATE_LORA, RW_DIM), RW_GATE_LORA ** -0.5),
        "rw_k_k": 0.85 + nrm((L, RW_DIM), 0.05),
        "rw_k_a": 1.0 + nrm((L, RW_DIM), 0.05),
        "rw_r_k": nrm((L, RW_HEADS, RW_HEAD_DIM), 0.1),
        "rw_gn_g": 1.0 + nrm((L, RW_DIM), 0.02),
        "rw_gn_b": nrm((L, RW_DIM), 0.02),
        "dsa_kv_g": 1.0 + nrm((L, DSA_LATENT), 0.02),
        "idx_k_g": 1.0 + nrm((L, IDX_DIM), 0.02),
        "idx_k_b": nrm((L, IDX_DIM), 0.02),
        "rel_bias": nrm((REL_BUCKETS, DSA_HEADS), 0.5),
        "w_br_a": nrm((L, RW_DIM, D), DEEPNORM_BETA * RW_DIM ** -0.5),
        "w_br_b": nrm((L, DSA_Q_DIM, D), DEEPNORM_BETA * DSA_Q_DIM ** -0.5),
        "w_out": nrm((L, D, D), DEEPNORM_BETA * D ** -0.5),
        "ln1_g": 1.0 + nrm((L, D), 0.02),
        "ln1_b": nrm((L, D), 0.02),
        "peer_wq": nrm((L, D, PEER_HEADS * PEER_KEY_DIM), D ** -0.5),
        "peer_keys": nrm((L, PEER_HEADS, 2, PEER_N_KEYS, PEER_HALF), PEER_HALF ** -0.5),
        "peer_u": nrm((L, PEER_N_EXPERTS, D), D ** -0.5),
        "peer_v": nrm((L, PEER_N_EXPERTS, D), DEEPNORM_BETA * PEER_HEADS ** -0.5),
        "ln2_g": 1.0 + nrm((L, D), 0.02),
        "ln2_b": nrm((L, D), 0.02),
    }


def reference(x, c, w_ada, b_ada, w_in, rw_mu, rw_w0, rw_w2, rw_a0, rw_a2, rw_g2, rw_k_k, rw_k_a,
              rw_r_k, rw_gn_g, rw_gn_b, dsa_kv_g, idx_k_g, idx_k_b, rel_bias, w_br_a, w_br_b, w_out,
              ln1_g, ln1_b, peer_wq, peer_keys, peer_u, peer_v, ln2_g, ln2_b):
    for l in range(DEPTH):
        mod = jax.nn.silu(c) @ w_ada[l] + b_ada[l]
        sh1, sc1, gt1, sh2, sc2, gt2 = jnp.split(mod, 6, axis=-1)

        h = x * (1 + sc1[:, None]) + sh1[:, None]
        z = h @ w_in[l]
        z_rw, z_q, z_kv, z_qi, z_ki, z_wi, z_ga, z_gb = jnp.split(z, _split_points(IN_SIZES), axis=-1)
        y_a = _rwkv7_time_mix(z_rw, rw_mu[l], rw_w0[l], rw_w2[l], rw_a0[l], rw_a2[l], rw_g2[l],
                              rw_k_k[l], rw_k_a[l], rw_r_k[l], rw_gn_g[l], rw_gn_b[l]) @ w_br_a[l]
        y_b = _dsa_attention(z_q, z_kv, z_qi, z_ki, z_wi, dsa_kv_g[l], idx_k_g[l], idx_k_b[l],
                             rel_bias) @ w_br_b[l]
        merged = jax.nn.sigmoid(z_ga) * y_a + jax.nn.sigmoid(z_gb) * y_b
        mix = merged @ w_out[l]
        x = _layer_norm(DEEPNORM_ALPHA * x + gt1[:, None] * mix, ln1_g[l], ln1_b[l])

        h2 = x * (1 + sc2[:, None]) + sh2[:, None]
        y2 = _peer(h2, peer_wq[l], peer_keys[l], peer_u[l], peer_v[l])
        x = _layer_norm(DEEPNORM_ALPHA * x + gt2[:, None] * y2, ln2_g[l], ln2_b[l])
    return x
```

```cpp
#include <hip/hip_runtime.h>
#include <hip/hip_cooperative_groups.h>
#include <cstdio>
#include <cstdint>
namespace cg = cooperative_groups;

#ifndef MK_SINGLE
#define MK_SINGLE 0
#endif

#define LAS __attribute__((address_space(3)))
typedef unsigned short bf16_t;
typedef short bf16x8 __attribute__((ext_vector_type(8)));
typedef float f32x4 __attribute__((ext_vector_type(4)));
typedef float f32x2 __attribute__((ext_vector_type(2)));
typedef unsigned u32x4 __attribute__((ext_vector_type(4)));
typedef unsigned u32x2 __attribute__((ext_vector_type(2)));

constexpr int D = 1024, NB = 8, S = 4096, T = NB * S;
constexpr int RW_H = 8, RW_N = 64, RW_DIM = 512;
constexpr int IN_COLS = 5316, NPAD = 5376;
constexpr int TOPK = 256;
constexpr int PEER_E = 16384;
constexpr float LN_EPS = 1e-5f;
constexpr float DN_ALPHA = 1.189207115002721f;
constexpr float RW_GN_EPS = 64e-5f;
constexpr int NTHR = 512, NWAVE = 8;
constexpr int LDS_BYTES = 147456;

constexpr size_t MiB = 1u << 20;
constexpr size_t WS_MODP = 1 * MiB;
constexpr size_t WS_MOD = 4 * MiB;
constexpr size_t WS_WIN = 5 * MiB;
constexpr size_t WS_WA = 16 * MiB;
constexpr size_t WS_WB = 17 * MiB;
constexpr size_t WS_WO = 19 * MiB;
constexpr size_t WS_WPQ = 21 * MiB;
constexpr size_t WS_W2T = 23 * MiB;
constexpr size_t WS_A2T = WS_W2T + 65536;
constexpr size_t WS_G2T = WS_A2T + 65536;
constexpr size_t WS_KEYS = WS_G2T + 131072;
constexpr size_t WS_UT = 24 * MiB;
constexpr size_t WS_VT = 56 * MiB;
constexpr size_t WS_ZRKV = 88 * MiB;
constexpr size_t WS_ZLORA = 184 * MiB;
constexpr size_t WS_ZQ = 200 * MiB;
constexpr size_t WS_GA = 264 * MiB;
constexpr size_t WS_GB = 328 * MiB;
constexpr size_t WS_CKV = 392 * MiB;
constexpr size_t WS_KIDX = 400 * MiB;
constexpr size_t WS_WIDX = 404 * MiB;
constexpr size_t WS_QIDX = 405 * MiB;
constexpr size_t WS_H1 = 421 * MiB;
constexpr size_t WS_YA = 421 * MiB;
constexpr size_t WS_SEL = 453 * MiB;
constexpr size_t WS_CNT = 469 * MiB;
constexpr size_t WS_H2 = 88 * MiB;
constexpr size_t WS_PQ = 200 * MiB;
constexpr size_t WS_EIDX = 328 * MiB;
constexpr size_t WS_GATE = 336 * MiB;
constexpr size_t WS_NEED = 485 * MiB;

__device__ __forceinline__ unsigned f2bf(float f) { unsigned u = __float_as_uint(f); return (u + 0x7fffu + ((u >> 16) & 1u)) >> 16; }
__device__ __forceinline__ unsigned pk2(float lo, float hi) { return f2bf(lo) | (f2bf(hi) << 16); }
__device__ __forceinline__ float bf2f(bf16_t b) { return __uint_as_float((unsigned)b << 16); }
__device__ __forceinline__ float bflo(unsigned w) { return __uint_as_float(w << 16); }
__device__ __forceinline__ float bfhi(unsigned w) { return __uint_as_float(w & 0xffff0000u); }
__device__ __forceinline__ float sigmoidf_(float x) { return 1.f / (1.f + __expf(-x)); }
__device__ __forceinline__ float wave_sum(float v) {
#pragma unroll
    for (int o = 1; o < 64; o <<= 1) v += __shfl_xor(v, o);
    return v;
}
template <int CTRL> __device__ __forceinline__ float dppf(float x) {
    return __int_as_float(__builtin_amdgcn_update_dpp(0, __float_as_int(x), CTRL, 0xf, 0xf, true));
}
__device__ __forceinline__ float red8(float x) { x += dppf<0xB1>(x); x += dppf<0x4E>(x); x += dppf<0x141>(x); return x; }
__device__ __forceinline__ float red16_sum(float x) { x += dppf<0xB1>(x); x += dppf<0x4E>(x); x += dppf<0x141>(x); x += dppf<0x140>(x); return x; }
__device__ __forceinline__ float red16_max(float x) { x = fmaxf(x, dppf<0xB1>(x)); x = fmaxf(x, dppf<0x4E>(x)); x = fmaxf(x, dppf<0x141>(x)); x = fmaxf(x, dppf<0x140>(x)); return x; }
__device__ __forceinline__ void st_bf16x4(bf16_t* p, f32x4 v) { u32x2 w; w.x = pk2(v.x, v.y); w.y = pk2(v.z, v.w); *(u32x2*)p = w; }
__device__ __forceinline__ unsigned sortable(float f) { unsigned u = __float_as_uint(f); if (u == 0x80000000u) u = 0u; return (u & 0x80000000u) ? ~u : (u | 0x80000000u); }

struct Params {
    const float *x, *c, *w_ada, *b_ada, *w_in, *rw_mu, *rw_w0, *rw_w2, *rw_a0, *rw_a2, *rw_g2, *rw_k_k, *rw_k_a, *rw_r_k, *rw_gn_g, *rw_gn_b;
    const float *dsa_kv_g, *idx_k_g, *idx_k_b, *rel_bias, *w_br_a, *w_br_b, *w_out, *ln1_g, *ln1_b, *peer_wq, *peer_keys, *peer_u, *peer_v, *ln2_g, *ln2_b;
    float* out; unsigned char* ws;
    int ph_lo, ph_hi;
};

__device__ __forceinline__ int win_src_col(int r) {
    if (r < 2944) return r;
    if (r < 3008) return r + 256;
    if (r < 3012) return r + 256;
    if (r < 3072) return -1;
    if (r < 3328) return r - 128;
    return r - 60;
}
template <bool WIN>
__device__ __forceinline__ void transpose_item(const float* W, int K, int N, bf16_t* WT, LAS float* scr, int item, int lane, int nrows) {
    const int nblk = nrows / 32, kb = item / nblk, nb = item % nblk, k0 = 64 * kb, n0 = 32 * nb;
    const int rr = n0 + (lane & 31);
    const int sc = WIN ? win_src_col(rr) : rr;
#pragma unroll 8
    for (int i = 0; i < 32; ++i) { const int kk = 2 * i + (lane >> 5); scr[kk * 33 + (lane & 31)] = (sc >= 0) ? W[(size_t)(k0 + kk) * N + sc] : 0.f; }
    asm volatile("s_waitcnt lgkmcnt(0)" ::: "memory");
    const int c = lane & 7;
#pragma unroll
    for (int j = 0; j < 4; ++j) { const int n = (lane >> 3) + 8 * j; const LAS float* s = scr + (8 * c) * 33 + n;
        u32x4 o; o.x = pk2(s[0 * 33], s[1 * 33]); o.y = pk2(s[2 * 33], s[3 * 33]); o.z = pk2(s[4 * 33], s[5 * 33]); o.w = pk2(s[6 * 33], s[7 * 33]);
        *(u32x4*)(WT + (size_t)(n0 + n) * K + k0 + 8 * c) = o; }
    asm volatile("s_waitcnt lgkmcnt(0)" ::: "memory");
}

__device__ __forceinline__ void phase_prep(const Params& p, LAS unsigned char* lds, int bid, int nblk) {
    const int tid = threadIdx.x, lane = tid & 63, wid = tid >> 6;
    const int gw = bid * NWAVE + wid, NGW = nblk * NWAVE;
    unsigned char* ws = p.ws;
    LAS float* scr = (LAS float*)(lds + wid * 16384);
    constexpr int I_IN = (D / 64) * (NPAD / 32), I_A = (512 / 64) * (D / 32), I_B = (D / 64) * (D / 32), I_W2 = 1 * (512 / 32), I_G2 = 2 * (512 / 32);
    constexpr int NIT = I_IN + I_A + 3 * I_B + 2 * I_W2 + I_G2;
    for (int it = gw; it < NIT; it += NGW) {
        int r = it;
        if (r < I_IN) { transpose_item<true>(p.w_in, D, IN_COLS, (bf16_t*)(ws + WS_WIN), scr, r, lane, NPAD); continue; } r -= I_IN;
        if (r < I_A) { transpose_item<false>(p.w_br_a, 512, D, (bf16_t*)(ws + WS_WA), scr, r, lane, D); continue; } r -= I_A;
        if (r < I_B) { transpose_item<false>(p.w_br_b, D, D, (bf16_t*)(ws + WS_WB), scr, r, lane, D); continue; } r -= I_B;
        if (r < I_B) { transpose_item<false>(p.w_out, D, D, (bf16_t*)(ws + WS_WO), scr, r, lane, D); continue; } r -= I_B;
        if (r < I_B) { transpose_item<false>(p.peer_wq, D, D, (bf16_t*)(ws + WS_WPQ), scr, r, lane, D); continue; } r -= I_B;
        if (r < I_W2) { transpose_item<false>(p.rw_w2, 64, 512, (bf16_t*)(ws + WS_W2T), scr, r, lane, 512); continue; } r -= I_W2;
        if (r < I_W2) { transpose_item<false>(p.rw_a2, 64, 512, (bf16_t*)(ws + WS_A2T), scr, r, lane, 512); continue; } r -= I_W2;
        transpose_item<false>(p.rw_g2, 128, 512, (bf16_t*)(ws + WS_G2T), scr, r, lane, 512);
    }
    {
        const size_t gt = (size_t)bid * NTHR + tid, GT = (size_t)nblk * NTHR;
        constexpr size_t NU = (size_t)PEER_E * D / 8, NK = (size_t)8 * 2 * 128 * 64 / 8;
        for (size_t i = gt; i < 2 * NU + NK; i += GT) {
            const float* src; bf16_t* dst; size_t j = i;
            if (j < NU) { src = p.peer_u; dst = (bf16_t*)(ws + WS_UT); }
            else if (j < 2 * NU) { j -= NU; src = p.peer_v; dst = (bf16_t*)(ws + WS_VT); }
            else { j -= 2 * NU; src = p.peer_keys; dst = (bf16_t*)(ws + WS_KEYS); }
            const f32x4 a = *(const f32x4*)(src + j * 8), b = *(const f32x4*)(src + j * 8 + 4);
            u32x4 o; o.x = pk2(a.x, a.y); o.y = pk2(a.z, a.w); o.z = pk2(b.x, b.y); o.w = pk2(b.z, b.w);
            *(u32x4*)(dst + j * 8) = o;
        }
    }
    {
        float* modp = (float*)(ws + WS_MODP);
        for (int it = gw; it < 16 * 24; it += NGW) {
            const int kb = it / 24, jb = it % 24;
            f32x4 acc[8];
#pragma unroll
            for (int b = 0; b < 8; ++b) acc[b] = (f32x4){0.f, 0.f, 0.f, 0.f};
            for (int k = kb * 64; k < kb * 64 + 64; ++k) {
                const f32x4 w = *(const f32x4*)(p.w_ada + (size_t)k * 6144 + jb * 256 + 4 * lane);
#pragma unroll
                for (int b = 0; b < 8; ++b) { const float cv = p.c[b * D + k]; const float sv = cv / (1.f + __expf(-cv)); acc[b] += w * sv; }
            }
#pragma unroll
            for (int b = 0; b < 8; ++b) *(f32x4*)(modp + ((size_t)kb * 8 + b) * 6144 + jb * 256 + 4 * lane) = acc[b];
        }
    }
}
__device__ __forceinline__ void phase_modsum(const Params& p, int bid, int nblk) {
    const float* modp = (const float*)(p.ws + WS_MODP); float* mod = (float*)(p.ws + WS_MOD);
    for (int i = bid * NTHR + threadIdx.x; i < 8 * 6144; i += nblk * NTHR) {
        const int b = i / 6144, j = i % 6144; float s = p.b_ada[j];
#pragma unroll
        for (int kb = 0; kb < 16; ++kb) s += modp[((size_t)kb * 8 + b) * 6144 + j];
        mod[i] = s;
    }
}
__device__ __forceinline__ void phase_h1(const Params& p, int bid, int nblk) {
    const int lane = threadIdx.x & 63, wid = threadIdx.x >> 6;
    const float* mod = (const float*)(p.ws + WS_MOD); bf16_t* h1 = (bf16_t*)(p.ws + WS_H1);
    for (int m = bid * NWAVE + wid; m < T; m += nblk * NWAVE) {
        const int b = m / S; const float* sh = mod + b * 6144, *sc = sh + 1024;
#pragma unroll
        for (int j = 0; j < 4; ++j) { const int c0 = 4 * lane + 256 * j;
            const f32x4 xv = *(const f32x4*)(p.x + (size_t)m * D + c0), s1 = *(const f32x4*)(sc + c0), s0 = *(const f32x4*)(sh + c0);
            st_bf16x4(h1 + (size_t)m * D + c0, xv * (1.f + s1) + s0); }
    }
}

struct GemmArgs { const bf16_t* A; const bf16_t* Bt; int M, N, K; };
constexpr int G_BM = 128, G_BN = 256, G_BK = 64, G_CLD = 260;
constexpr int G_ABUF = G_BM * G_BK * 2, G_BBUF = G_BN * G_BK * 2;
template <class Epi>
__device__ __forceinline__ void gemm_phase(LAS unsigned char* lds, const GemmArgs g, const Epi& epi, int bid, int nblk) {
    const int tid = threadIdx.x, lane = tid & 63, wid = tid >> 6, wm = wid >> 2, wn = wid & 3;
    const int tiles_n = g.N / G_BN, ntiles = (g.M / G_BM) * tiles_n, nk = g.K / G_BK;
    const int lr = tid >> 3, lc = tid & 7;
    const unsigned sw_off = (unsigned)(lr * 128 + ((lc ^ (lr & 7)) << 4));
    LAS unsigned char* sA = lds; LAS unsigned char* sB = lds + 2 * G_ABUF;
    LAS float* sC = (LAS float*)lds;
    for (int tile = bid; tile < ntiles; tile += nblk) {
        const int tm = tile / tiles_n, tn = tile % tiles_n, m0 = tm * G_BM, n0 = tn * G_BN;
        const bf16_t* gA = g.A + (size_t)(m0 + lr) * g.K + lc * 8;
        const bf16_t* gB = g.Bt + (size_t)(n0 + lr) * g.K + lc * 8;
        f32x4 acc[4][4];
#pragma unroll
        for (int i = 0; i < 4; ++i)
#pragma unroll
            for (int j = 0; j < 4; ++j) acc[i][j] = (f32x4){0.f, 0.f, 0.f, 0.f};
        u32x4 ra[2], rb[4];
#pragma unroll
        for (int i = 0; i < 2; ++i) ra[i] = *(const u32x4*)(gA + (size_t)i * 64 * g.K);
#pragma unroll
        for (int i = 0; i < 4; ++i) rb[i] = *(const u32x4*)(gB + (size_t)i * 64 * g.K);
#pragma unroll
        for (int i = 0; i < 2; ++i) *(LAS u32x4*)(sA + sw_off + i * 8192) = ra[i];
#pragma unroll
        for (int i = 0; i < 4; ++i) *(LAS u32x4*)(sB + sw_off + i * 8192) = rb[i];
        __syncthreads();
        for (int kt = 0; kt < nk; ++kt) {
            const int cur = kt & 1;
            if (kt + 1 < nk) {
#pragma unroll
                for (int i = 0; i < 2; ++i) ra[i] = *(const u32x4*)(gA + (size_t)i * 64 * g.K + (kt + 1) * G_BK);
#pragma unroll
                for (int i = 0; i < 4; ++i) rb[i] = *(const u32x4*)(gB + (size_t)i * 64 * g.K + (kt + 1) * G_BK);
            }
            LAS unsigned char* cA = sA + cur * G_ABUF; LAS unsigned char* cB = sB + cur * G_BBUF;
#pragma unroll
            for (int ks = 0; ks < 2; ++ks) {
                bf16x8 af[4], bfr[4];
                const unsigned choff = (unsigned)(((ks * 4 + (lane >> 4)) ^ (lane & 7)) << 4);
#pragma unroll
                for (int i = 0; i < 4; ++i) af[i] = *(const LAS bf16x8*)(cA + (wm * 64 + i * 16 + (lane & 15)) * 128 + choff);
#pragma unroll
                for (int j = 0; j < 4; ++j) bfr[j] = *(const LAS bf16x8*)(cB + (wn * 64 + j * 16 + (lane & 15)) * 128 + choff);
#pragma unroll
                for (int i = 0; i < 4; ++i)
#pragma unroll
                    for (int j = 0; j < 4; ++j) acc[i][j] = __builtin_amdgcn_mfma_f32_16x16x32_bf16(af[i], bfr[j], acc[i][j], 0, 0, 0);
            }
            if (kt + 1 < nk) {
                LAS unsigned char* nA = sA + (cur ^ 1) * G_ABUF; LAS unsigned char* nB = sB + (cur ^ 1) * G_BBUF;
#pragma unroll
                for (int i = 0; i < 2; ++i) *(LAS u32x4*)(nA + sw_off + i * 8192) = ra[i];
#pragma unroll
                for (int i = 0; i < 4; ++i) *(LAS u32x4*)(nB + sw_off + i * 8192) = rb[i];
            }
            __syncthreads();
        }
#pragma unroll
        for (int i = 0; i < 4; ++i)
#pragma unroll
            for (int j = 0; j < 4; ++j)
#pragma unroll
                for (int r = 0; r < 4; ++r) sC[(wm * 64 + i * 16 + (lane >> 4) * 4 + r) * G_CLD + wn * 64 + j * 16 + (lane & 15)] = acc[i][j][r];
        __syncthreads();
        for (int r = wid; r < G_BM; r += NWAVE) { const f32x4 v = *(const LAS f32x4*)(sC + r * G_CLD + 4 * lane); epi(m0 + r, tn, lane, v); }
        __syncthreads();
    }
}

struct EpiInproj {
    bf16_t *zrkv, *zlora, *zq, *ckv, *kidx, *qidx, *ga, *gb; float* widx; const float *kv_g, *ik_g, *ik_b;
    __device__ __forceinline__ void operator()(int row, int tn, int lane, f32x4 v) const {
        if (tn < 6) { st_bf16x4(zrkv + (size_t)row * 1536 + tn * 256 + 4 * lane, v); }
        else if (tn == 6) { st_bf16x4(zlora + (size_t)row * 256 + 4 * lane, v); }
        else if (tn < 11) { st_bf16x4(zq + (size_t)row * 1024 + (tn - 7) * 256 + 4 * lane, v * 0.08838834764831845f); }
        else if (tn == 11) {
            float ss = (lane < 32) ? (v.x * v.x + v.y * v.y + v.z * v.z + v.w * v.w) : 0.f;
            ss = wave_sum(ss);
            const float rs = rsqrtf(ss * (1.f / 128.f) + LN_EPS);
            const bool isk = (lane >= 32 && lane < 48);
            float s1 = isk ? (v.x + v.y + v.z + v.w) : 0.f;
            s1 = wave_sum(s1);
            const float mean = s1 * (1.f / 64.f);
            const f32x4 d = v - mean;
            float s2 = isk ? (d.x * d.x + d.y * d.y + d.z * d.z + d.w * d.w) : 0.f;
            s2 = wave_sum(s2);
            const float rstd = rsqrtf(s2 * (1.f / 64.f) + LN_EPS);
            if (lane < 32) { const f32x4 g = *(const f32x4*)(kv_g + 4 * lane); st_bf16x4(ckv + (size_t)row * 128 + 4 * lane, v * rs * g); }
            else if (isk) { const int c = 4 * (lane - 32); const f32x4 g = *(const f32x4*)(ik_g + c), b = *(const f32x4*)(ik_b + c); st_bf16x4(kidx + (size_t)row * 64 + c, d * rstd * g + b); }
            else if (lane == 48) { *(f32x4*)(widx + (size_t)row * 4) = v * (0.5f * 0.125f); }
        }
        else if (tn == 12) { st_bf16x4(qidx + (size_t)row * 256 + 4 * lane, v); }
        else {
            f32x4 s; s.x = sigmoidf_(v.x); s.y = sigmoidf_(v.y); s.z = sigmoidf_(v.z); s.w = sigmoidf_(v.w);
            if (tn < 17) st_bf16x4(ga + (size_t)row * 1024 + (tn - 13) * 256 + 4 * lane, s);
            else st_bf16x4(gb + (size_t)row * 1024 + (tn - 17) * 256 + 4 * lane, s);
        }
    }
};
__device__ __forceinline__ f32x4 ld_bf16x4(const bf16_t* p) { const u32x2 w = *(const u32x2*)p; return (f32x4){bflo(w.x), bfhi(w.x), bflo(w.y), bfhi(w.y)}; }
struct EpiBrA { bf16_t* ga;
    __device__ __forceinline__ void operator()(int row, int tn, int lane, f32x4 v) const { bf16_t* q = ga + (size_t)row * 1024 + tn * 256 + 4 * lane; st_bf16x4(q, ld_bf16x4(q) * v); } };
struct EpiBrB { bf16_t* m1; const bf16_t* gb;
    __device__ __forceinline__ void operator()(int row, int tn, int lane, f32x4 v) const { const size_t o = (size_t)row * 1024 + tn * 256 + 4 * lane; st_bf16x4(m1 + o, ld_bf16x4(m1 + o) + ld_bf16x4(gb + o) * v); } };
struct EpiOut { const float* x; const float* mod; float* out;
    __device__ __forceinline__ void operator()(int row, int tn, int lane, f32x4 v) const { const int c = tn * 256 + 4 * lane; const size_t o = (size_t)row * D + c;
        const f32x4 gt = *(const f32x4*)(mod + (row / S) * 6144 + 2 * 1024 + c); *(f32x4*)(out + o) = *(const f32x4*)(x + o) * DN_ALPHA + gt * v; } };
struct EpiPq { float* pq;
    __device__ __forceinline__ void operator()(int row, int tn, int lane, f32x4 v) const { *(f32x4*)(pq + (size_t)row * D + tn * 256 + 4 * lane) = v; } };

constexpr int RL_R = 0, RL_W = 16384, RL_KP = 32768, RL_KK = 49152, RL_BV = 65536, RL_V = 81920, RL_Y = 98304, RL_SG = 98304, RL_G = 114688, RL_TW = 122880, RL_AL = 131072, RL_RK = 139264;
template <int KD, bool OUT_BF16>
__device__ __forceinline__ void lora_mm(const LAS bf16_t* A, const bf16_t* Bt, LAS unsigned char* dst, int wid, int lane) {
    const int mi = wid >> 1;
#pragma unroll
    for (int nn = 0; nn < 2; ++nn) {
        const int ni = 2 * (wid & 1) + nn;
        f32x4 acc = (f32x4){0.f, 0.f, 0.f, 0.f};
#pragma unroll
        for (int ks = 0; ks < KD / 32; ++ks) {
            const bf16x8 a = *(const LAS bf16x8*)(A + (16 * mi + (lane & 15)) * KD + 32 * ks + 8 * (lane >> 4));
            const bf16x8 b = *(const bf16x8*)(Bt + (size_t)(16 * ni + (lane & 15)) * KD + 32 * ks + 8 * (lane >> 4));
            acc = __builtin_amdgcn_mfma_f32_16x16x32_bf16(a, b, acc, 0, 0, 0);
        }
#pragma unroll
        for (int r = 0; r < 4; ++r) {
            const int row = 16 * mi + (lane >> 4) * 4 + r, col = 16 * ni + (lane & 15);
            if (OUT_BF16) ((LAS bf16_t*)dst)[row * 64 + col] = (bf16_t)f2bf(acc[r]);
            else ((LAS float*)dst)[row * 64 + col] = acc[r];
        }
    }
}
__device__ __forceinline__ f32x4 mix4(f32x4 z, f32x4 zp, f32x4 mu) { return z + (zp - z) * mu; }
__device__ __forceinline__ void ld_bf16x8(const bf16_t* p, f32x4& a, f32x4& b) { const u32x4 w = *(const u32x4*)p; a = (f32x4){bflo(w.x), bfhi(w.x), bflo(w.y), bfhi(w.y)}; b = (f32x4){bflo(w.z), bfhi(w.z), bflo(w.w), bfhi(w.w)}; }

__device__ __forceinline__ void rwkv_unit(const Params& p, LAS unsigned char* lds, int b, int h) {
    const int tid = threadIdx.x, lane = tid & 63, wid = tid >> 6;
    const bf16_t* zrkv = (const bf16_t*)(p.ws + WS_ZRKV); const bf16_t* zlora = (const bf16_t*)(p.ws + WS_ZLORA);
    bf16_t* ya = (bf16_t*)(p.ws + WS_YA);
    const bf16_t* w2t = (const bf16_t*)(p.ws + WS_W2T) + (size_t)h * 64 * 64;
    const bf16_t* a2t = (const bf16_t*)(p.ws + WS_A2T) + (size_t)h * 64 * 64;
    const bf16_t* g2t = (const bf16_t*)(p.ws + WS_G2T) + (size_t)h * 64 * 128;
    LAS float* R = (LAS float*)(lds + RL_R); LAS float* W = (LAS float*)(lds + RL_W); LAS float* KP = (LAS float*)(lds + RL_KP); LAS float* KK = (LAS float*)(lds + RL_KK);
    LAS float* BV = (LAS float*)(lds + RL_BV); LAS float* V = (LAS float*)(lds + RL_V); LAS float* Y = (LAS float*)(lds + RL_Y); LAS float* RK = (LAS float*)(lds + RL_RK);
    LAS bf16_t* SG = (LAS bf16_t*)(lds + RL_SG); LAS bf16_t* G = (LAS bf16_t*)(lds + RL_G); LAS bf16_t* TW = (LAS bf16_t*)(lds + RL_TW); LAS bf16_t* AL = (LAS bf16_t*)(lds + RL_AL);
    const int pt = tid >> 3, pc = (tid & 7) * 8;
    const int hc = h * 64 + pc;
    const int kq = lane & 7, vloc = 8 * wid + (lane >> 3);
    float st[8];
#pragma unroll
    for (int j = 0; j < 8; ++j) st[j] = 0.f;
    for (int ch = 0; ch < S / 64; ++ch) {
        const int t0 = ch * 64;
        {
            const size_t row = (size_t)b * S + t0 + pt; const bool hasp = (t0 + pt) > 0;
            const bf16_t* zr = zrkv + row * 1536; const bf16_t* zl = zlora + row * 256;
            f32x4 c0, c1, p0, p1, m0, m1;
            const f32x4 zero = (f32x4){0.f, 0.f, 0.f, 0.f};
            ld_bf16x8(zr + hc, c0, c1); if (hasp) ld_bf16x8(zr - 1536 + hc, p0, p1); else { p0 = zero; p1 = zero; }
            m0 = *(const f32x4*)(p.rw_mu + hc); m1 = *(const f32x4*)(p.rw_mu + hc + 4);
            *(LAS f32x4*)(R + pt * 64 + pc) = mix4(c0, p0, m0); *(LAS f32x4*)(R + pt * 64 + pc + 4) = mix4(c1, p1, m1);
            ld_bf16x8(zr + 512 + hc, c0, c1); if (hasp) ld_bf16x8(zr - 1536 + 512 + hc, p0, p1); else { p0 = zero; p1 = zero; }
            m0 = *(const f32x4*)(p.rw_mu + 512 + hc); m1 = *(const f32x4*)(p.rw_mu + 512 + hc + 4);
            *(LAS f32x4*)(KP + pt * 64 + pc) = mix4(c0, p0, m0); *(LAS f32x4*)(KP + pt * 64 + pc + 4) = mix4(c1, p1, m1);
            ld_bf16x8(zr + 1024 + hc, c0, c1); if (hasp) ld_bf16x8(zr - 1536 + 1024 + hc, p0, p1); else { p0 = zero; p1 = zero; }
            m0 = *(const f32x4*)(p.rw_mu + 1024 + hc); m1 = *(const f32x4*)(p.rw_mu + 1024 + hc + 4);
            *(LAS f32x4*)(V + pt * 64 + pc) = mix4(c0, p0, m0); *(LAS f32x4*)(V + pt * 64 + pc + 4) = mix4(c1, p1, m1);
            ld_bf16x8(zl + pc, c0, c1); if (hasp) ld_bf16x8(zl - 256 + pc, p0, p1); else { p0 = zero; p1 = zero; }
            m0 = *(const f32x4*)(p.rw_mu + 1536 + pc); m1 = *(const f32x4*)(p.rw_mu + 1536 + pc + 4);
            { const f32x4 a = mix4(c0, p0, m0), bb = mix4(c1, p1, m1); u32x4 o; o.x = pk2(tanhf(a.x), tanhf(a.y)); o.y = pk2(tanhf(a.z), tanhf(a.w)); o.z = pk2(tanhf(bb.x), tanhf(bb.y)); o.w = pk2(tanhf(bb.z), tanhf(bb.w));
              *(LAS u32x4*)(TW + pt * 64 + pc) = o; }
            ld_bf16x8(zl + 64 + pc, c0, c1); if (hasp) ld_bf16x8(zl - 256 + 64 + pc, p0, p1); else { p0 = zero; p1 = zero; }
            m0 = *(const f32x4*)(p.rw_mu + 1600 + pc); m1 = *(const f32x4*)(p.rw_mu + 1600 + pc + 4);
            { const f32x4 a = mix4(c0, p0, m0), bb = mix4(c1, p1, m1); u32x4 o; o.x = pk2(a.x, a.y); o.y = pk2(a.z, a.w); o.z = pk2(bb.x, bb.y); o.w = pk2(bb.z, bb.w);
              *(LAS u32x4*)(AL + pt * 64 + pc) = o; }
#pragma unroll
            for (int hh = 0; hh < 2; ++hh) {
                const int gc = 2 * pc + 8 * hh;
                ld_bf16x8(zl + 128 + gc, c0, c1); if (hasp) ld_bf16x8(zl - 256 + 128 + gc, p0, p1); else { p0 = zero; p1 = zero; }
                m0 = *(const f32x4*)(p.rw_mu + 1664 + gc); m1 = *(const f32x4*)(p.rw_mu + 1664 + gc + 4);
                const f32x4 a = mix4(c0, p0, m0), bb = mix4(c1, p1, m1); u32x4 o;
                o.x = pk2(sigmoidf_(a.x), sigmoidf_(a.y)); o.y = pk2(sigmoidf_(a.z), sigmoidf_(a.w)); o.z = pk2(sigmoidf_(bb.x), sigmoidf_(bb.y)); o.w = pk2(sigmoidf_(bb.z), sigmoidf_(bb.w));
                *(LAS u32x4*)(SG + pt * 128 + gc) = o;
            }
        }
        __syncthreads();
        lora_mm<64, false>(TW, w2t, lds + RL_W, wid, lane);
        lora_mm<64, false>(AL, a2t, lds + RL_BV, wid, lane);
        lora_mm<128, true>(SG, g2t, lds + RL_G, wid, lane);
        __syncthreads();
        {
            float rkp = 0.f, ssq = 0.f; float kkv[8], av[8], kraw[8];
#pragma unroll
            for (int j = 0; j < 8; ++j) {
                const int c = pc + j, gc = hc + j;
                const float xw = p.rw_w0[gc] + W[pt * 64 + c];
                const float sp = fmaxf(-xw, 0.f) + log1pf(__expf(-fabsf(xw)));
                const float ew = __expf(-sp - 0.5f);
                W[pt * 64 + c] = __expf(-ew);
                av[j] = sigmoidf_(p.rw_a0[gc] + BV[pt * 64 + c]);
                kraw[j] = KP[pt * 64 + c];
                kkv[j] = kraw[j] * p.rw_k_k[gc];
                ssq += kkv[j] * kkv[j];
            }
            ssq = red8(ssq);
            const float inv = rsqrtf(fmaxf(ssq, 1e-24f));
#pragma unroll
            for (int j = 0; j < 8; ++j) {
                const int c = pc + j, gc = hc + j;
                const float kk = kkv[j] * inv;
                const float kp = kraw[j] * (1.f + (av[j] - 1.f) * p.rw_k_a[gc]);
                KK[pt * 64 + c] = kk; BV[pt * 64 + c] = kk * av[j]; KP[pt * 64 + c] = kp;
                rkp += R[pt * 64 + c] * kp * p.rw_r_k[gc];
            }
            rkp = red8(rkp);
            if ((tid & 7) == 0) RK[pt] = rkp;
        }
        __syncthreads();
#pragma unroll 2
        for (int t = 0; t < 64; ++t) {
            const f32x4 k0 = *(const LAS f32x4*)(KK + t * 64 + 8 * kq), k1 = *(const LAS f32x4*)(KK + t * 64 + 8 * kq + 4);
            float sa = st[0] * k0.x + st[1] * k0.y + st[2] * k0.z + st[3] * k0.w + st[4] * k1.x + st[5] * k1.y + st[6] * k1.z + st[7] * k1.w;
            sa = -red8(sa);
            const f32x4 w0 = *(const LAS f32x4*)(W + t * 64 + 8 * kq), w1 = *(const LAS f32x4*)(W + t * 64 + 8 * kq + 4);
            const f32x4 b0 = *(const LAS f32x4*)(BV + t * 64 + 8 * kq), b1 = *(const LAS f32x4*)(BV + t * 64 + 8 * kq + 4);
            const f32x4 q0 = *(const LAS f32x4*)(KP + t * 64 + 8 * kq), q1 = *(const LAS f32x4*)(KP + t * 64 + 8 * kq + 4);
            const f32x4 r0 = *(const LAS f32x4*)(R + t * 64 + 8 * kq), r1 = *(const LAS f32x4*)(R + t * 64 + 8 * kq + 4);
            const float vv = V[t * 64 + vloc];
            st[0] = st[0] * w0.x + sa * b0.x + vv * q0.x; st[1] = st[1] * w0.y + sa * b0.y + vv * q0.y; st[2] = st[2] * w0.z + sa * b0.z + vv * q0.z; st[3] = st[3] * w0.w + sa * b0.w + vv * q0.w;
            st[4] = st[4] * w1.x + sa * b1.x + vv * q1.x; st[5] = st[5] * w1.y + sa * b1.y + vv * q1.y; st[6] = st[6] * w1.z + sa * b1.z + vv * q1.z; st[7] = st[7] * w1.w + sa * b1.w + vv * q1.w;
            float y = st[0] * r0.x + st[1] * r0.y + st[2] * r0.z + st[3] * r0.w + st[4] * r1.x + st[5] * r1.y + st[6] * r1.z + st[7] * r1.w;
            y = red8(y);
            if (kq == 0) Y[t * 64 + vloc] = y;
        }
        __syncthreads();
        {
            float yv[8]; float s = 0.f;
#pragma unroll
            for (int j = 0; j < 8; ++j) { yv[j] = Y[pt * 64 + pc + j]; s += yv[j]; }
            const float mean = red8(s) * (1.f / 64.f); float q = 0.f;
#pragma unroll
            for (int j = 0; j < 8; ++j) { yv[j] -= mean; q += yv[j] * yv[j]; }
            const float rstd = rsqrtf(red8(q) * (1.f / 64.f) + RW_GN_EPS);
            const float rk = RK[pt]; float o[8];
#pragma unroll
            for (int j = 0; j < 8; ++j) { const int gc = hc + j;
                o[j] = (yv[j] * rstd * p.rw_gn_g[gc] + p.rw_gn_b[gc] + rk * V[pt * 64 + pc + j]) * bf2f(G[pt * 64 + pc + j]); }
            u32x4 w; w.x = pk2(o[0], o[1]); w.y = pk2(o[2], o[3]); w.z = pk2(o[4], o[5]); w.w = pk2(o[6], o[7]);
            *(u32x4*)(ya + ((size_t)b * S + t0 + pt) * 512 + hc) = w;
        }
        __syncthreads();
    }
}

__device__ __forceinline__ int mbcnt64(unsigned long long m) { return (int)__builtin_amdgcn_mbcnt_hi((unsigned)(m >> 32), __builtin_amdgcn_mbcnt_lo((unsigned)m, 0u)); }
template <int NV> __device__ __forceinline__ int wave_count_ge(const unsigned (&u)[NV], unsigned cand) {
    if (NV <= 8) { int c = 0;
#pragma unroll
        for (int i = 0; i < NV; ++i) c += (int)__builtin_popcountll(__ballot(u[i] >= cand));
        return c; }
    else { int c = 0;
#pragma unroll
        for (int i = 0; i < NV; ++i) c += (u[i] >= cand) ? 1 : 0;
        c += __builtin_amdgcn_update_dpp(0, c, 0xB1, 0xf, 0xf, true); c += __builtin_amdgcn_update_dpp(0, c, 0x4E, 0xf, 0xf, true);
        c += __builtin_amdgcn_update_dpp(0, c, 0x141, 0xf, 0xf, true); c += __builtin_amdgcn_update_dpp(0, c, 0x140, 0xf, 0xf, true);
        return __builtin_amdgcn_readlane(c, 0) + __builtin_amdgcn_readlane(c, 16) + __builtin_amdgcn_readlane(c, 32) + __builtin_amdgcn_readlane(c, 48); }
}
template <int NV, int K> __device__ __forceinline__ unsigned wave_kth(const unsigned (&u)[NV]) {
    unsigned Tt = 0u;
    for (int bit = 31; bit >= 0; --bit) {
        const unsigned cand = Tt | (1u << bit);
        const int c = wave_count_ge<NV>(u, cand);
        if (c >= K) Tt = cand;
        if (c == K) break;
    }
    return Tt;
}

constexpr int IX_LD = 4112;
__device__ __forceinline__ void indexer_unit(const Params& p, LAS unsigned char* lds, int unit) {
    const int tid = threadIdx.x, lane = tid & 63, wid = tid >> 6;
    const int b = unit >> 9, t0 = (unit & 511) * 8;
    const bf16_t* qidx = (const bf16_t*)(p.ws + WS_QIDX); const bf16_t* kidx = (const bf16_t*)(p.ws + WS_KIDX); const float* widx = (const float*)(p.ws + WS_WIDX);
    unsigned short* sel = (unsigned short*)(p.ws + WS_SEL); int* cnt = (int*)(p.ws + WS_CNT);
    LAS float* SC = (LAS float*)lds;
    const int t = t0 + wid; const size_t trow = (size_t)b * S + t;
    unsigned short* out = sel + trow * TOPK;
    if (t0 < TOPK) {
#pragma unroll
        for (int i = 0; i < 4; ++i) { const int idx = i * 64 + lane; if (idx <= t) out[idx] = (unsigned short)idx; }
        if (lane == 0) cnt[trow] = t + 1;
        return;
    }
    bf16x8 afr[2][2]; f32x4 wv[2];
#pragma unroll
    for (int rt = 0; rt < 2; ++rt) {
        const size_t row = (size_t)b * S + t0 + 4 * rt + ((lane & 15) >> 2);
#pragma unroll
        for (int ks = 0; ks < 2; ++ks) afr[rt][ks] = *(const bf16x8*)(qidx + row * 256 + (lane & 3) * 64 + 32 * ks + 8 * (lane >> 4));
        wv[rt] = *(const f32x4*)(widx + ((size_t)b * S + t0 + 4 * rt + (lane >> 4)) * 4);
    }
    const int ntiles = (t0 + 8 + 15) >> 4;
    for (int kt = wid; kt < ntiles; kt += NWAVE) {
        const bf16_t* kp = kidx + ((size_t)b * S + kt * 16 + (lane & 15)) * 64 + 8 * (lane >> 4);
        const bf16x8 b0 = *(const bf16x8*)kp, b1 = *(const bf16x8*)(kp + 32);
#pragma unroll
        for (int rt = 0; rt < 2; ++rt) {
            f32x4 acc = (f32x4){0.f, 0.f, 0.f, 0.f};
            acc = __builtin_amdgcn_mfma_f32_16x16x32_bf16(afr[rt][0], b0, acc, 0, 0, 0);
            acc = __builtin_amdgcn_mfma_f32_16x16x32_bf16(afr[rt][1], b1, acc, 0, 0, 0);
            const float s = wv[rt].x * fmaxf(acc.x, 0.f) + wv[rt].y * fmaxf(acc.y, 0.f) + wv[rt].z * fmaxf(acc.z, 0.f) + wv[rt].w * fmaxf(acc.w, 0.f);
            SC[(4 * rt + (lane >> 4)) * IX_LD + kt * 16 + (lane & 15)] = s;
        }
    }
    __syncthreads();
    {
        const int n = t + 1;
        unsigned u[64];
#pragma unroll
        for (int i = 0; i < 64; ++i) { const int idx = i * 64 + lane; u[i] = (idx < n) ? sortable(SC[wid * IX_LD + idx]) : 0u; }
        const unsigned Tt = wave_kth<64, TOPK>(u);
        const int cgt = wave_count_ge<64>(u, Tt + 1u);
        const int need_eq = TOPK - cgt;
        int base = 0, eqb = 0;
#pragma unroll
        for (int i = 0; i < 64; ++i) {
            if (i * 64 < n) {
                const bool gt = u[i] > Tt, eq = u[i] == Tt;
                const unsigned long long meq = __ballot(eq);
                const bool take = gt || (eq && (eqb + mbcnt64(meq)) < need_eq);
                const unsigned long long mt = __ballot(take);
                if (take) out[base + mbcnt64(mt)] = (unsigned short)(i * 64 + lane);
                base += (int)__builtin_popcountll(mt); eqb += (int)__builtin_popcountll(meq);
            }
        }
        if (lane == 0) cnt[trow] = TOPK;
    }
    __syncthreads();
}

constexpr int AT_LUT = 0, AT_FAR = 4096, AT_WAVE = 8192, AT_WSZ = 8192 + 512;
__device__ __forceinline__ void attn_phase(const Params& p, LAS unsigned char* lds, int bid, int nblk) {
    const int tid = threadIdx.x, lane = tid & 63, wid = tid >> 6;
    bf16_t* zq = (bf16_t*)(p.ws + WS_ZQ); const bf16_t* ckv = (const bf16_t*)(p.ws + WS_CKV);
    const unsigned short* sel = (const unsigned short*)(p.ws + WS_SEL); const int* cntp = (const int*)(p.ws + WS_CNT);
    LAS float* LUT = (LAS float*)(lds + AT_LUT); LAS float* FAR = (LAS float*)(lds + AT_FAR);
    LAS float* P = (LAS float*)(lds + AT_WAVE + wid * AT_WSZ); LAS unsigned short* SEL = (LAS unsigned short*)(lds + AT_WAVE + wid * AT_WSZ + 8192);
    for (int i = tid; i < 1024; i += NTHR) { const int hh = i >> 7, n = i & 127; int bk;
        if (n < 16) bk = n; else { bk = 16 + (int)(logf((float)n / 16.f) / 2.0794415416798357f * 16.f); bk = bk < 31 ? bk : 31; }
        LUT[i] = p.rel_bias[bk * 8 + hh]; }
    if (tid < 8) FAR[tid] = p.rel_bias[31 * 8 + tid];
    __syncthreads();
    for (int t = bid * NWAVE + wid; t < T; t += nblk * NWAVE) {
        const int b = t / S, tp = t % S; const int cnt = cntp[t];
        { const u32x2 w = *(const u32x2*)(sel + (size_t)t * TOPK + 4 * lane); const int s0 = 4 * lane;
          u32x2 o; o.x = (s0 < cnt ? (w.x & 0xffffu) : 0u) | (s0 + 1 < cnt ? (w.x & 0xffff0000u) : 0u); o.y = (s0 + 2 < cnt ? (w.y & 0xffffu) : 0u) | (s0 + 3 < cnt ? (w.y & 0xffff0000u) : 0u);
          *(LAS u32x2*)(SEL + 4 * lane) = o; }
        bf16x8 qf[4];
#pragma unroll
        for (int ks = 0; ks < 4; ++ks) { if ((lane & 15) < 8) qf[ks] = *(const bf16x8*)(zq + (size_t)t * 1024 + (lane & 15) * 128 + 32 * ks + 8 * (lane >> 4)); else qf[ks] = (bf16x8){0, 0, 0, 0, 0, 0, 0, 0}; }
        asm volatile("s_waitcnt lgkmcnt(0)" ::: "memory");
        const int hb = (lane >> 4) * 4;
        f32x4 lg[16];
#pragma unroll
        for (int kt = 0; kt < 16; ++kt) {
            const int slot = kt * 16 + (lane & 15); const int key = SEL[slot];
            const bf16_t* kp = ckv + ((size_t)b * S + key) * 128 + 8 * (lane >> 4);
            f32x4 acc = (f32x4){0.f, 0.f, 0.f, 0.f};
#pragma unroll
            for (int ks = 0; ks < 4; ++ks) acc = __builtin_amdgcn_mfma_f32_16x16x32_bf16(qf[ks], *(const bf16x8*)(kp + 32 * ks), acc, 0, 0, 0);
            const int n = tp - key; const bool ok = slot < cnt;
#pragma unroll
            for (int r = 0; r < 4; ++r) { const int hh = (hb + r) & 7; const float bias = (n < 128) ? LUT[hh * 128 + (n & 127)] : FAR[hh]; lg[kt][r] = ok ? acc[r] + bias : -INFINITY; }
        }
#pragma unroll
        for (int r = 0; r < 4; ++r) {
            float m = lg[0][r];
#pragma unroll
            for (int kt = 1; kt < 16; ++kt) m = fmaxf(m, lg[kt][r]);
            m = red16_max(m); float s = 0.f;
#pragma unroll
            for (int kt = 0; kt < 16; ++kt) { lg[kt][r] = __expf(lg[kt][r] - m); s += lg[kt][r]; }
            s = red16_sum(s); const float inv = 1.f / s;
#pragma unroll
            for (int kt = 0; kt < 16; ++kt) lg[kt][r] *= inv;
        }
        if (lane < 32) {
#pragma unroll
            for (int kt = 0; kt < 16; ++kt) *(LAS f32x4*)(P + (kt * 16 + (lane & 15)) * 8 + hb) = lg[kt];
        }
        asm volatile("s_waitcnt lgkmcnt(0)" ::: "memory");
        float o0[8], o1[8];
#pragma unroll
        for (int hh = 0; hh < 8; ++hh) { o0[hh] = 0.f; o1[hh] = 0.f; }
        const bf16_t* vb = ckv + (size_t)b * S * 128 + 2 * lane;
        const int cnt4 = (cnt + 3) & ~3;
        for (int s = 0; s < cnt4; s += 4) {
            unsigned w[4];
#pragma unroll
            for (int j = 0; j < 4; ++j) w[j] = *(const unsigned*)(vb + (size_t)SEL[s + j] * 128);
#pragma unroll
            for (int j = 0; j < 4; ++j) {
                const f32x4 pa = *(const LAS f32x4*)(P + (s + j) * 8), pb = *(const LAS f32x4*)(P + (s + j) * 8 + 4);
                const float v0 = bflo(w[j]), v1 = bfhi(w[j]);
                o0[0] += pa.x * v0; o1[0] += pa.x * v1; o0[1] += pa.y * v0; o1[1] += pa.y * v1; o0[2] += pa.z * v0; o1[2] += pa.z * v1; o0[3] += pa.w * v0; o1[3] += pa.w * v1;
                o0[4] += pb.x * v0; o1[4] += pb.x * v1; o0[5] += pb.y * v0; o1[5] += pb.y * v1; o0[6] += pb.z * v0; o1[6] += pb.z * v1; o0[7] += pb.w * v0; o1[7] += pb.w * v1;
            }
        }
#pragma unroll
        for (int hh = 0; hh < 8; ++hh) *(unsigned*)(zq + (size_t)t * 1024 + hh * 128 + 2 * lane) = pk2(o0[hh], o1[hh]);
        asm volatile("s_waitcnt lgkmcnt(0)" ::: "memory");
    }
}

__device__ __forceinline__ void phase_ln1(const Params& p, int bid, int nblk) {
    const int lane = threadIdx.x & 63, wid = threadIdx.x >> 6;
    const float* mod = (const float*)(p.ws + WS_MOD); bf16_t* h2 = (bf16_t*)(p.ws + WS_H2);
    for (int m = bid * NWAVE + wid; m < T; m += nblk * NWAVE) {
        const int b = m / S; float* row = p.out + (size_t)m * D;
        f32x4 v[4]; float s = 0.f;
#pragma unroll
        for (int j = 0; j < 4; ++j) { v[j] = *(const f32x4*)(row + 4 * lane + 256 * j); s += (v[j].x + v[j].y) + (v[j].z + v[j].w); }
        const float mean = wave_sum(s) * (1.f / D); float q = 0.f;
#pragma unroll
        for (int j = 0; j < 4; ++j) { v[j] = v[j] - mean; q += (v[j].x * v[j].x + v[j].y * v[j].y) + (v[j].z * v[j].z + v[j].w * v[j].w); }
        const float rstd = rsqrtf(wave_sum(q) * (1.f / D) + LN_EPS);
#pragma unroll
        for (int j = 0; j < 4; ++j) { const int c = 4 * lane + 256 * j;
            const f32x4 x1 = v[j] * rstd * *(const f32x4*)(p.ln1_g + c) + *(const f32x4*)(p.ln1_b + c);
            *(f32x4*)(row + c) = x1;
            st_bf16x4(h2 + (size_t)m * D + c, x1 * (1.f + *(const f32x4*)(mod + b * 6144 + 4096 + c)) + *(const f32x4*)(mod + b * 6144 + 3072 + c)); }
    }
}

constexpr int RT_S = 0, RT_WAVE = 16384, RT_WSZ = 512;
template <int NV> __device__ __forceinline__ void emit_topk16(const unsigned (&u)[NV], const float (&val)[NV], const int (&idx)[NV], LAS float* ov, LAS int* oi, int lane) {
    const unsigned Tt = wave_kth<NV, 16>(u);
    const int cgt = wave_count_ge<NV>(u, Tt + 1u);
    const int need_eq = 16 - cgt; int base = 0, eqb = 0;
#pragma unroll
    for (int i = 0; i < NV; ++i) {
        const bool gt = u[i] > Tt, eq = u[i] == Tt;
        const unsigned long long meq = __ballot(eq);
        const bool take = gt || (eq && (eqb + mbcnt64(meq)) < need_eq);
        const unsigned long long mt = __ballot(take);
        if (take) { const int pos = base + mbcnt64(mt); ov[pos] = val[i]; oi[pos] = idx[i]; }
        base += (int)__builtin_popcountll(mt); eqb += (int)__builtin_popcountll(meq);
    }
}
__device__ __forceinline__ void route_phase(const Params& p, LAS unsigned char* lds, int bid, int nblk) {
    const int tid = threadIdx.x, lane = tid & 63, wid = tid >> 6;
    const float* pq = (const float*)(p.ws + WS_PQ); const bf16_t* keys = (const bf16_t*)(p.ws + WS_KEYS);
    unsigned short* eidx = (unsigned short*)(p.ws + WS_EIDX); float* gate = (float*)(p.ws + WS_GATE);
    LAS float* SS = (LAS float*)(lds + RT_S);
    LAS float* L1v = (LAS float*)(lds + RT_WAVE + wid * RT_WSZ); LAS int* L1i = (LAS int*)(L1v + 16); LAS float* L2v = L1v + 32; LAS int* L2i = (LAS int*)(L1v + 48);
    LAS float* Ev = L1v + 64; LAS int* Ei = (LAS int*)(L1v + 80);
    for (int unit = bid; unit < (T / 16) * 8; unit += nblk) {
        const int tt = unit >> 3, h = unit & 7, t0 = tt * 16;
        {
            const int c = wid >> 2;
            const float* qp = pq + (size_t)(t0 + (lane & 15)) * D + h * 128 + c * 64 + 8 * (lane >> 4);
            bf16x8 af[2];
#pragma unroll
            for (int ks = 0; ks < 2; ++ks) { const f32x4 a = *(const f32x4*)(qp + 32 * ks), bq = *(const f32x4*)(qp + 32 * ks + 4);
                u32x4 w; w.x = pk2(a.x, a.y); w.y = pk2(a.z, a.w); w.z = pk2(bq.x, bq.y); w.w = pk2(bq.z, bq.w); af[ks] = __builtin_bit_cast(bf16x8, w); }
#pragma unroll
            for (int nn = 0; nn < 2; ++nn) {
                const int nt = 2 * (wid & 3) + nn;
                const bf16_t* kp = keys + ((size_t)(h * 2 + c) * 128 + 16 * nt + (lane & 15)) * 64 + 8 * (lane >> 4);
                f32x4 acc = (f32x4){0.f, 0.f, 0.f, 0.f};
                acc = __builtin_amdgcn_mfma_f32_16x16x32_bf16(af[0], *(const bf16x8*)kp, acc, 0, 0, 0);
                acc = __builtin_amdgcn_mfma_f32_16x16x32_bf16(af[1], *(const bf16x8*)(kp + 32), acc, 0, 0, 0);
#pragma unroll
                for (int r = 0; r < 4; ++r) SS[((lane >> 4) * 4 + r) * 256 + c * 128 + 16 * nt + (lane & 15)] = acc[r];
            }
        }
        __syncthreads();
        for (int q = 0; q < 2; ++q) {
            const int tok = 2 * wid + q;
#pragma unroll
            for (int c = 0; c < 2; ++c) {
                float val[2]; int idx[2]; unsigned u[2];
#pragma unroll
                for (int i = 0; i < 2; ++i) { idx[i] = i * 64 + lane; val[i] = SS[tok * 256 + c * 128 + idx[i]]; u[i] = sortable(val[i]); }
                if (c == 0) emit_topk16<2>(u, val, idx, L1v, L1i, lane); else emit_topk16<2>(u, val, idx, L2v, L2i, lane);
            }
            asm volatile("s_waitcnt lgkmcnt(0)" ::: "memory");
            {
                float val[4]; int idx[4]; unsigned u[4];
                const float s1 = L1v[lane >> 2]; const int i1 = L1i[lane >> 2];
#pragma unroll
                for (int j = 0; j < 4; ++j) { const int bb = (lane & 3) * 4 + j; val[j] = s1 + L2v[bb]; idx[j] = i1 * 128 + L2i[bb]; u[j] = sortable(val[j]); }
                emit_topk16<4>(u, val, idx, Ev, Ei, lane);
            }
            asm volatile("s_waitcnt lgkmcnt(0)" ::: "memory");
            {
                const float v = Ev[lane & 15]; const int e = Ei[lane & 15];
                const float m = red16_max(v); const float ex = __expf(v - m); const float sm = red16_sum(ex);
                if (lane < 16) { const size_t o = (size_t)(t0 + tok) * 128 + h * 16 + lane; eidx[o] = (unsigned short)e; gate[o] = ex / sm; }
            }
            asm volatile("s_waitcnt lgkmcnt(0)" ::: "memory");
        }
        __syncthreads();
    }
}

constexpr int EX_WSZ = 2048 + 512 + 512;
__device__ __forceinline__ float gelu_exact(float x) { return 0.5f * x * (1.f + erff(x * 0.7071067811865476f)); }
__device__ __forceinline__ void expert_phase(const Params& p, LAS unsigned char* lds, int bid, int nblk) {
    const int tid = threadIdx.x, lane = tid & 63, wid = tid >> 6;
    const bf16_t* h2 = (const bf16_t*)(p.ws + WS_H2); const bf16_t* ut = (const bf16_t*)(p.ws + WS_UT); const bf16_t* vt = (const bf16_t*)(p.ws + WS_VT);
    const unsigned short* eidx = (const unsigned short*)(p.ws + WS_EIDX); const float* gate = (const float*)(p.ws + WS_GATE); const float* mod = (const float*)(p.ws + WS_MOD);
    LAS bf16_t* H2 = (LAS bf16_t*)(lds + wid * EX_WSZ); LAS float* ACT = (LAS float*)(lds + wid * EX_WSZ + 2048); LAS int* EI = (LAS int*)(lds + wid * EX_WSZ + 2560);
    for (int t = bid * NWAVE + wid; t < T; t += nblk * NWAVE) {
        const int b = t / S;
        *(LAS u32x4*)(H2 + 8 * lane) = *(const u32x4*)(h2 + (size_t)t * D + 8 * lane);
        *(LAS u32x4*)(H2 + 512 + 8 * lane) = *(const u32x4*)(h2 + (size_t)t * D + 512 + 8 * lane);
        { const unsigned w = *(const unsigned*)(eidx + (size_t)t * 128 + 2 * lane); EI[2 * lane] = (int)(w & 0xffffu); EI[2 * lane + 1] = (int)(w >> 16); }
        asm volatile("s_waitcnt lgkmcnt(0)" ::: "memory");
#pragma unroll 1
        for (int g = 0; g < 8; ++g) {
            const int e = EI[g * 16 + (lane & 15)];
            const bf16_t* up = ut + (size_t)e * D + 8 * (lane >> 4);
            f32x4 acc = (f32x4){0.f, 0.f, 0.f, 0.f};
#pragma unroll 8
            for (int ks = 0; ks < 32; ++ks) acc = __builtin_amdgcn_mfma_f32_16x16x32_bf16(*(const bf16x8*)(up + 32 * ks), *(const LAS bf16x8*)(H2 + 32 * ks + 8 * (lane >> 4)), acc, 0, 0, 0);
            const f32x4 gt = *(const f32x4*)(gate + (size_t)t * 128 + g * 16 + (lane >> 4) * 4);
            f32x4 a; a.x = gelu_exact(acc.x) * gt.x; a.y = gelu_exact(acc.y) * gt.y; a.z = gelu_exact(acc.z) * gt.z; a.w = gelu_exact(acc.w) * gt.w;
            if ((lane & 15) == 0) *(LAS f32x4*)(ACT + g * 16 + (lane >> 4) * 4) = a;
        }
        asm volatile("s_waitcnt lgkmcnt(0)" ::: "memory");
        float y[16];
#pragma unroll
        for (int j = 0; j < 16; ++j) y[j] = 0.f;
        for (int e0 = 0; e0 < 128; e0 += 4) {
            u32x4 w0[4], w1[4]; float a[4];
#pragma unroll
            for (int j = 0; j < 4; ++j) { const bf16_t* vp = vt + (size_t)EI[e0 + j] * D + 8 * lane; w0[j] = *(const u32x4*)vp; w1[j] = *(const u32x4*)(vp + 512); a[j] = ACT[e0 + j]; }
#pragma unroll
            for (int j = 0; j < 4; ++j) {
                y[0] += a[j] * bflo(w0[j].x); y[1] += a[j] * bfhi(w0[j].x); y[2] += a[j] * bflo(w0[j].y); y[3] += a[j] * bfhi(w0[j].y);
                y[4] += a[j] * bflo(w0[j].z); y[5] += a[j] * bfhi(w0[j].z); y[6] += a[j] * bflo(w0[j].w); y[7] += a[j] * bfhi(w0[j].w);
                y[8] += a[j] * bflo(w1[j].x); y[9] += a[j] * bfhi(w1[j].x); y[10] += a[j] * bflo(w1[j].y); y[11] += a[j] * bfhi(w1[j].y);
                y[12] += a[j] * bflo(w1[j].z); y[13] += a[j] * bfhi(w1[j].z); y[14] += a[j] * bflo(w1[j].w); y[15] += a[j] * bfhi(w1[j].w);
            }
        }
        float* row = p.out + (size_t)t * D; const float* g2 = mod + b * 6144 + 5120;
        float v[16]; float s = 0.f;
#pragma unroll
        for (int hh = 0; hh < 2; ++hh)
#pragma unroll
            for (int q = 0; q < 2; ++q) { const int c = 512 * hh + 8 * lane + 4 * q; const f32x4 xv = *(const f32x4*)(row + c), gv = *(const f32x4*)(g2 + c);
                v[8 * hh + 4 * q + 0] = xv.x * DN_ALPHA + gv.x * y[8 * hh + 4 * q + 0]; v[8 * hh + 4 * q + 1] = xv.y * DN_ALPHA + gv.y * y[8 * hh + 4 * q + 1];
                v[8 * hh + 4 * q + 2] = xv.z * DN_ALPHA + gv.z * y[8 * hh + 4 * q + 2]; v[8 * hh + 4 * q + 3] = xv.w * DN_ALPHA + gv.w * y[8 * hh + 4 * q + 3]; }
#pragma unroll
        for (int j = 0; j < 16; ++j) s += v[j];
        const float mean = wave_sum(s) * (1.f / D); float qq = 0.f;
#pragma unroll
        for (int j = 0; j < 16; ++j) { v[j] -= mean; qq += v[j] * v[j]; }
        const float rstd = rsqrtf(wave_sum(qq) * (1.f / D) + LN_EPS);
#pragma unroll
        for (int hh = 0; hh < 2; ++hh)
#pragma unroll
            for (int q = 0; q < 2; ++q) { const int c = 512 * hh + 8 * lane + 4 * q; const f32x4 gv = *(const f32x4*)(p.ln2_g + c), bv = *(const f32x4*)(p.ln2_b + c);
                f32x4 o; o.x = v[8 * hh + 4 * q + 0] * rstd * gv.x + bv.x; o.y = v[8 * hh + 4 * q + 1] * rstd * gv.y + bv.y; o.z = v[8 * hh + 4 * q + 2] * rstd * gv.z + bv.z; o.w = v[8 * hh + 4 * q + 3] * rstd * gv.w + bv.w;
                *(f32x4*)(row + c) = o; }
        asm volatile("s_waitcnt lgkmcnt(0)" ::: "memory");
    }
}

constexpr int NPHASE = 12;
__global__ void __launch_bounds__(NTHR) fwd_kernel(Params p) {
    extern __shared__ __attribute__((aligned(16))) unsigned char lds_raw[];
    LAS unsigned char* lds = (LAS unsigned char*)lds_raw;
    const int bid = blockIdx.x, nblk = gridDim.x;
    unsigned char* ws = p.ws;
#if MK_SINGLE
#define GRID_SYNC() cg::this_grid().sync()
#else
#define GRID_SYNC() do {} while (0)
#endif
#define PH(k) if (p.ph_lo <= (k) && (k) < p.ph_hi)
#define SEAM(k) if (p.ph_lo <= (k) && (k) + 1 < p.ph_hi) GRID_SYNC()
    PH(0) { phase_prep(p, lds, bid, nblk); } SEAM(0);
    PH(1) { phase_modsum(p, bid, nblk); } SEAM(1);
    PH(2) { phase_h1(p, bid, nblk); } SEAM(2);
    PH(3) { GemmArgs g{(const bf16_t*)(ws + WS_H1), (const bf16_t*)(ws + WS_WIN), T, NPAD, D};
        EpiInproj e{(bf16_t*)(ws + WS_ZRKV), (bf16_t*)(ws + WS_ZLORA), (bf16_t*)(ws + WS_ZQ), (bf16_t*)(ws + WS_CKV), (bf16_t*)(ws + WS_KIDX), (bf16_t*)(ws + WS_QIDX), (bf16_t*)(ws + WS_GA), (bf16_t*)(ws + WS_GB),
                    (float*)(ws + WS_WIDX), p.dsa_kv_g, p.idx_k_g, p.idx_k_b};
        gemm_phase(lds, g, e, bid, nblk); } SEAM(3);
    PH(4) {
        if (bid < 64) rwkv_unit(p, lds, bid >> 3, bid & 7);
        else for (int u = (T / 8 - 1) - (bid - 64); u >= 0; u -= (nblk - 64)) indexer_unit(p, lds, u);
    } SEAM(4);
    PH(5) { attn_phase(p, lds, bid, nblk); } SEAM(5);
    PH(6) { { GemmArgs g{(const bf16_t*)(ws + WS_YA), (const bf16_t*)(ws + WS_WA), T, D, 512}; EpiBrA e{(bf16_t*)(ws + WS_GA)}; gemm_phase(lds, g, e, bid, nblk); }
            { GemmArgs g{(const bf16_t*)(ws + WS_ZQ), (const bf16_t*)(ws + WS_WB), T, D, D}; EpiBrB e{(bf16_t*)(ws + WS_GA), (const bf16_t*)(ws + WS_GB)}; gemm_phase(lds, g, e, bid, nblk); } } SEAM(6);
    PH(7) { GemmArgs g{(const bf16_t*)(ws + WS_GA), (const bf16_t*)(ws + WS_WO), T, D, D}; EpiOut e{p.x, (const float*)(ws + WS_MOD), p.out}; gemm_phase(lds, g, e, bid, nblk); } SEAM(7);
    PH(8) { phase_ln1(p, bid, nblk); } SEAM(8);
    PH(9) { GemmArgs g{(const bf16_t*)(ws + WS_H2), (const bf16_t*)(ws + WS_WPQ), T, D, D}; EpiPq e{(float*)(ws + WS_PQ)}; gemm_phase(lds, g, e, bid, nblk); } SEAM(9);
    PH(10) { route_phase(p, lds, bid, nblk); } SEAM(10);
    PH(11) { expert_phase(p, lds, bid, nblk); }
}

extern "C" void kernel_launch(void* const* d_in, const int* in_sizes, int n_in, void* d_out, int out_size, void* d_ws, size_t ws_size, hipStream_t stream) {
    static int grid = 0;
    if (grid == 0) {
        if (n_in != 31 || out_size != T * D || ws_size < WS_NEED) { fprintf(stderr, "kernel_launch: unexpected shapes (n_in %d, out %d, ws %zu)\n", n_in, out_size, ws_size); grid = -1; return; }
        int dev = 0, cus = 0, per_cu = 0;
        (void)hipGetDevice(&dev); (void)hipDeviceGetAttribute(&cus, hipDeviceAttributeMultiprocessorCount, dev);
        if (hipFuncSetAttribute((const void*)fwd_kernel, hipFuncAttributeMaxDynamicSharedMemorySize, LDS_BYTES) != hipSuccess) { fprintf(stderr, "kernel_launch: hipFuncSetAttribute failed\n"); grid = -1; return; }
        if (hipOccupancyMaxActiveBlocksPerMultiprocessor(&per_cu, (const void*)fwd_kernel, NTHR, LDS_BYTES) != hipSuccess || per_cu < 1) { fprintf(stderr, "kernel_launch: occupancy query failed (%d)\n", per_cu); grid = -1; return; }
        grid = cus * (per_cu > 1 ? 1 : per_cu);
        fprintf(stderr, "kernel_launch: %d CUs, %d blocks/CU reported, grid %d\n", cus, per_cu, grid);
    }
    if (grid < 0) return;
    Params p{};
    const float** f = (const float**)&p;
    for (int i = 0; i < 31; ++i) f[i] = (const float*)d_in[i];
    p.out = (float*)d_out; p.ws = (unsigned char*)d_ws;
#if MK_SINGLE
    p.ph_lo = 0; p.ph_hi = NPHASE;
    void* args[] = {&p};
    hipError_t e = hipLaunchCooperativeKernel((const void*)fwd_kernel, dim3(grid), dim3(NTHR), args, LDS_BYTES, stream);
    if (e != hipSuccess) fprintf(stderr, "kernel_launch: cooperative launch failed: %s (grid %d)\n", hipGetErrorString(e), grid);
#else
    for (int ph = 0; ph < NPHASE; ++ph) { p.ph_lo = ph; p.ph_hi = ph + 1; hipLaunchKernelGGL(fwd_kernel, dim3(grid), dim3(NTHR), LDS_BYTES, stream, p); }
#endif
}
```

```cpp
#include <hip/hip_runtime.h>
#include <hip/hip_cooperative_groups.h>
#include <cstdio>
#include <cstdint>
namespace cg = cooperative_groups;

#ifndef PROBE_PHASE
#define PROBE_PHASE -1
#endif
#ifndef MK_SINGLE
#define MK_SINGLE 1
#endif

#define LAS __attribute__((address_space(3)))
typedef unsigned short bf16_t;
typedef short bf16x8 __attribute__((ext_vector_type(8)));
typedef float f32x4 __attribute__((ext_vector_type(4)));
typedef float f32x2 __attribute__((ext_vector_type(2)));
typedef unsigned u32x4 __attribute__((ext_vector_type(4)));
typedef unsigned u32x2 __attribute__((ext_vector_type(2)));

constexpr int D = 1024, NB = 8, S = 4096, T = NB * S;
constexpr int RW_H = 8, RW_N = 64, RW_DIM = 512;
constexpr int IN_COLS = 5316, NPAD = 5376;
constexpr int TOPK = 256;
constexpr int PEER_E = 16384;
constexpr float LN_EPS = 1e-5f;
constexpr float DN_ALPHA = 1.189207115002721f;
constexpr float RW_GN_EPS = 64e-5f;
constexpr int NTHR = 512, NWAVE = 8;
constexpr int LDS_BYTES = 147456;

constexpr size_t MiB = 1u << 20;
constexpr size_t WS_MODP = 90 * MiB;
constexpr size_t WS_MOD = 4 * MiB;
constexpr size_t WS_WIN = 5 * MiB;
constexpr size_t WS_WA = 16 * MiB;
constexpr size_t WS_WB = 17 * MiB;
constexpr size_t WS_WO = 19 * MiB;
constexpr size_t WS_WPQ = 21 * MiB;
constexpr size_t WS_W2T = 23 * MiB;
constexpr size_t WS_A2T = WS_W2T + 65536;
constexpr size_t WS_G2T = WS_A2T + 65536;
constexpr size_t WS_KEYS = WS_G2T + 131072;
constexpr size_t WS_UT = 24 * MiB;
constexpr size_t WS_VT = 40 * MiB;
constexpr float U_SCALE = 64.f, V_SCALE = 8.f;
constexpr size_t WS_ZRKV = 88 * MiB;
constexpr size_t WS_ZLORA = 184 * MiB;
constexpr size_t WS_ZQ = 200 * MiB;
constexpr size_t WS_GA = 264 * MiB;
constexpr size_t WS_GB = 328 * MiB;
constexpr size_t WS_CKV = 392 * MiB;
constexpr size_t WS_KIDX = 400 * MiB;
constexpr size_t WS_WIDX = 404 * MiB;
constexpr size_t WS_QIDX = 405 * MiB;
constexpr size_t WS_H1 = 421 * MiB;
constexpr size_t WS_YA = 421 * MiB;
constexpr size_t WS_SEL = 453 * MiB;
constexpr size_t WS_CNT = 469 * MiB;
constexpr size_t WS_H2 = 88 * MiB;
constexpr size_t WS_PQ = 200 * MiB;
constexpr size_t WS_EIDX = 328 * MiB;
constexpr size_t WS_GATE = 336 * MiB;
constexpr size_t WS_RG = 453 * MiB;
constexpr size_t WS_ZMISC = 485 * MiB;
constexpr size_t WS_NEED = 502 * MiB;

__device__ __forceinline__ unsigned f2bf(float f) { unsigned u = __float_as_uint(f); return (u + 0x7fffu + ((u >> 16) & 1u)) >> 16; }
__device__ __forceinline__ unsigned pk2(float lo, float hi) { return f2bf(lo) | (f2bf(hi) << 16); }
__device__ __forceinline__ unsigned pk2h(float lo, float hi) { unsigned r; asm("s_nop 1\n\tv_cvt_pk_bf16_f32 %0, %1, %2" : "=v"(r) : "v"(lo), "v"(hi)); return r; }
__device__ __forceinline__ float bf2f(bf16_t b) { return __uint_as_float((unsigned)b << 16); }
__device__ __forceinline__ float bflo(unsigned w) { return __uint_as_float(w << 16); }
__device__ __forceinline__ float bfhi(unsigned w) { return __uint_as_float(w & 0xffff0000u); }
__device__ __forceinline__ float sigmoidf_(float x) { return __builtin_amdgcn_rcpf(1.f + __expf(-x)); }
__device__ __forceinline__ float tanh_fast(float x) { return 1.f - 2.f * __builtin_amdgcn_rcpf(1.f + __expf(2.f * x)); }
__device__ __forceinline__ float wave_sum(float v) {
#pragma unroll
    for (int o = 1; o < 64; o <<= 1) v += __shfl_xor(v, o);
    return v;
}
template <int CTRL> __device__ __forceinline__ float dppf(float x) {
    return __int_as_float(__builtin_amdgcn_update_dpp(0, __float_as_int(x), CTRL, 0xf, 0xf, true));
}
__device__ __forceinline__ float red8(float x) { x += dppf<0xB1>(x); x += dppf<0x4E>(x); x += dppf<0x141>(x); return x; }
__device__ __forceinline__ float red16_sum(float x) { x += dppf<0xB1>(x); x += dppf<0x4E>(x); x += dppf<0x141>(x); x += dppf<0x140>(x); return x; }
__device__ __forceinline__ float red16_max(float x) { x = fmaxf(x, dppf<0xB1>(x)); x = fmaxf(x, dppf<0x4E>(x)); x = fmaxf(x, dppf<0x141>(x)); x = fmaxf(x, dppf<0x140>(x)); return x; }
__device__ __forceinline__ void st_bf16x4(bf16_t* p, f32x4 v) { u32x2 w; w.x = pk2(v.x, v.y); w.y = pk2(v.z, v.w); *(u32x2*)p = w; }
__device__ __forceinline__ unsigned umax_(unsigned a, unsigned b) { return a > b ? a : b; }
__device__ __forceinline__ unsigned umin_(unsigned a, unsigned b) { return a < b ? a : b; }
__device__ __forceinline__ unsigned sortable(float f) { const unsigned u = __float_as_uint(f); return u ^ ((unsigned)((int)u >> 31) | 0x80000000u); }

__device__ __forceinline__ f32x4 ld_bf16x4(const bf16_t* p) { const u32x2 w = *(const u32x2*)p; return (f32x4){bflo(w.x), bfhi(w.x), bflo(w.y), bfhi(w.y)}; }
__device__ __forceinline__ void ld_bf16x8(const bf16_t* p, f32x4& a, f32x4& b) { const u32x4 w = *(const u32x4*)p; a = (f32x4){bflo(w.x), bfhi(w.x), bflo(w.y), bfhi(w.y)}; b = (f32x4){bflo(w.z), bfhi(w.z), bflo(w.w), bfhi(w.w)}; }
#define LBAR() do { asm volatile("s_waitcnt lgkmcnt(0)" ::: "memory"); __builtin_amdgcn_s_barrier(); asm volatile("" ::: "memory"); } while (0)
#define KEEP1(x) asm volatile("" :: "v"(x))
#define KEEP4(v) asm volatile("" :: "v"((v).x), "v"((v).y), "v"((v).z), "v"((v).w))
struct Params {
    const float *x, *c, *w_ada, *b_ada, *w_in, *rw_mu, *rw_w0, *rw_w2, *rw_a0, *rw_a2, *rw_g2, *rw_k_k, *rw_k_a, *rw_r_k, *rw_gn_g, *rw_gn_b;
    const float *dsa_kv_g, *idx_k_g, *idx_k_b, *rel_bias, *w_br_a, *w_br_b, *w_out, *ln1_g, *ln1_b, *peer_wq, *peer_keys, *peer_u, *peer_v, *ln2_g, *ln2_b;
    float* out; unsigned char* ws;
    int ph_lo, ph_hi, probe_ph, pad;
};

__device__ __forceinline__ int win_src_col(int r) {
    if (r < 2944) return r;
    if (r < 3008) return r + 256;
    if (r < 3012) return r + 256;
    if (r < 3072) return -1;
    if (r < 3328) return r - 128;
    return r - 60;
}
template <bool WIN>
__device__ __forceinline__ void transpose_item(const float* W, int K, int N, bf16_t* WT, LAS float* scr, int item, int lane, int nrows, bool dry) {
    const int nblk = nrows / 32, kb = item / nblk, nb = item % nblk, k0 = 64 * kb, n0 = 32 * nb;
    const int rr = n0 + (lane & 31);
    const int sc = WIN ? win_src_col(rr) : rr;
#pragma unroll 8
    for (int i = 0; i < 32; ++i) { const int kk = 2 * i + (lane >> 5); scr[kk * 33 + (lane & 31)] = (sc >= 0) ? W[(size_t)(k0 + kk) * N + sc] : 0.f; }
    asm volatile("s_waitcnt lgkmcnt(0)" ::: "memory");
    const int c = lane & 7;
#pragma unroll
    for (int j = 0; j < 4; ++j) { const int n = (lane >> 3) + 8 * j; const LAS float* s = scr + (8 * c) * 33 + n;
        u32x4 o; o.x = pk2(s[0 * 33], s[1 * 33]); o.y = pk2(s[2 * 33], s[3 * 33]); o.z = pk2(s[4 * 33], s[5 * 33]); o.w = pk2(s[6 * 33], s[7 * 33]);
        if (!dry) *(u32x4*)(WT + (size_t)(n0 + n) * K + k0 + 8 * c) = o; }
    asm volatile("s_waitcnt lgkmcnt(0)" ::: "memory");
}

__device__ __forceinline__ void peer_tables(const Params& p, int bid, int nblk, bool dry) {
    const int tid = threadIdx.x; unsigned char* ws = p.ws;
    {
        const size_t gt = (size_t)bid * NTHR + tid, GT = (size_t)nblk * NTHR;
        constexpr size_t NU = (size_t)PEER_E * D / 16, NK = (size_t)8 * 2 * 128 * 64 / 16;
        for (size_t i = gt; i < 2 * NU + NK; i += GT) {
            if (i < 2 * NU) {
                const bool isv = i >= NU; const size_t j = isv ? i - NU : i;
                const float* src = (isv ? p.peer_v : p.peer_u) + j * 16; unsigned char* dst = ws + (isv ? WS_VT : WS_UT) + j * 16; const float sc = isv ? V_SCALE : U_SCALE;
                u32x4 o;
#pragma unroll
                for (int q = 0; q < 4; ++q) { const f32x4 a = *(const f32x4*)(src + 4 * q) * sc; int w = __builtin_amdgcn_cvt_pk_fp8_f32(a.x, a.y, 0, false); w = __builtin_amdgcn_cvt_pk_fp8_f32(a.z, a.w, w, true); o[q] = (unsigned)w; }
                if (!dry) *(u32x4*)dst = o; else KEEP4(o);
            } else {
                const size_t j = i - 2 * NU; const float* src = p.peer_keys + j * 16; bf16_t* dst = (bf16_t*)(ws + WS_KEYS) + j * 16;
#pragma unroll
                for (int hh = 0; hh < 2; ++hh) { const f32x4 a = *(const f32x4*)(src + 8 * hh), b = *(const f32x4*)(src + 8 * hh + 4);
                    u32x4 o; o.x = pk2(a.x, a.y); o.y = pk2(a.z, a.w); o.z = pk2(b.x, b.y); o.w = pk2(b.z, b.w); if (!dry) *(u32x4*)(dst + 8 * hh) = o; else KEEP4(o); }
            }
        }
    }
}
__device__ __forceinline__ void phase_prep(const Params& p, LAS unsigned char* lds, int bid, int nblk, bool dry) {
    const int tid = threadIdx.x, lane = tid & 63, wid = tid >> 6;
    const int gw = bid * NWAVE + wid, NGW = nblk * NWAVE;
    unsigned char* ws = p.ws;
    LAS float* scr = (LAS float*)(lds + wid * 16384);
    constexpr int I_IN = (D / 64) * (NPAD / 32), I_A = (512 / 64) * (D / 32), I_B = (D / 64) * (D / 32), I_W2 = 1 * (512 / 32), I_G2 = 2 * (512 / 32);
    constexpr int NIT = I_IN + I_A + 3 * I_B + 2 * I_W2 + I_G2;
    for (int it = gw; it < NIT; it += NGW) {
        int r = it;
        if (r < I_IN) { transpose_item<true>(p.w_in, D, IN_COLS, (bf16_t*)(ws + WS_WIN), scr, r, lane, NPAD, dry); continue; } r -= I_IN;
        if (r < I_A) { transpose_item<false>(p.w_br_a, 512, D, (bf16_t*)(ws + WS_WA), scr, r, lane, D, dry); continue; } r -= I_A;
        if (r < I_B) { transpose_item<false>(p.w_br_b, D, D, (bf16_t*)(ws + WS_WB), scr, r, lane, D, dry); continue; } r -= I_B;
        if (r < I_B) { transpose_item<false>(p.w_out, D, D, (bf16_t*)(ws + WS_WO), scr, r, lane, D, dry); continue; } r -= I_B;
        if (r < I_B) { transpose_item<false>(p.peer_wq, D, D, (bf16_t*)(ws + WS_WPQ), scr, r, lane, D, dry); continue; } r -= I_B;
        if (r < I_W2) { transpose_item<false>(p.rw_w2, 64, 512, (bf16_t*)(ws + WS_W2T), scr, r, lane, 512, dry); continue; } r -= I_W2;
        if (r < I_W2) { transpose_item<false>(p.rw_a2, 64, 512, (bf16_t*)(ws + WS_A2T), scr, r, lane, 512, dry); continue; } r -= I_W2;
        transpose_item<false>(p.rw_g2, 128, 512, (bf16_t*)(ws + WS_G2T), scr, r, lane, 512, dry);
    }
    {
        float* modp = (float*)(ws + WS_MODP); LAS float* SV = (LAS float*)lds;
        __syncthreads();
        for (int i = tid; i < 8 * D; i += NTHR) { const int b = i >> 10, k = i & 1023; const float cv = p.c[i]; SV[k * 8 + b] = cv * __builtin_amdgcn_rcpf(1.f + __expf(-cv)); }
        __syncthreads();
        for (int it = gw; it < 64 * 24; it += NGW) {
            const int kb = it / 24, jb = it % 24;
            f32x4 w[16];
#pragma unroll
            for (int i = 0; i < 16; ++i) w[i] = *(const f32x4*)(p.w_ada + (size_t)(kb * 16 + i) * 6144 + jb * 256 + 4 * lane);
            f32x4 acc[8];
#pragma unroll
            for (int b = 0; b < 8; ++b) acc[b] = (f32x4){0.f, 0.f, 0.f, 0.f};
#pragma unroll
            for (int i = 0; i < 16; ++i) { const f32x4 s0 = *(const LAS f32x4*)(SV + (kb * 16 + i) * 8), s1 = *(const LAS f32x4*)(SV + (kb * 16 + i) * 8 + 4);
                acc[0] += w[i] * s0.x; acc[1] += w[i] * s0.y; acc[2] += w[i] * s0.z; acc[3] += w[i] * s0.w; acc[4] += w[i] * s1.x; acc[5] += w[i] * s1.y; acc[6] += w[i] * s1.z; acc[7] += w[i] * s1.w; }
#pragma unroll
            for (int b = 0; b < 8; ++b) if (!dry) *(f32x4*)(modp + ((size_t)kb * 8 + b) * 6144 + jb * 256 + 4 * lane) = acc[b];
        }
    }
}
__device__ __forceinline__ void phase_modsum(const Params& p, int bid, int nblk) {
    const float* modp = (const float*)(p.ws + WS_MODP); float* mod = (float*)(p.ws + WS_MOD);
    for (int i = bid * NTHR + threadIdx.x; i < 8 * 6144; i += nblk * NTHR) {
        const int b = i / 6144, j = i % 6144; float s = p.b_ada[j];
#pragma unroll
        for (int kb = 0; kb < 64; ++kb) s += modp[((size_t)kb * 8 + b) * 6144 + j];
        mod[i] = s;
    }
}
__device__ __forceinline__ void phase_h1(const Params& p, int bid, int nblk) {
    const int lane = threadIdx.x & 63, wid = threadIdx.x >> 6;
    const float* mod = (const float*)(p.ws + WS_MOD); bf16_t* h1 = (bf16_t*)(p.ws + WS_H1);
    for (int m = bid * NWAVE + wid; m < T; m += nblk * NWAVE) {
        const int b = m / S; const float* sh = mod + b * 6144, *sc = sh + 1024;
#pragma unroll
        for (int j = 0; j < 4; ++j) { const int c0 = 4 * lane + 256 * j;
            const f32x4 xv = *(const f32x4*)(p.x + (size_t)m * D + c0), s1 = *(const f32x4*)(sc + c0), s0 = *(const f32x4*)(sh + c0);
            st_bf16x4(h1 + (size_t)m * D + c0, xv * (1.f + s1) + s0); }
    }
}

namespace pg8 {
#define PG8_LAS __attribute__((address_space(3)))
typedef unsigned short bf16_t;
typedef short bf16x8 __attribute__((ext_vector_type(8)));
typedef float f32x4 __attribute__((ext_vector_type(4)));
typedef unsigned u32x4 __attribute__((ext_vector_type(4)));
constexpr int BM = 256, BK = 64, HALF = 128, HTB = HALF * BK * 2  , STAGE_BYTES = 8 * HTB, NXCD = 8, WGM = 8;

__host__ __device__ __forceinline__ int lds_byte(int r, int c) { const int st = (r >> 4) * 2 + (c >> 5), rr = r & 15, cc = c & 31, ob = rr * 64 + cc * 2; return st * 1024 + (ob ^ (((ob >> 9) & 1) << 5)); }
__host__ __device__ __forceinline__ void stage_rc(int b, int& R, int& C) { const int st = b / 1024, sb = b % 1024, swz = sb ^ (((sb >> 9) & 1) << 5); R = (st >> 1) * 16 + swz / 64; C = (st & 1) * 32 + (swz % 64) / 2; }
__host__ __device__ __forceinline__ int perm32(int rho) { const int n = rho >> 4, i = rho & 15; return 8 * (i >> 2) + 4 * n + (i & 3); }

struct Unit { int pm, pn; };
struct Gemm { const bf16_t* A; const bf16_t* Bt; int M, N, K; };

struct StaticOrder {
    int nM, nN, nwg, G, c;
    __host__ __device__ void init(int M, int N, int G_, int c_) { nM = M / BM; nN = N / BM; nwg = nM * nN; G = G_; c = c_; }
    __host__ __device__ bool next(int i, Unit& u) const {
        const long L = (long)i * G + c; if (L >= nwg) return false;
        int wgid = (int)L; { const int q = nwg / NXCD, r = nwg % NXCD, xcd = wgid % NXCD, off = wgid / NXCD; wgid = (xcd < r ? xcd * (q + 1) : r * (q + 1) + (xcd - r) * q) + off; }
        const int nig = WGM * nN, gid = wgid / nig, fm = gid * WGM, gsz = (nM - fm) < WGM ? (nM - fm) : WGM;
        u.pm = fm + ((wgid % nig) % gsz); u.pn = (wgid % nig) / gsz; return true;
    }
    __device__ __forceinline__ void a_ready(const Unit&) const {}
    __device__ __forceinline__ void done(const Unit&) const {}
};

__device__ __forceinline__ unsigned cvt_pk_bf16(float lo, float hi) { unsigned r; asm volatile("s_nop 0\n\tv_cvt_pk_bf16_f32 %0, %1, %2" : "=v"(r) : "v"(lo), "v"(hi)); return r; }
template <class Epi, class Sched, bool ALIGN_EPI = false, bool SP2 = false>
__device__ __forceinline__ void gemm_phase(PG8_LAS unsigned char* lds, const Gemm g, const Sched& S, const Epi& E) {
    const int tid = threadIdx.x, wid = __builtin_amdgcn_readfirstlane(tid >> 6), lane = tid & 63, wr = wid >> 2, wc = wid & 3, fr = lane & 15, fq = lane >> 4;
    const int K = g.K, nt = K / BK;
    unsigned voffA[2], voffB[2];
#pragma unroll
    for (int i = 0; i < 2; ++i) { int R, C; stage_rc(tid * 16 + i * 8192, R, C); const int Rb = Epi::PERM ? ((R & ~31) + perm32(R & 31)) : R;
        voffA[i] = (unsigned)(R * K + C) * 2u; voffB[i] = (unsigned)(Rb * K + C) * 2u; }
    const size_t kstep = (size_t)(BK * 2);
    const size_t hstep = (size_t)HALF * K * 2;
    const size_t tstep = 2 * hstep;
    const unsigned ldsw = (unsigned)wid * 1024u;
    const int aoff = lds_byte(wr * 64 + fr, fq * 8), boff = lds_byte(wc * 32 + fr, fq * 8);
#define PG8_SA(b, h) (((b) * 2 + (h)) * HTB)
#define PG8_SB(b, h) ((4 + (b) * 2 + (h)) * HTB)
#define PG8_STAGE(bufoff, gbase, voff) do { _Pragma("unroll") for (int _i = 0; _i < 2; ++_i) \
        __builtin_amdgcn_global_load_lds((const unsigned*)((const char*)(gbase) + (voff)[_i]), (PG8_LAS unsigned*)(lds + (bufoff) + ldsw + _i * 8192), 16, 0, 0); } while (0)
#define PG8_LDA(dst, b, h) do { _Pragma("unroll") for (int m = 0; m < 4; ++m) _Pragma("unroll") for (int k = 0; k < 2; ++k) dst[m][k] = *(const PG8_LAS bf16x8*)(lds + PG8_SA(b, h) + aoff + m * 2048 + k * 1024); } while (0)
#define PG8_LDB(dst, b, h) do { _Pragma("unroll") for (int n = 0; n < 2; ++n) _Pragma("unroll") for (int k = 0; k < 2; ++k) dst[n][k] = *(const PG8_LAS bf16x8*)(lds + PG8_SB(b, h) + boff + n * 2048 + k * 1024); } while (0)
#define PG8_MMA(ai, bj, At, Bt) do { __builtin_amdgcn_s_setprio(1); _Pragma("unroll") for (int m = 0; m < 4; ++m) _Pragma("unroll") for (int n = 0; n < 2; ++n) _Pragma("unroll") for (int k = 0; k < 2; ++k) \
        acc[ai][bj][m][n] = __builtin_amdgcn_mfma_f32_16x16x32_bf16(Bt[n][k], At[m][k], acc[ai][bj][m][n], 0, 0, 0); __builtin_amdgcn_s_setprio(0); } while (0)
#define PG8_WAIT_V(n) asm volatile("s_waitcnt vmcnt(" #n ")" ::: "memory")
#define PG8_WAIT_L(n) asm volatile("s_waitcnt lgkmcnt(" #n ")" ::: "memory")
#define PG8_BAR __builtin_amdgcn_s_barrier()
#define PG8_SCHED __builtin_amdgcn_sched_barrier(0)
    Unit cur, nxt; int ui = 0;
    if (!S.next(0, cur)) return;
    f32x4 acc[2][2][4][2];
#pragma unroll
    for (int a = 0; a < 2; ++a)
#pragma unroll
        for (int b = 0; b < 2; ++b)
#pragma unroll
            for (int m = 0; m < 4; ++m)
#pragma unroll
                for (int n = 0; n < 2; ++n) acc[a][b][m][n] = (f32x4){0.f, 0.f, 0.f, 0.f};
    bf16x8 At[4][2], B0[2][2], B1[2][2];
    const char* cA = (const char*)g.A + (size_t)cur.pm * tstep; const char* cB = (const char*)g.Bt + (size_t)cur.pn * tstep;
    S.a_ready(cur);
    if constexpr (SP2) {
        PG8_STAGE(PG8_SB(0, 0), cB, voffB); PG8_STAGE(PG8_SB(0, 1), cB + hstep, voffB); PG8_STAGE(PG8_SA(0, 0), cA, voffA); PG8_STAGE(PG8_SA(0, 1), cA + hstep, voffA);
        if (wr == 1) PG8_BAR;
        PG8_WAIT_V(2); PG8_BAR;
        PG8_STAGE(PG8_SB(1, 0), cB + kstep, voffB); PG8_STAGE(PG8_SA(1, 0), cA + kstep, voffA); PG8_STAGE(PG8_SB(1, 1), cB + hstep + kstep, voffB);
        PG8_WAIT_V(6); PG8_BAR;
    } else {
        PG8_STAGE(PG8_SB(0, 0), cB, voffB); PG8_STAGE(PG8_SA(0, 0), cA, voffA); PG8_STAGE(PG8_SB(0, 1), cB + hstep, voffB); PG8_STAGE(PG8_SA(0, 1), cA + hstep, voffA);
        if (wr == 1) PG8_BAR;
        PG8_WAIT_V(4); PG8_BAR;
        PG8_STAGE(PG8_SB(1, 0), cB + kstep, voffB); PG8_STAGE(PG8_SA(1, 0), cA + kstep, voffA); PG8_STAGE(PG8_SB(1, 1), cB + hstep + kstep, voffB);
        PG8_WAIT_V(6); PG8_BAR;
    }
    for (;;) {
        const bool has_next = S.next(ui + 1, nxt);
        const char* nA = has_next ? (const char*)g.A + (size_t)nxt.pm * tstep : cA; const char* nB = has_next ? (const char*)g.Bt + (size_t)nxt.pn * tstep : cB;
        for (int t = 0; t < nt; t += 2) {
            const bool last = (t == nt - 2);
            const char* a1 = cA + (size_t)(t + 1) * kstep;
            const char* a2 = last ? nA : cA + (size_t)(t + 2) * kstep; const char* b2 = last ? nB : cB + (size_t)(t + 2) * kstep;
            const char* a3 = a2 + kstep; const char* b3 = b2 + kstep;
            if (last && has_next) S.a_ready(nxt);
            if constexpr (SP2) {
            PG8_LDB(B0, 0, 0); PG8_LDB(B1, 0, 1); PG8_SCHED; PG8_LDA(At, 0, 0); PG8_STAGE(PG8_SA(1, 1), a1 + hstep, voffA);
            PG8_WAIT_V(8); PG8_WAIT_L(0); PG8_BAR; PG8_MMA(0, 0, At, B0); PG8_MMA(0, 1, At, B1); PG8_BAR; PG8_SCHED;
            PG8_LDA(At, 0, 1); PG8_STAGE(PG8_SB(0, 0), b2, voffB); PG8_STAGE(PG8_SB(0, 1), b2 + hstep, voffB); PG8_STAGE(PG8_SA(0, 0), a2, voffA);
            PG8_WAIT_V(8); PG8_WAIT_L(0); PG8_BAR; PG8_MMA(1, 0, At, B0); PG8_MMA(1, 1, At, B1); PG8_BAR; PG8_SCHED;
            PG8_LDB(B0, 1, 0); PG8_LDB(B1, 1, 1); PG8_SCHED; PG8_LDA(At, 1, 0); PG8_STAGE(PG8_SA(0, 1), a2 + hstep, voffA);
            PG8_WAIT_V(8); PG8_WAIT_L(0); PG8_BAR; PG8_MMA(0, 0, At, B0); PG8_MMA(0, 1, At, B1); PG8_BAR; PG8_SCHED;
            PG8_LDA(At, 1, 1); PG8_STAGE(PG8_SB(1, 0), b3, voffB); PG8_STAGE(PG8_SB(1, 1), b3 + hstep, voffB); PG8_STAGE(PG8_SA(1, 0), a3, voffA);
            PG8_WAIT_V(8); PG8_WAIT_L(0); PG8_BAR; PG8_MMA(1, 0, At, B0); PG8_MMA(1, 1, At, B1); PG8_BAR; PG8_SCHED;
            } else {
            PG8_LDB(B0, 0, 0); PG8_SCHED; PG8_LDA(At, 0, 0); PG8_STAGE(PG8_SA(1, 1), a1 + hstep, voffA);
            PG8_WAIT_L(8); PG8_BAR; PG8_WAIT_L(0); PG8_MMA(0, 0, At, B0); PG8_BAR; PG8_SCHED;
            PG8_LDB(B1, 0, 1); PG8_STAGE(PG8_SB(0, 0), b2, voffB);
            PG8_BAR; PG8_WAIT_L(0); PG8_MMA(0, 1, At, B1); PG8_BAR;
            PG8_LDA(At, 0, 1); PG8_STAGE(PG8_SA(0, 0), a2, voffA);
            PG8_BAR; PG8_WAIT_L(0); PG8_MMA(1, 0, At, B0); PG8_BAR; PG8_SCHED;
            PG8_STAGE(PG8_SB(0, 1), b2 + hstep, voffB);
            PG8_WAIT_V(6); PG8_BAR; PG8_MMA(1, 1, At, B1); PG8_BAR;
            PG8_LDB(B0, 1, 0); PG8_SCHED; PG8_LDA(At, 1, 0); PG8_STAGE(PG8_SA(0, 1), a2 + hstep, voffA);
            PG8_WAIT_L(8); PG8_BAR; PG8_WAIT_L(0); PG8_MMA(0, 0, At, B0); PG8_BAR; PG8_SCHED;
            PG8_LDB(B1, 1, 1); PG8_STAGE(PG8_SB(1, 0), b3, voffB);
            PG8_BAR; PG8_WAIT_L(0); PG8_MMA(0, 1, At, B1); PG8_BAR;
            PG8_LDA(At, 1, 1); PG8_STAGE(PG8_SA(1, 0), a3, voffA);
            PG8_BAR; PG8_WAIT_L(0); PG8_MMA(1, 0, At, B0); PG8_BAR; PG8_SCHED;
            PG8_STAGE(PG8_SB(1, 1), b3 + hstep, voffB);
            PG8_WAIT_V(6); PG8_BAR; PG8_MMA(1, 1, At, B1); PG8_BAR;
            }
        }
        if constexpr (ALIGN_EPI) { if (wr == 0) PG8_BAR; }
        if constexpr (!Epi::AFTER_DRAIN) { E(acc, cur, wr, wc, fr, fq); S.done(cur); }
        if (!has_next) break;
#pragma unroll
        for (int a = 0; a < 2; ++a)
#pragma unroll
            for (int b = 0; b < 2; ++b)
#pragma unroll
                for (int m = 0; m < 4; ++m)
#pragma unroll
                    for (int n = 0; n < 2; ++n) acc[a][b][m][n] = (f32x4){0.f, 0.f, 0.f, 0.f};
        cur = nxt; cA = nA; cB = nB; ++ui;
        if constexpr (ALIGN_EPI) { if (wr == 1) PG8_BAR; }
    }
    PG8_WAIT_V(0);
    if constexpr (!ALIGN_EPI) { if (wr == 0) PG8_BAR; }
    PG8_BAR;
    if constexpr (Epi::AFTER_DRAIN) { E.fused(acc, cur, wr, wc, fr, fq, lds, wid, lane); S.done(cur); }
#undef PG8_SA
#undef PG8_SB
#undef PG8_STAGE
#undef PG8_LDA
#undef PG8_LDB
#undef PG8_MMA
#undef PG8_WAIT_V
#undef PG8_WAIT_L
#undef PG8_BAR
#undef PG8_SCHED
}

template <class F> struct EpiRow8 {
    static constexpr bool PERM = true, AFTER_DRAIN = false; F f;
    __device__ __forceinline__ void operator()(const f32x4 (&acc)[2][2][4][2], const Unit& u, int wr, int wc, int fr, int fq) const {
        const int row0 = u.pm * BM + wr * 64 + fr, col0 = u.pn * BM + wc * 32 + 8 * fq;
        asm volatile("s_nop 7\n\ts_nop 7" ::: "memory"); __builtin_amdgcn_sched_barrier(0);
#pragma unroll
        for (int ai = 0; ai < 2; ++ai)
#pragma unroll
            for (int m = 0; m < 4; ++m)
#pragma unroll
                for (int bj = 0; bj < 2; ++bj) f(row0 + ai * HALF + m * 16, col0 + bj * HALF, acc[ai][bj][m][0], acc[ai][bj][m][1]);
    }
};
}
__device__ __forceinline__ u32x4 pk8(f32x4 a, f32x4 b) { u32x4 w; w.x = pg8::cvt_pk_bf16(a.x, a.y); w.y = pg8::cvt_pk_bf16(a.z, a.w); w.z = pg8::cvt_pk_bf16(b.x, b.y); w.w = pg8::cvt_pk_bf16(b.z, b.w); return w; }
__device__ __forceinline__ f32x4 sig4(f32x4 v) { f32x4 s; s.x = sigmoidf_(v.x); s.y = sigmoidf_(v.y); s.z = sigmoidf_(v.z); s.w = sigmoidf_(v.w); return s; }
#define F_DRY if (dry) { KEEP4(v0); KEEP4(v1); return; }
struct FInproj { bf16_t *zrkv, *zlora, *zq, *zmisc, *qidx, *ga, *gb; int dry;
    __device__ __forceinline__ void operator()(int row, int col, f32x4 v0, f32x4 v1) const { F_DRY
        if (col < 1536) *(u32x4*)(zrkv + (size_t)row * 1536 + col) = pk8(v0, v1);
        else if (col < 1792) *(u32x4*)(zlora + (size_t)row * 256 + (col - 1536)) = pk8(v0, v1);
        else if (col < 2816) *(u32x4*)(zq + (size_t)row * 1024 + (col - 1792)) = pk8(v0 * 0.12751743082459868f, v1 * 0.12751743082459868f);
        else if (col < 3072) *(u32x4*)(zmisc + (size_t)row * 256 + (col - 2816)) = pk8(v0, v1);
        else if (col < 3328) *(u32x4*)(qidx + (size_t)row * 256 + (col - 3072)) = pk8(v0, v1);
        else if (col < 4352) *(u32x4*)(ga + (size_t)row * 1024 + (col - 3328)) = pk8(sig4(v0), sig4(v1));
        else *(u32x4*)(gb + (size_t)row * 1024 + (col - 4352)) = pk8(sig4(v0), sig4(v1)); } };
struct FBrA { bf16_t* ga; int dry;
    __device__ __forceinline__ void operator()(int row, int col, f32x4 v0, f32x4 v1) const { F_DRY bf16_t* q = ga + (size_t)row * 1024 + col; f32x4 a, b; ld_bf16x8(q, a, b); *(u32x4*)q = pk8(a * v0, b * v1); } };
struct FBrB { bf16_t* m1; const bf16_t* gb; int dry;
    __device__ __forceinline__ void operator()(int row, int col, f32x4 v0, f32x4 v1) const { F_DRY const size_t o = (size_t)row * 1024 + col; f32x4 a, b, c, d; ld_bf16x8(m1 + o, a, b); ld_bf16x8(gb + o, c, d); *(u32x4*)(m1 + o) = pk8(a * v0 + c, b * v1 + d); } };
struct FOut { const float* x; const float* mod; float* out; int dry;
    __device__ __forceinline__ void operator()(int row, int col, f32x4 v0, f32x4 v1) const { F_DRY const size_t o = (size_t)row * D + col; const float* gt = mod + (row / S) * 6144 + 2048 + col;
        *(f32x4*)(out + o) = *(const f32x4*)(x + o) * DN_ALPHA + *(const f32x4*)gt * v0; *(f32x4*)(out + o + 4) = *(const f32x4*)(x + o + 4) * DN_ALPHA + *(const f32x4*)(gt + 4) * v1; } };
struct FPq { bf16_t* pq; int dry;
    __device__ __forceinline__ void operator()(int row, int col, f32x4 v0, f32x4 v1) const { F_DRY *(u32x4*)(pq + (size_t)row * D + col) = pk8(v0, v1); } };
__device__ __forceinline__ void dsa_norm_rows(const Params& p, int bid, int nblk, bool dry) {
    const int lane = threadIdx.x & 63, wid = threadIdx.x >> 6;
    const bf16_t* zmisc = (const bf16_t*)(p.ws + WS_ZMISC); bf16_t* ckv = (bf16_t*)(p.ws + WS_CKV); bf16_t* kidx = (bf16_t*)(p.ws + WS_KIDX); float* widx = (float*)(p.ws + WS_WIDX);
    for (int row = bid * NWAVE + wid; row < T; row += nblk * NWAVE) {
        const f32x4 v = ld_bf16x4(zmisc + (size_t)row * 256 + 4 * lane);
        float ss = (lane < 32) ? (v.x * v.x + v.y * v.y + v.z * v.z + v.w * v.w) : 0.f;
        ss = wave_sum(ss);
        const float rs = rsqrtf(ss * (1.f / 128.f) + LN_EPS);
        const bool isk = (lane >= 32 && lane < 48);
        float s1 = isk ? (v.x + v.y + v.z + v.w) : 0.f;
        s1 = wave_sum(s1);
        const float mean = s1 * (1.f / 64.f);
        const f32x4 d = v - mean;
        float s2 = isk ? (d.x * d.x + d.y * d.y + d.z * d.z + d.w * d.w) : 0.f;
        s2 = wave_sum(s2);
        const float rstd = rsqrtf(s2 * (1.f / 64.f) + LN_EPS);
        if (dry) { KEEP1(rs); KEEP1(rstd); continue; }
        if (lane < 32) { const f32x4 g = *(const f32x4*)(p.dsa_kv_g + 4 * lane); st_bf16x4(ckv + (size_t)row * 128 + 4 * lane, v * rs * g); }
        else if (isk) { const int c = 4 * (lane - 32); const f32x4 g = *(const f32x4*)(p.idx_k_g + c), b = *(const f32x4*)(p.idx_k_b + c); st_bf16x4(kidx + (size_t)row * 64 + c, d * rstd * g + b); }
        else if (lane == 48) { *(f32x4*)(widx + (size_t)row * 4) = v * (0.5f * 0.125f); }
    }
}

constexpr int RL_R = 0, RL_W = 16384, RL_KP = 32768, RL_KK = 49152, RL_BV = 65536, RL_V = 81920, RL_Y = 98304, RL_SG = 98304, RL_G = 114688, RL_TW = 122880, RL_AL = 131072, RL_RK = 139264;
template <int KD, bool OUT_BF16>
__device__ __forceinline__ void lora_mm(const LAS bf16_t* A, const bf16_t* Bt, LAS unsigned char* dst, int wid, int lane) {
    const int mi = wid >> 1;
#pragma unroll
    for (int nn = 0; nn < 2; ++nn) {
        const int ni = 2 * (wid & 1) + nn;
        f32x4 acc = (f32x4){0.f, 0.f, 0.f, 0.f};
#pragma unroll
        for (int ks = 0; ks < KD / 32; ++ks) {
            const bf16x8 a = *(const LAS bf16x8*)(A + (16 * mi + (lane & 15)) * KD + 32 * ks + 8 * (lane >> 4));
            const bf16x8 b = *(const bf16x8*)(Bt + (size_t)(16 * ni + (lane & 15)) * KD + 32 * ks + 8 * (lane >> 4));
            acc = __builtin_amdgcn_mfma_f32_16x16x32_bf16(a, b, acc, 0, 0, 0);
        }
#pragma unroll
        for (int r = 0; r < 4; ++r) {
            const int row = 16 * mi + (lane >> 4) * 4 + r, col = 16 * ni + (lane & 15);
            if (OUT_BF16) ((LAS bf16_t*)dst)[row * 64 + col] = (bf16_t)f2bf(acc[r]);
            else ((LAS float*)dst)[row * 64 + col] = acc[r];
        }
    }
}
template <int KD> __device__ __forceinline__ void lora_ldb(bf16x8 (&bfr)[2][KD / 32], const bf16_t* Bt, int wid, int lane) {
#pragma unroll
    for (int nn = 0; nn < 2; ++nn)
#pragma unroll
        for (int ks = 0; ks < KD / 32; ++ks) bfr[nn][ks] = *(const bf16x8*)(Bt + (size_t)(16 * (2 * (wid & 1) + nn) + (lane & 15)) * KD + 32 * ks + 8 * (lane >> 4));
}
template <int KD, bool OUT_BF16> __device__ __forceinline__ void lora_mm2(const LAS bf16_t* A, const bf16x8 (&bfr)[2][KD / 32], LAS unsigned char* dst, int wid, int lane) {
    const int mi = wid >> 1;
#pragma unroll
    for (int nn = 0; nn < 2; ++nn) {
        const int ni = 2 * (wid & 1) + nn;
        f32x4 acc = (f32x4){0.f, 0.f, 0.f, 0.f};
#pragma unroll
        for (int ks = 0; ks < KD / 32; ++ks) acc = __builtin_amdgcn_mfma_f32_16x16x32_bf16(*(const LAS bf16x8*)(A + (16 * mi + (lane & 15)) * KD + 32 * ks + 8 * (lane >> 4)), bfr[nn][ks], acc, 0, 0, 0);
#pragma unroll
        for (int r = 0; r < 4; ++r) { const int row = 16 * mi + (lane >> 4) * 4 + r, col = 16 * ni + (lane & 15);
            if (OUT_BF16) ((LAS bf16_t*)dst)[row * 64 + col] = (bf16_t)f2bf(acc[r]); else ((LAS float*)dst)[row * 64 + col] = acc[r]; }
    }
}
__device__ __forceinline__ f32x4 mix4(f32x4 z, f32x4 zp, f32x4 mu) { return z + (zp - z) * mu; }

constexpr size_t PREP_STRIDE = (size_t)T * 512;
constexpr size_t WS_RKG = 501 * MiB;
#define SIDX(row, col) ((row) * 64 + (((((col) >> 3) ^ ((row) & 7)) << 3) | ((col) & 7)))
__device__ __forceinline__ void mm64(f32x4 (&acc)[2], const LAS bf16_t* A, const LAS bf16_t* Bt, int wid, int lane) {
    const int mi = wid >> 1, l15 = lane & 15, g = lane >> 4;
#pragma unroll
    for (int nn = 0; nn < 2; ++nn) { const int ni = 2 * (wid & 1) + nn;
#pragma unroll
        for (int ks = 0; ks < 2; ++ks) acc[nn] = __builtin_amdgcn_mfma_f32_16x16x32_bf16(*(const LAS bf16x8*)(A + (16 * mi + l15) * 64 + (((4 * ks + g) ^ (l15 & 7)) << 3)), *(const LAS bf16x8*)(Bt + (16 * ni + l15) * 64 + (((4 * ks + g) ^ (l15 & 7)) << 3)), acc[nn], 0, 0, 0); }
}
#define MMT(acc, A, Bt) mm64(acc, Bt, A, wid, lane)
#define MM4_EACH(acc, BODY) do { _Pragma("unroll") for (int nn_ = 0; nn_ < 2; ++nn_) { const int i = 16 * (2 * (wid & 1) + nn_) + (lane & 15), j0 = 16 * (wid >> 1) + 4 * (lane >> 4); f32x4 v4 = acc[nn_]; \
        asm volatile("s_nop 7\n\ts_nop 4" : "+v"(v4.x), "+v"(v4.y), "+v"(v4.z), "+v"(v4.w)); BODY acc[nn_] = v4; } } while (0)
#define ST4S(slot, ii, jj, v) do { u32x2 w_; w_.x = pk2h((v).x, (v).y); w_.y = pk2h((v).z, (v).w); *(LAS u32x2*)(SLOT(slot) + SIDX(ii, jj)) = w_; } while (0)
__device__ __forceinline__ f32x4 ld4s(const LAS bf16_t* q) { const u32x2 w = *(const LAS u32x2*)q; return (f32x4){bflo(w.x), bfhi(w.x), bflo(w.y), bfhi(w.y)}; }
#define MM_ZERO(acc) do { acc[0] = (f32x4){0.f, 0.f, 0.f, 0.f}; acc[1] = acc[0]; } while (0)
#define MM_EACH(acc, BODY) do { _Pragma("unroll") for (int nn_ = 0; nn_ < 2; ++nn_) _Pragma("unroll") for (int r_ = 0; r_ < 4; ++r_) { \
        const int row = 16 * (wid >> 1) + 4 * (lane >> 4) + r_, col = 16 * (2 * (wid & 1) + nn_) + (lane & 15); float val = acc[nn_][r_]; BODY acc[nn_][r_] = val; } } while (0)
#define SLOT(i) ((LAS bf16_t*)(lds + (i) * 8192))
__device__ __forceinline__ void rwkv_chunk_unit(const Params& p, LAS unsigned char* lds, int tile, int h, bool dry) {
    const int tid = threadIdx.x, lane = tid & 63, wid = tid >> 6;
    const bf16_t* zrkv = (const bf16_t*)(p.ws + WS_ZRKV); const bf16_t* zlora = (const bf16_t*)(p.ws + WS_ZLORA);
    bf16_t* pre = (bf16_t*)p.out; bf16_t* gout = (bf16_t*)(p.ws + WS_RG); float* rkg = (float*)(p.ws + WS_RKG);
    const bf16_t* w2t = (const bf16_t*)(p.ws + WS_W2T) + (size_t)h * 64 * 64;
    const bf16_t* a2t = (const bf16_t*)(p.ws + WS_A2T) + (size_t)h * 64 * 64;
    const bf16_t* g2t = (const bf16_t*)(p.ws + WS_G2T) + (size_t)h * 64 * 128;
    LAS float* W = (LAS float*)(lds + RL_W); LAS float* KP = (LAS float*)(lds + RL_KP); LAS float* BV = (LAS float*)(lds + RL_BV);
    LAS bf16_t* SG = (LAS bf16_t*)(lds + RL_SG); LAS bf16_t* G = (LAS bf16_t*)(lds + RL_G); LAS bf16_t* TW = (LAS bf16_t*)(lds + RL_TW); LAS bf16_t* AL = (LAS bf16_t*)(lds + RL_AL);
    const int pt = tid >> 3, pc = (tid & 7) * 8, hc = h * 64 + pc;
    const size_t row = (size_t)tile * 64 + pt; const bool hasp = (row % S) > 0;
    f32x4 rm0, rm1, vm0, vm1;
    bf16x8 bw2[2][2], ba2[2][2];
    lora_ldb<64>(bw2, w2t, wid, lane); lora_ldb<64>(ba2, a2t, wid, lane);
    const f32x4 pw0a = *(const f32x4*)(p.rw_w0 + hc), pw0b = *(const f32x4*)(p.rw_w0 + hc + 4), pa0a = *(const f32x4*)(p.rw_a0 + hc), pa0b = *(const f32x4*)(p.rw_a0 + hc + 4);
    const f32x4 pkka = *(const f32x4*)(p.rw_k_k + hc), pkkb = *(const f32x4*)(p.rw_k_k + hc + 4), pkaa = *(const f32x4*)(p.rw_k_a + hc), pkab = *(const f32x4*)(p.rw_k_a + hc + 4);
    const f32x4 prka = *(const f32x4*)(p.rw_r_k + hc), prkb = *(const f32x4*)(p.rw_r_k + hc + 4);
    {
        const bf16_t* zr = zrkv + row * 1536; const bf16_t* zl = zlora + row * 256;
        f32x4 c0, c1, p0, p1, m0, m1; const f32x4 zero = (f32x4){0.f, 0.f, 0.f, 0.f};
        ld_bf16x8(zr + hc, c0, c1); if (hasp) ld_bf16x8(zr - 1536 + hc, p0, p1); else { p0 = zero; p1 = zero; }
        m0 = *(const f32x4*)(p.rw_mu + hc); m1 = *(const f32x4*)(p.rw_mu + hc + 4); rm0 = mix4(c0, p0, m0); rm1 = mix4(c1, p1, m1);
        ld_bf16x8(zr + 1024 + hc, c0, c1); if (hasp) ld_bf16x8(zr - 1536 + 1024 + hc, p0, p1); else { p0 = zero; p1 = zero; }
        m0 = *(const f32x4*)(p.rw_mu + 1024 + hc); m1 = *(const f32x4*)(p.rw_mu + 1024 + hc + 4); vm0 = mix4(c0, p0, m0); vm1 = mix4(c1, p1, m1);
        ld_bf16x8(zr + 512 + hc, c0, c1); if (hasp) ld_bf16x8(zr - 1536 + 512 + hc, p0, p1); else { p0 = zero; p1 = zero; }
        m0 = *(const f32x4*)(p.rw_mu + 512 + hc); m1 = *(const f32x4*)(p.rw_mu + 512 + hc + 4);
        *(LAS f32x4*)(KP + pt * 64 + pc) = mix4(c0, p0, m0); *(LAS f32x4*)(KP + pt * 64 + pc + 4) = mix4(c1, p1, m1);
        ld_bf16x8(zl + pc, c0, c1); if (hasp) ld_bf16x8(zl - 256 + pc, p0, p1); else { p0 = zero; p1 = zero; }
        m0 = *(const f32x4*)(p.rw_mu + 1536 + pc); m1 = *(const f32x4*)(p.rw_mu + 1536 + pc + 4);
        { const f32x4 a = mix4(c0, p0, m0), bb = mix4(c1, p1, m1); u32x4 o; o.x = pk2h(tanh_fast(a.x), tanh_fast(a.y)); o.y = pk2h(tanh_fast(a.z), tanh_fast(a.w)); o.z = pk2h(tanh_fast(bb.x), tanh_fast(bb.y)); o.w = pk2h(tanh_fast(bb.z), tanh_fast(bb.w));
          *(LAS u32x4*)(TW + pt * 64 + pc) = o; }
        ld_bf16x8(zl + 64 + pc, c0, c1); if (hasp) ld_bf16x8(zl - 256 + 64 + pc, p0, p1); else { p0 = zero; p1 = zero; }
        m0 = *(const f32x4*)(p.rw_mu + 1600 + pc); m1 = *(const f32x4*)(p.rw_mu + 1600 + pc + 4);
        { const f32x4 a = mix4(c0, p0, m0), bb = mix4(c1, p1, m1); u32x4 o; o.x = pk2h(a.x, a.y); o.y = pk2h(a.z, a.w); o.z = pk2h(bb.x, bb.y); o.w = pk2h(bb.z, bb.w);
          *(LAS u32x4*)(AL + pt * 64 + pc) = o; }
#pragma unroll
        for (int hh = 0; hh < 2; ++hh) {
            const int gc = 2 * pc + 8 * hh;
            ld_bf16x8(zl + 128 + gc, c0, c1); if (hasp) ld_bf16x8(zl - 256 + 128 + gc, p0, p1); else { p0 = zero; p1 = zero; }
            m0 = *(const f32x4*)(p.rw_mu + 1664 + gc); m1 = *(const f32x4*)(p.rw_mu + 1664 + gc + 4);
            const f32x4 a = mix4(c0, p0, m0), bb = mix4(c1, p1, m1); u32x4 o;
            o.x = pk2h(sigmoidf_(a.x), sigmoidf_(a.y)); o.y = pk2h(sigmoidf_(a.z), sigmoidf_(a.w)); o.z = pk2h(sigmoidf_(bb.x), sigmoidf_(bb.y)); o.w = pk2h(sigmoidf_(bb.z), sigmoidf_(bb.w));
            *(LAS u32x4*)(SG + pt * 128 + gc) = o;
        }
    }
    LBAR();
    lora_mm2<64, false>(TW, bw2, lds + RL_W, wid, lane);
    lora_mm2<64, false>(AL, ba2, lds + RL_BV, wid, lane);
    lora_mm<128, true>(SG, g2t, lds + RL_G, wid, lane);
    LBAR();
    float ew[8], kk[8], bv[8], kp[8];
    {
        float ssq = 0.f; float kkv[8], av[8], kraw[8];
        const float pw0[8] = {pw0a.x, pw0a.y, pw0a.z, pw0a.w, pw0b.x, pw0b.y, pw0b.z, pw0b.w}, pa0[8] = {pa0a.x, pa0a.y, pa0a.z, pa0a.w, pa0b.x, pa0b.y, pa0b.z, pa0b.w};
        const float pkk[8] = {pkka.x, pkka.y, pkka.z, pkka.w, pkkb.x, pkkb.y, pkkb.z, pkkb.w}, pka[8] = {pkaa.x, pkaa.y, pkaa.z, pkaa.w, pkab.x, pkab.y, pkab.z, pkab.w}, prk[8] = {prka.x, prka.y, prka.z, prka.w, prkb.x, prkb.y, prkb.z, prkb.w};
#pragma unroll
        for (int j = 0; j < 8; ++j) {
            const int c = pc + j;
            const float xw = pw0[j] + W[pt * 64 + c];
            const float sp = fmaxf(-xw, 0.f) + __logf(1.f + __expf(-fabsf(xw)));
            ew[j] = __expf(-sp - 0.5f);
            av[j] = sigmoidf_(pa0[j] + BV[pt * 64 + c]);
            kraw[j] = KP[pt * 64 + c];
            kkv[j] = kraw[j] * pkk[j];
            ssq += kkv[j] * kkv[j];
        }
        ssq = red8(ssq);
        const float inv = rsqrtf(fmaxf(ssq, 1e-24f));
        float rkp = 0.f; const float rr[8] = {rm0.x, rm0.y, rm0.z, rm0.w, rm1.x, rm1.y, rm1.z, rm1.w};
#pragma unroll
        for (int j = 0; j < 8; ++j) { kk[j] = kkv[j] * inv; bv[j] = kk[j] * av[j]; kp[j] = kraw[j] * (1.f + (av[j] - 1.f) * pka[j]); rkp += rr[j] * kp[j] * prk[j]; }
        rkp = red8(rkp);
        const u32x4 og = *(const LAS u32x4*)(G + pt * 64 + pc);
        if (!dry) { *(u32x4*)(gout + row * 512 + hc) = og; if ((tid & 7) == 0) rkg[row * 8 + h] = rkp; } else { KEEP4(og); KEEP1(rkp); }
    }
    LBAR();
    const int stg = dry ? p.probe_ph - 420 : 99;
    if (stg == 0) return;
    LAS float* LG = (LAS float*)(lds + 10 * 8192); LAS float* SEG = (LAS float*)(lds + 12 * 8192); LAS float* GCv = (LAS float*)(lds + 131072);
    *(LAS f32x4*)(LG + pt * 64 + pc) = (f32x4){ew[0], ew[1], ew[2], ew[3]}; *(LAS f32x4*)(LG + pt * 64 + pc + 4) = (f32x4){ew[4], ew[5], ew[6], ew[7]};
    LBAR();
    { const int k = tid & 63, seg = tid >> 6; float sm = 0.f;
#pragma unroll
      for (int i = 0; i < 8; ++i) sm += LG[(seg * 8 + i) * 64 + k];
      SEG[seg * 64 + k] = sm; }
    LBAR();
    { const int k = tid & 63, seg = tid >> 6; float acc = 0.f;
#pragma unroll
      for (int q = 0; q < 8; ++q) acc += (q < seg) ? SEG[q * 64 + k] : 0.f;
#pragma unroll
      for (int i = 0; i < 8; ++i) { acc += LG[(seg * 8 + i) * 64 + k]; LG[(seg * 8 + i) * 64 + k] = -acc; } }
    LBAR();
    {
        const f32x4 l0 = *(const LAS f32x4*)(LG + pt * 64 + pc), l1 = *(const LAS f32x4*)(LG + pt * 64 + pc + 4), c0 = *(const LAS f32x4*)(LG + 63 * 64 + pc), c1 = *(const LAS f32x4*)(LG + 63 * 64 + pc + 4);
        const float lg[8] = {l0.x, l0.y, l0.z, l0.w, l1.x, l1.y, l1.z, l1.w}, lc[8] = {c0.x, c0.y, c0.z, c0.w, c1.x, c1.y, c1.z, c1.w};
        const float rr[8] = {rm0.x, rm0.y, rm0.z, rm0.w, rm1.x, rm1.y, rm1.z, rm1.w}, vv[8] = {vm0.x, vm0.y, vm0.z, vm0.w, vm1.x, vm1.y, vm1.z, vm1.w};
        float am[8], rmv[8], bm[8], km[8], bh[8], kh[8];
#pragma unroll
        for (int j = 0; j < 8; ++j) { const float gam = __expf(lg[j]), gm1 = __expf(lg[j] + ew[j]), gi = __expf(-lg[j]), gcr = __expf(lc[j] - lg[j]);
            am[j] = -kk[j] * gm1; rmv[j] = rr[j] * gam; bm[j] = bv[j] * gi; km[j] = kp[j] * gi; bh[j] = bv[j] * gcr; kh[j] = kp[j] * gcr;
            if (pt == 63) GCv[pc + j] = gam; }
#define ST8(slot, a) do { u32x4 o_; o_.x = pk2h(a[0], a[1]); o_.y = pk2h(a[2], a[3]); o_.z = pk2h(a[4], a[5]); o_.w = pk2h(a[6], a[7]); *(LAS u32x4*)(SLOT(slot) + SIDX(pt, pc)) = o_; } while (0)
        ST8(0, am); ST8(1, rmv); ST8(2, bm); ST8(3, km);
#undef ST8
#pragma unroll
        for (int j = 0; j < 8; ++j) { SLOT(4)[SIDX(pc + j, pt)] = (bf16_t)f2bf(am[j]); SLOT(5)[SIDX(pc + j, pt)] = (bf16_t)f2bf(bh[j]); SLOT(6)[SIDX(pc + j, pt)] = (bf16_t)f2bf(kh[j]); SLOT(7)[SIDX(pc + j, pt)] = (bf16_t)f2bf(vv[j]); }
    }
    LBAR();
    if (stg == 1) return;
    f32x4 acc[2];
    MM_ZERO(acc); MMT(acc, SLOT(2), SLOT(0));
    MM4_EACH(acc, { v4.x = (i < j0) ? v4.x : 0.f; v4.y = (i < j0 + 1) ? v4.y : 0.f; v4.z = (i < j0 + 2) ? v4.z : 0.f; v4.w = (i < j0 + 3) ? v4.w : 0.f; ST4S(10, i, j0, v4);
                    f32x4 t4 = v4; if (i == j0) t4.x += 1.f; if (i == j0 + 1) t4.y += 1.f; if (i == j0 + 2) t4.z += 1.f; if (i == j0 + 3) t4.w += 1.f; ST4S(14, i, j0, t4); });
    MM_ZERO(acc); MMT(acc, SLOT(0), SLOT(2));
    MM4_EACH(acc, { v4.x = (j0 < i) ? v4.x : 0.f; v4.y = (j0 + 1 < i) ? v4.y : 0.f; v4.z = (j0 + 2 < i) ? v4.z : 0.f; v4.w = (j0 + 3 < i) ? v4.w : 0.f; ST4S(11, i, j0, v4); });
    MM_ZERO(acc); MMT(acc, SLOT(3), SLOT(0));
    MM4_EACH(acc, { v4.x = (i < j0) ? v4.x : 0.f; v4.y = (i < j0 + 1) ? v4.y : 0.f; v4.z = (i < j0 + 2) ? v4.z : 0.f; v4.w = (i < j0 + 3) ? v4.w : 0.f; ST4S(8, i, j0, v4); });
    MM_ZERO(acc); MMT(acc, SLOT(1), SLOT(2));
    MM4_EACH(acc, { v4.x = (j0 <= i) ? v4.x : 0.f; v4.y = (j0 + 1 <= i) ? v4.y : 0.f; v4.z = (j0 + 2 <= i) ? v4.z : 0.f; v4.w = (j0 + 3 <= i) ? v4.w : 0.f; ST4S(9, i, j0, v4); });
    LBAR();
    if (stg == 2) return;
    {
        int pc_ = 10, pn_ = 12, tc_ = 14, tn_ = 15;
        MM_ZERO(acc); MMT(acc, SLOT(pc_), SLOT(pc_ + 1)); MM4_EACH(acc, { ST4S(pn_, i, j0, v4); });
        MM_ZERO(acc); MMT(acc, SLOT(pc_ + 1), SLOT(pc_)); MM4_EACH(acc, { ST4S(pn_ + 1, i, j0, v4); });
        LBAR();
        { const int t_ = pc_; pc_ = pn_; pn_ = t_; }
#pragma unroll 1
        for (int j = 0; j < 5; ++j) {
            if (j < 4) {
                MM_ZERO(acc); MMT(acc, SLOT(pc_), SLOT(pc_ + 1)); MM4_EACH(acc, { ST4S(pn_, i, j0, v4); });
                MM_ZERO(acc); MMT(acc, SLOT(pc_ + 1), SLOT(pc_)); MM4_EACH(acc, { ST4S(pn_ + 1, i, j0, v4); });
            }
            MM_ZERO(acc); MMT(acc, SLOT(tc_), SLOT(pc_ + 1));
            MM4_EACH(acc, { v4 = v4 + ld4s(SLOT(tc_) + SIDX(i, j0)); ST4S(tn_, i, j0, v4); });
            LBAR();
            { const int t_ = pc_; pc_ = pn_; pn_ = t_; } { const int t_ = tc_; tc_ = tn_; tn_ = t_; }
        }
    }
    if (stg == 3) return;
    MM_ZERO(acc); MMT(acc, SLOT(9), SLOT(15));
    MM4_EACH(acc, { ST4S(0, i, j0, v4); });
    MM_ZERO(acc); MMT(acc, SLOT(5), SLOT(15));
    MM4_EACH(acc, { ST4S(2, i, j0, v4); });
    LBAR();
    if (stg == 4) return;
    bf16_t* gbase = pre + ((size_t)tile * 64) * 512 + h * 64;
#define GST4(arr, ii, jj, v) do { u32x2 w_; w_.x = pk2h((v).x, (v).y); w_.y = pk2h((v).z, (v).w); if (!dry) *(u32x2*)(gbase + (size_t)(arr) * PREP_STRIDE + (size_t)(ii) * 512 + (jj)) = w_; else { KEEP1(w_.x); KEEP1(w_.y); } } while (0)
    MM_ZERO(acc); MMT(acc, SLOT(0), SLOT(4));
    MM4_EACH(acc, { v4 = v4 + ld4s(SLOT(1) + SIDX(i, j0)); GST4(0, i, j0, v4); });
    MM_ZERO(acc); MMT(acc, SLOT(1), SLOT(3));
    MM4_EACH(acc, { v4.x = (j0 <= i) ? v4.x : 0.f; v4.y = (j0 + 1 <= i) ? v4.y : 0.f; v4.z = (j0 + 2 <= i) ? v4.z : 0.f; v4.w = (j0 + 3 <= i) ? v4.w : 0.f; });
    MMT(acc, SLOT(0), SLOT(8));
    MM4_EACH(acc, { GST4(1, i, j0, v4); });
    MM_ZERO(acc); MMT(acc, SLOT(2), SLOT(4));
    MM4_EACH(acc, { const float gc_ = GCv[i]; if (i == j0) v4.x += gc_; if (i == j0 + 1) v4.y += gc_; if (i == j0 + 2) v4.z += gc_; if (i == j0 + 3) v4.w += gc_; GST4(2, i, j0, v4); });
    MM_ZERO(acc); MMT(acc, SLOT(2), SLOT(8));
    MM4_EACH(acc, { v4 = v4 + ld4s(SLOT(6) + SIDX(i, j0)); ST4S(5, i, j0, v4); });
    LBAR();
    MM_ZERO(acc); MMT(acc, SLOT(7), SLOT(5));
    MM4_EACH(acc, { GST4(3, i, j0, v4); });
#undef GST4
    LBAR();
}
__device__ __forceinline__ void up8(const u32x4 w, f32x4& a, f32x4& b) { a = (f32x4){bflo(w.x), bfhi(w.x), bflo(w.y), bfhi(w.y)}; b = (f32x4){bflo(w.z), bfhi(w.z), bflo(w.w), bfhi(w.w)}; }
__device__ __forceinline__ void rwkv_state_out_pass(const Params& p, LAS unsigned char* lds, int b, int h) {
    const int tid = threadIdx.x, lane = tid & 63, wid = tid >> 6;
    const bf16_t* zrkv = (const bf16_t*)(p.ws + WS_ZRKV); const bf16_t* pre = (const bf16_t*)p.out; const bf16_t* gin = (const bf16_t*)(p.ws + WS_RG); const float* rkg = (const float*)(p.ws + WS_RKG);
    bf16_t* ya = (bf16_t*)(p.ws + WS_YA);
    LAS bf16_t* SL = (LAS bf16_t*)lds; LAS bf16_t* VT = (LAS bf16_t*)(lds + 8192);
    LAS float* V = (LAS float*)(lds + RL_V); LAS float* Y = (LAS float*)(lds + RL_Y); LAS float* RK = (LAS float*)(lds + RL_RK); LAS bf16_t* G = (LAS bf16_t*)(lds + RL_G);
    const int pt = tid >> 3, pc = (tid & 7) * 8, hc = h * 64 + pc;
    const int mi = wid >> 1, l15 = lane & 15, g = lane >> 4;
    const f32x4 muv0 = *(const f32x4*)(p.rw_mu + 1024 + hc), muv1 = *(const f32x4*)(p.rw_mu + 1024 + hc + 4);
    *(LAS u32x4*)(SL + tid * 8) = (u32x4){0u, 0u, 0u, 0u};
    bf16x8 gt[2][2], pa[2], qa[2]; unsigned short hm[2][4]; u32x4 vcq, vpq, gq; float rkq;
#define SO_LOAD(cc) do { const size_t r0_ = (size_t)b * S + (cc) * 64; const bf16_t* gb_ = pre + r0_ * 512 + h * 64; \
        _Pragma("unroll") for (int ks = 0; ks < 2; ++ks) { pa[ks] = *(const bf16x8*)(gb_ + (size_t)(16 * mi + l15) * 512 + 32 * ks + 8 * g); qa[ks] = *(const bf16x8*)(gb_ + PREP_STRIDE + (size_t)(16 * mi + l15) * 512 + 32 * ks + 8 * g); } \
        _Pragma("unroll") for (int nn = 0; nn < 2; ++nn) { const int ni = 2 * (wid & 1) + nn; \
            _Pragma("unroll") for (int ks = 0; ks < 2; ++ks) gt[nn][ks] = *(const bf16x8*)(gb_ + 2 * PREP_STRIDE + (size_t)(16 * ni + l15) * 512 + 32 * ks + 8 * g); \
            _Pragma("unroll") for (int r = 0; r < 4; ++r) hm[nn][r] = gb_[3 * PREP_STRIDE + (size_t)(16 * mi + 4 * g + r) * 512 + 16 * ni + l15]; } \
        const bf16_t* zr_ = zrkv + (r0_ + pt) * 1536 + 1024 + hc; vcq = *(const u32x4*)zr_; vpq = ((cc) * 64 + pt > 0) ? *(const u32x4*)(zr_ - 1536) : (u32x4){0u, 0u, 0u, 0u}; \
        gq = *(const u32x4*)(gin + (r0_ + pt) * 512 + hc); rkq = rkg[(r0_ + pt) * 8 + h]; } while (0)
    SO_LOAD(0);
    for (int c = 0; c < S / 64; ++c) {
        { f32x4 a0, a1, b0, b1; up8(vcq, a0, a1); up8(vpq, b0, b1);
          const f32x4 v0 = mix4(a0, b0, muv0), v1 = mix4(a1, b1, muv1);
          *(LAS f32x4*)(V + pt * 64 + pc) = v0; *(LAS f32x4*)(V + pt * 64 + pc + 4) = v1;
          const float vv[8] = {v0.x, v0.y, v0.z, v0.w, v1.x, v1.y, v1.z, v1.w};
#pragma unroll
          for (int j = 0; j < 8; ++j) VT[(pc + j) * 64 + pt] = (bf16_t)f2bf(vv[j]);
          *(LAS u32x4*)(G + pt * 64 + pc) = gq; if ((tid & 7) == 0) RK[pt] = rkq; }
        LBAR();
        f32x4 ay[2], as[2];
#pragma unroll
        for (int nn = 0; nn < 2; ++nn) { const int ni = 2 * (wid & 1) + nn;
            ay[nn] = (f32x4){0.f, 0.f, 0.f, 0.f}; as[nn] = (f32x4){bf2f(hm[nn][0]), bf2f(hm[nn][1]), bf2f(hm[nn][2]), bf2f(hm[nn][3])};
#pragma unroll
            for (int ks = 0; ks < 2; ++ks) {
                const bf16x8 sb = *(const LAS bf16x8*)(SL + (16 * ni + l15) * 64 + 32 * ks + 8 * g);
                ay[nn] = __builtin_amdgcn_mfma_f32_16x16x32_bf16(pa[ks], sb, ay[nn], 0, 0, 0);
                ay[nn] = __builtin_amdgcn_mfma_f32_16x16x32_bf16(qa[ks], *(const LAS bf16x8*)(VT + (16 * ni + l15) * 64 + 32 * ks + 8 * g), ay[nn], 0, 0, 0);
                as[nn] = __builtin_amdgcn_mfma_f32_16x16x32_bf16(*(const LAS bf16x8*)(SL + (16 * mi + l15) * 64 + 32 * ks + 8 * g), gt[nn][ks], as[nn], 0, 0, 0); } }
        MM_EACH(ay, { Y[row * 64 + col] = val; });
        if (c + 1 < S / 64) SO_LOAD(c + 1);
        LBAR();
        MM_EACH(as, { SL[row * 64 + col] = (bf16_t)f2bf(val); });
        {
            float yv[8]; float sm = 0.f;
#pragma unroll
            for (int j = 0; j < 8; ++j) { yv[j] = Y[pt * 64 + pc + j]; sm += yv[j]; }
            const float mean = red8(sm) * (1.f / 64.f); float qq = 0.f;
#pragma unroll
            for (int j = 0; j < 8; ++j) { yv[j] -= mean; qq += yv[j] * yv[j]; }
            const float rstd = rsqrtf(red8(qq) * (1.f / 64.f) + RW_GN_EPS);
            const float rk = RK[pt]; float o[8];
#pragma unroll
            for (int j = 0; j < 8; ++j) { const int gc = hc + j;
                o[j] = (yv[j] * rstd * p.rw_gn_g[gc] + p.rw_gn_b[gc] + rk * V[pt * 64 + pc + j]) * bf2f(G[pt * 64 + pc + j]); }
            u32x4 w; w.x = pk2(o[0], o[1]); w.y = pk2(o[2], o[3]); w.z = pk2(o[4], o[5]); w.w = pk2(o[6], o[7]);
            *(u32x4*)(ya + ((size_t)b * S + c * 64 + pt) * 512 + hc) = w;
        }
        LBAR();
    }
#undef SO_LOAD
}

__device__ __forceinline__ int mbcnt64(unsigned long long m) { return (int)__builtin_amdgcn_mbcnt_hi((unsigned)(m >> 32), __builtin_amdgcn_mbcnt_lo((unsigned)m, 0u)); }
template <int NV> __device__ __forceinline__ int wave_count_ge(const unsigned (&u)[NV], unsigned cand) {
    if (NV <= 8) { int c = 0;
#pragma unroll
        for (int i = 0; i < NV; ++i) c += (int)__builtin_popcountll(__ballot(u[i] >= cand));
        return c; }
    else { int c = 0;
#pragma unroll
        for (int i = 0; i < NV; ++i) c += (u[i] >= cand) ? 1 : 0;
        c += __builtin_amdgcn_update_dpp(0, c, 0xB1, 0xf, 0xf, true); c += __builtin_amdgcn_update_dpp(0, c, 0x4E, 0xf, 0xf, true);
        c += __builtin_amdgcn_update_dpp(0, c, 0x141, 0xf, 0xf, true); c += __builtin_amdgcn_update_dpp(0, c, 0x140, 0xf, 0xf, true);
        return __builtin_amdgcn_readlane(c, 0) + __builtin_amdgcn_readlane(c, 16) + __builtin_amdgcn_readlane(c, 32) + __builtin_amdgcn_readlane(c, 48); }
}
template <int NV, int K> __device__ __forceinline__ unsigned wave_kth(const unsigned (&u)[NV]) {
    unsigned Tt = 0u;
    for (int bit = 31; bit >= 0; --bit) {
        const unsigned cand = Tt | (1u << bit);
        const int c = wave_count_ge<NV>(u, cand);
        if (c >= K) Tt = cand;
        if (c == K) break;
    }
    return Tt;
}

__device__ __forceinline__ int cnt4_ge(int c, unsigned a, unsigned b, unsigned d, unsigned e, unsigned x) {
    asm volatile("v_cmp_ge_u32_e64 s[20:21], %1, %5\n\tv_cmp_ge_u32_e64 s[22:23], %2, %5\n\tv_cmp_ge_u32_e64 s[24:25], %3, %5\n\tv_cmp_ge_u32_e64 s[26:27], %4, %5\n\t"
                 "v_addc_co_u32_e64 %0, s[28:29], %0, 0, s[20:21]\n\tv_addc_co_u32_e64 %0, s[28:29], %0, 0, s[22:23]\n\tv_addc_co_u32_e64 %0, s[28:29], %0, 0, s[24:25]\n\tv_addc_co_u32_e64 %0, s[28:29], %0, 0, s[26:27]"
                 : "+v"(c) : "v"(a), "v"(b), "v"(d), "v"(e), "v"(x) : "s20", "s21", "s22", "s23", "s24", "s25", "s26", "s27", "s28", "s29");
    return c;
}
__device__ __forceinline__ int wave_count_ge64(const unsigned (&u)[64], unsigned cand, int ngrp) {
    int c = 0;
#pragma unroll
    for (int gq = 0; gq < 4; ++gq) if (gq < ngrp) {
#pragma unroll
        for (int i = 0; i < 16; i += 4) c = cnt4_ge(c, u[gq * 16 + i], u[gq * 16 + i + 1], u[gq * 16 + i + 2], u[gq * 16 + i + 3], cand);
    }
    c += __builtin_amdgcn_update_dpp(0, c, 0xB1, 0xf, 0xf, true); c += __builtin_amdgcn_update_dpp(0, c, 0x4E, 0xf, 0xf, true);
    c += __builtin_amdgcn_update_dpp(0, c, 0x141, 0xf, 0xf, true); c += __builtin_amdgcn_update_dpp(0, c, 0x140, 0xf, 0xf, true);
    return __builtin_amdgcn_readlane(c, 0) + __builtin_amdgcn_readlane(c, 16) + __builtin_amdgcn_readlane(c, 32) + __builtin_amdgcn_readlane(c, 48);
}
template <int K> __device__ __forceinline__ unsigned wave_kth_interp(const unsigned (&u)[64], int ngrp, bool& allge, int& cgt) {
    unsigned mx = 0u;
#pragma unroll
    for (int gq = 0; gq < 4; ++gq) if (gq < ngrp) {
#pragma unroll
        for (int i = 0; i < 16; ++i) mx = umax_(mx, u[gq * 16 + i]);
    }
    { int m = (int)mx;
      unsigned o;
      o = (unsigned)__builtin_amdgcn_update_dpp(0, m, 0xB1, 0xf, 0xf, true); mx = umax_(mx, o); m = (int)mx;
      o = (unsigned)__builtin_amdgcn_update_dpp(0, m, 0x4E, 0xf, 0xf, true); mx = umax_(mx, o); m = (int)mx;
      o = (unsigned)__builtin_amdgcn_update_dpp(0, m, 0x141, 0xf, 0xf, true); mx = umax_(mx, o); m = (int)mx;
      o = (unsigned)__builtin_amdgcn_update_dpp(0, m, 0x140, 0xf, 0xf, true); mx = umax_(mx, o); m = (int)mx;
      mx = umax_(umax_((unsigned)__builtin_amdgcn_readlane(m, 0), (unsigned)__builtin_amdgcn_readlane(m, 16)), umax_((unsigned)__builtin_amdgcn_readlane(m, 32), (unsigned)__builtin_amdgcn_readlane(m, 48))); }
    unsigned Tt = 0u; allge = false; int startbit = 31 - __builtin_clz(mx | 1u);
    {
        unsigned P = mx & 0xff800000u;
        for (int j = 0; j < 4; ++j) {
            const int c = wave_count_ge64(u, P | (P == 0u ? 1u : 0u), ngrp);
            if (c >= K) { Tt = P; startbit = 22; if (c == K && P != 0u) allge = true; break; }
            if (P < 0x00800000u) break;
            P -= 0x00800000u;
        }
    }
    if (!allge) {
        for (int bit = startbit; bit >= 0; --bit) {
            const unsigned cand = Tt | (1u << bit);
            const int c = wave_count_ge64(u, cand, ngrp);
            if (c >= K) { Tt = cand; if (c == K) { allge = true; break; } }
        }
    }
    cgt = allge ? 0 : wave_count_ge64(u, Tt + 1u, ngrp);
    return Tt;
}

constexpr int IX_LD = 4112;
constexpr int IX_LUT = 8 * IX_LD * 4, IX_FAR = IX_LUT + 4096;
typedef short v4i16_t __attribute__((ext_vector_type(4)));
__device__ __forceinline__ void attn_query(int lane, int t, int cnt, LAS unsigned char* WL, const LAS float* LUT, const LAS float* FAR, bf16_t* zq, const bf16_t* ckv, bool dry, int fake = 0) {
    const int b = t / S, tp = t % S;
    LAS unsigned short* SEL = (LAS unsigned short*)WL; LAS bf16_t* PT = (LAS bf16_t*)(WL + 512); LAS unsigned char* VI = WL + 2048;
    const int l15 = lane & 15, g = lane >> 4;
    bf16x8 qf[4];
#pragma unroll
    for (int ks = 0; ks < 4; ++ks) { if (l15 < 8) qf[ks] = *(const bf16x8*)(zq + (size_t)t * 1024 + l15 * 128 + 32 * ks + 8 * g); else qf[ks] = (bf16x8){0, 0, 0, 0, 0, 0, 0, 0}; }
    const bf16_t* kb = ckv + (size_t)b * S * 128 + 8 * l15;
    const int nch = (cnt + 31) >> 5;
    u32x4 pre[8];
#pragma unroll
    for (int i = 0; i < 8; ++i) pre[i] = *(const u32x4*)(kb + (size_t)(fake ? (SEL[4 * i + g] & 31) : SEL[4 * i + g]) * 128);
    f32x4 O[8];
#pragma unroll
    for (int nt = 0; nt < 8; ++nt) O[nt] = (f32x4){0.f, 0.f, 0.f, 0.f};
    float mrun[4], lrun[4];
#pragma unroll
    for (int r = 0; r < 4; ++r) { mrun[r] = -INFINITY; lrun[r] = 0.f; }
    for (int ch = 0; ch < nch; ++ch) {
#pragma unroll
        for (int i = 0; i < 8; ++i) { const int r = 4 * i + g; *(LAS u32x4*)(VI + r * 256 + ((l15 ^ (r & 15)) << 4)) = pre[i]; }
        if (ch + 1 < nch) {
#pragma unroll
            for (int i = 0; i < 8; ++i) pre[i] = *(const u32x4*)(kb + (size_t)(fake ? (SEL[(ch + 1) * 32 + 4 * i + g] & 31) : SEL[(ch + 1) * 32 + 4 * i + g]) * 128);
        }
        asm volatile("s_waitcnt lgkmcnt(0)" ::: "memory");
        f32x4 sc[2];
#pragma unroll
        for (int nt2 = 0; nt2 < 2; ++nt2) {
            const int row = 16 * nt2 + l15; f32x4 acc = (f32x4){0.f, 0.f, 0.f, 0.f};
#pragma unroll
            for (int ks = 0; ks < 4; ++ks) acc = __builtin_amdgcn_mfma_f32_16x16x32_bf16(qf[ks], *(const LAS bf16x8*)(VI + row * 256 + (((4 * ks + g) ^ l15) << 4)), acc, 0, 0, 0);
            const int slot = ch * 32 + row; const int key = SEL[slot]; const int n = tp - key; const bool ok = slot < cnt;
            const f32x4 bias = (n < 128) ? *(const LAS f32x4*)(LUT + n * 8 + ((4 * g) & 7)) : *(const LAS f32x4*)(FAR + ((4 * g) & 7));
#pragma unroll
            for (int r = 0; r < 4; ++r) acc[r] = ok ? acc[r] + bias[r] : -INFINITY;
            sc[nt2] = acc;
        }
        float alpha[4];
#pragma unroll
        for (int r = 0; r < 4; ++r) {
            const float cm = red16_max(fmaxf(sc[0][r], sc[1][r]));
            const float mn = fmaxf(mrun[r], cm);
            alpha[r] = __builtin_amdgcn_exp2f(mrun[r] - mn); mrun[r] = mn;
            sc[0][r] = __builtin_amdgcn_exp2f(sc[0][r] - mn); sc[1][r] = __builtin_amdgcn_exp2f(sc[1][r] - mn);
            lrun[r] = lrun[r] * alpha[r] + red16_sum(sc[0][r] + sc[1][r]);
        }
        if (!__all(alpha[0] == 1.f && alpha[1] == 1.f && alpha[2] == 1.f && alpha[3] == 1.f)) {
#pragma unroll
            for (int nt = 0; nt < 8; ++nt) { O[nt].x *= alpha[0]; O[nt].y *= alpha[1]; O[nt].z *= alpha[2]; O[nt].w *= alpha[3]; }
        }
        if (g < 2) {
#pragma unroll
            for (int nt2 = 0; nt2 < 2; ++nt2)
#pragma unroll
                for (int r = 0; r < 4; ++r) PT[(4 * g + r) * 32 + 16 * nt2 + l15] = (bf16_t)(pk2h(sc[nt2][r], sc[nt2][r]) & 0xffffu);
        }
        asm volatile("s_waitcnt lgkmcnt(0)" ::: "memory");
        const bf16x8 pa = *(const LAS bf16x8*)(PT + l15 * 32 + 8 * g);
        const int q4 = l15 >> 2, p4 = l15 & 3;
#pragma unroll
        for (int nt = 0; nt < 8; ++nt) {
            const int r0 = 8 * g + q4, r1 = r0 + 4, chn = 2 * nt + (p4 >> 1);
            const v4i16_t lo = __builtin_amdgcn_ds_read_tr16_b64_v4i16((LAS v4i16_t*)(VI + r0 * 256 + ((chn ^ (r0 & 15)) << 4) + (p4 & 1) * 8));
            const v4i16_t hi = __builtin_amdgcn_ds_read_tr16_b64_v4i16((LAS v4i16_t*)(VI + r1 * 256 + ((chn ^ (r1 & 15)) << 4) + (p4 & 1) * 8));
            const bf16x8 vb = (bf16x8){lo[0], lo[1], lo[2], lo[3], hi[0], hi[1], hi[2], hi[3]};
            O[nt] = __builtin_amdgcn_mfma_f32_16x16x32_bf16(pa, vb, O[nt], 0, 0, 0);
        }
        asm volatile("s_waitcnt lgkmcnt(0)" ::: "memory");
    }
    if (g < 2) {
        float inv[4];
#pragma unroll
        for (int r = 0; r < 4; ++r) inv[r] = 1.f / lrun[r];
#pragma unroll
        for (int nt = 0; nt < 8; ++nt)
#pragma unroll
            for (int r = 0; r < 4; ++r) { const float ov = O[nt][r] * inv[r]; const bf16_t o = (bf16_t)(pk2h(ov, ov) & 0xffffu); if (!dry) zq[(size_t)t * 1024 + (4 * g + r) * 128 + 16 * nt + l15] = o; else KEEP1(o); }
    }
}
__device__ __forceinline__ void dsa_tables(const Params& p, LAS unsigned char* lds) {
    LAS float* LUT = (LAS float*)(lds + IX_LUT); LAS float* FAR = (LAS float*)(lds + IX_FAR);
    for (int i = threadIdx.x; i < 1024; i += NTHR) { const int n = i >> 3, hh = i & 7; int bk;
        if (n < 16) bk = n; else { bk = 16 + (int)(logf((float)n / 16.f) / 2.0794415416798357f * 16.f); bk = bk < 31 ? bk : 31; }
        LUT[i] = p.rel_bias[bk * 8 + hh] * 1.4426950408889634f; }
    if (threadIdx.x < 8) FAR[threadIdx.x] = p.rel_bias[31 * 8 + threadIdx.x] * 1.4426950408889634f;
    __syncthreads();
}
__device__ __forceinline__ void dsa_unit(const Params& p, LAS unsigned char* lds, int unit, bool dry, int fake = 0) {
    const int tid = threadIdx.x, lane = tid & 63, wid = tid >> 6;
    const int b = unit >> 9, t0 = (unit & 511) * 8;
    const bf16_t* qidx = (const bf16_t*)(p.ws + WS_QIDX); const bf16_t* kidx = (const bf16_t*)(p.ws + WS_KIDX); const float* widx = (const float*)(p.ws + WS_WIDX);
    bf16_t* zq = (bf16_t*)(p.ws + WS_ZQ); const bf16_t* ckv = (const bf16_t*)(p.ws + WS_CKV);
    LAS float* SC = (LAS float*)lds;
    const LAS float* LUT = (const LAS float*)(lds + IX_LUT); const LAS float* FAR = (const LAS float*)(lds + IX_FAR);
    LAS unsigned char* WL = (LAS unsigned char*)(SC + wid * IX_LD);
    LAS unsigned short* SEL = (LAS unsigned short*)WL;
    const int t = t0 + wid;
    int cnt;
    if (t0 < TOPK) {
#pragma unroll
        for (int i = 0; i < 4; ++i) { const int idx = i * 64 + lane; SEL[idx] = (unsigned short)(idx <= t ? idx : 0); }
        cnt = t + 1;
    } else {
        bf16x8 afr[2][2]; f32x4 wv[2];
#pragma unroll
        for (int rt = 0; rt < 2; ++rt) {
            const size_t row = (size_t)b * S + t0 + 4 * rt + ((lane & 15) >> 2);
#pragma unroll
            for (int ks = 0; ks < 2; ++ks) afr[rt][ks] = *(const bf16x8*)(qidx + row * 256 + (lane & 3) * 64 + 32 * ks + 8 * (lane >> 4));
            wv[rt] = *(const f32x4*)(widx + ((size_t)b * S + t0 + 4 * rt + (lane >> 4)) * 4);
        }
        const int ntiles = (t0 + 8 + 15) >> 4;
        for (int kt0 = wid; kt0 < ntiles; kt0 += 4 * NWAVE) {
            bf16x8 kb0[4], kb1[4];
#pragma unroll
            for (int q = 0; q < 4; ++q) { const int kt = kt0 + q * NWAVE; const int ktc = kt < ntiles ? kt : kt0;
                const bf16_t* kp = kidx + ((size_t)b * S + ktc * 16 + (lane & 15)) * 64 + 8 * (lane >> 4); kb0[q] = *(const bf16x8*)kp; kb1[q] = *(const bf16x8*)(kp + 32); }
#pragma unroll
            for (int q = 0; q < 4; ++q) { const int kt = kt0 + q * NWAVE;
#pragma unroll
                for (int rt = 0; rt < 2; ++rt) {
                    f32x4 acc = (f32x4){0.f, 0.f, 0.f, 0.f};
                    acc = __builtin_amdgcn_mfma_f32_16x16x32_bf16(afr[rt][0], kb0[q], acc, 0, 0, 0);
                    acc = __builtin_amdgcn_mfma_f32_16x16x32_bf16(afr[rt][1], kb1[q], acc, 0, 0, 0);
                    const float sv = wv[rt].x * fmaxf(acc.x, 0.f) + wv[rt].y * fmaxf(acc.y, 0.f) + wv[rt].z * fmaxf(acc.z, 0.f) + wv[rt].w * fmaxf(acc.w, 0.f);
                    if (kt < ntiles) SC[(4 * rt + (lane >> 4)) * IX_LD + kt * 16 + (lane & 15)] = sv;
                }
            }
        }
        LBAR();
        const int n = t + 1;
        unsigned u[64];
#pragma unroll
        for (int i = 0; i < 64; ++i) { const int idx = i * 64 + lane; u[i] = (idx < n) ? sortable(SC[wid * IX_LD + idx]) : 0u; }
        asm volatile("s_waitcnt lgkmcnt(0)" ::: "memory");
        const int ngrp = (n + 1023) >> 10;
        bool allge = true; int cgt = 0;
        unsigned Tt = u[0];
        if (fake != 3) Tt = wave_kth_interp<TOPK>(u, ngrp, allge, cgt);
        int base = 0;
        if (fake >= 3) { KEEP1(Tt); KEEP1(cgt); }
        else if (allge) {
#pragma unroll
            for (int i = 0; i < 64; ++i) {
                if (i * 64 < n) {
                    const bool take = u[i] >= Tt;
                    const unsigned long long mt = __ballot(take);
                    if (take) SEL[base + mbcnt64(mt)] = (unsigned short)(i * 64 + lane);
                    base += (int)__builtin_popcountll(mt);
                }
            }
        } else {
            const int need_eq = TOPK - cgt; int eqb = 0;
#pragma unroll
            for (int i = 0; i < 64; ++i) {
                if (i * 64 < n) {
                    const bool gt = u[i] > Tt, eq = u[i] == Tt;
                    const unsigned long long meq = __ballot(eq);
                    const bool take = gt || (eq && (eqb + mbcnt64(meq)) < need_eq);
                    const unsigned long long mt = __ballot(take);
                    if (take) SEL[base + mbcnt64(mt)] = (unsigned short)(i * 64 + lane);
                    base += (int)__builtin_popcountll(mt); eqb += (int)__builtin_popcountll(meq);
                }
            }
        }
        cnt = TOPK;
    }
    asm volatile("s_waitcnt lgkmcnt(0)" ::: "memory");
    if (fake < 2) attn_query(lane, b * S + t, cnt, WL, LUT, FAR, zq, ckv, dry, fake);
    LBAR();
}

__device__ __forceinline__ void phase_ln1(const Params& p, int bid, int nblk) {
    const int lane = threadIdx.x & 63, wid = threadIdx.x >> 6;
    const float* mod = (const float*)(p.ws + WS_MOD); bf16_t* h2 = (bf16_t*)(p.ws + WS_H2);
    for (int m = bid * NWAVE + wid; m < T; m += nblk * NWAVE) {
        const int b = m / S; float* row = p.out + (size_t)m * D;
        f32x4 v[4]; float s = 0.f;
#pragma unroll
        for (int j = 0; j < 4; ++j) { v[j] = *(const f32x4*)(row + 4 * lane + 256 * j); s += (v[j].x + v[j].y) + (v[j].z + v[j].w); }
        const float mean = wave_sum(s) * (1.f / D); float q = 0.f;
#pragma unroll
        for (int j = 0; j < 4; ++j) { v[j] = v[j] - mean; q += (v[j].x * v[j].x + v[j].y * v[j].y) + (v[j].z * v[j].z + v[j].w * v[j].w); }
        const float rstd = rsqrtf(wave_sum(q) * (1.f / D) + LN_EPS);
#pragma unroll
        for (int j = 0; j < 4; ++j) { const int c = 4 * lane + 256 * j;
            const f32x4 x1 = v[j] * rstd * *(const f32x4*)(p.ln1_g + c) + *(const f32x4*)(p.ln1_b + c);
            *(f32x4*)(row + c) = x1;
            st_bf16x4(h2 + (size_t)m * D + c, x1 * (1.f + *(const f32x4*)(mod + b * 6144 + 4096 + c)) + *(const f32x4*)(mod + b * 6144 + 3072 + c)); }
    }
}

__device__ __forceinline__ float unsortable(unsigned u) { return __uint_as_float((u & 0x80000000u) ? (u & 0x7fffffffu) : ~u); }
template <int N> __device__ __forceinline__ void bitonic_sort_desc(unsigned (&v)[N]) {
#pragma unroll
    for (int k = 2; k <= N; k <<= 1)
#pragma unroll
        for (int j = k >> 1; j > 0; j >>= 1)
#pragma unroll
            for (int i = 0; i < N; ++i) { const int l = i ^ j; if (l > i) { const unsigned hi = umax_(v[i], v[l]), lo = umin_(v[i], v[l]); if ((i & k) == 0) { v[i] = hi; v[l] = lo; } else { v[i] = lo; v[l] = hi; } } }
}
__device__ __forceinline__ void bitonic_merge16_desc(unsigned (&m)[16]) {
#pragma unroll
    for (int j = 8; j > 0; j >>= 1)
#pragma unroll
        for (int i = 0; i < 16; ++i) { const int l = i ^ j; if (l > i) { const unsigned hi = umax_(m[i], m[l]), lo = umin_(m[i], m[l]); m[i] = hi; m[l] = lo; } }
}
constexpr int RT2_WSZ = (4 * 32 * 16 + 64) * 4;
__device__ __forceinline__ void route_phase(const Params& p, LAS unsigned char* lds, int bid, int nblk, bool dry) {
    const int tid = threadIdx.x, lane = tid & 63, wid = tid >> 6;
    const bf16_t* pq = (const bf16_t*)(p.ws + WS_PQ); const bf16_t* keys = (const bf16_t*)(p.ws + WS_KEYS);
    unsigned short* eidx = (unsigned short*)(p.ws + WS_EIDX); float* gate = (float*)(p.ws + WS_GATE);
    LAS unsigned* LST = (LAS unsigned*)(lds + wid * RT2_WSZ);
    const int tok = lane & 15, grp = lane >> 4;
    for (int task = bid * NWAVE + wid; task < (T / 16) * 2; task += nblk * NWAVE) {
        const int t0 = (task >> 1) * 16, hq = task & 1;
#pragma unroll 1
        for (int hl = 0; hl < 4; ++hl) {
            const int h = hq * 4 + hl;
#pragma unroll 1
            for (int c = 0; c < 2; ++c) {
                const bf16_t* qp = pq + (size_t)(t0 + tok) * D + h * 128 + c * 64 + 8 * grp;
                bf16x8 bq[2];
#pragma unroll
                for (int ks = 0; ks < 2; ++ks) bq[ks] = *(const bf16x8*)(qp + 32 * ks);
                unsigned v[32];
#pragma unroll
                for (int mt = 0; mt < 8; ++mt) {
                    const bf16_t* kp = keys + ((size_t)(h * 2 + c) * 128 + 16 * mt + tok) * 64 + 8 * grp;
                    f32x4 acc = (f32x4){0.f, 0.f, 0.f, 0.f};
                    acc = __builtin_amdgcn_mfma_f32_16x16x32_bf16(*(const bf16x8*)kp, bq[0], acc, 0, 0, 0);
                    acc = __builtin_amdgcn_mfma_f32_16x16x32_bf16(*(const bf16x8*)(kp + 32), bq[1], acc, 0, 0, 0);
#pragma unroll
                    for (int r = 0; r < 4; ++r) { const int n = 16 * mt + 4 * grp + r; v[4 * mt + r] = (sortable(acc[r]) & 0xffffff80u) | (unsigned)(127 - n); }
                }
                bitonic_sort_desc<32>(v);
                unsigned m[16];
#pragma unroll
                for (int i = 0; i < 16; ++i) m[i] = umax_(v[i], (unsigned)__shfl_xor((int)v[15 - i], 16));
                bitonic_merge16_desc(m);
                unsigned m2[16];
#pragma unroll
                for (int i = 0; i < 16; ++i) m2[i] = umax_(m[i], (unsigned)__shfl_xor((int)m[15 - i], 32));
                bitonic_merge16_desc(m2);
                if (grp == 0) {
#pragma unroll
                    for (int i = 0; i < 16; ++i) LST[(hl * 32 + c * 16 + i) * 16 + hl * 16 + tok] = m2[i];
                }
            }
        }
        asm volatile("s_waitcnt lgkmcnt(0)" ::: "memory");
        {
            const int lb = grp * 32 * 16 + grp * 16 + tok;
            float av[16], bv[16];
#pragma unroll
            for (int i = 0; i < 16; ++i) { av[i] = unsortable(LST[lb + i * 16] & 0xffffff80u); bv[i] = unsortable(LST[lb + (16 + i) * 16] & 0xffffff80u); }
            unsigned top[16];
#pragma unroll
            for (int i = 0; i < 16; ++i) top[i] = 0u;
#pragma unroll
            for (int i = 0; i < 16; ++i)
#pragma unroll
                for (int j = 0; j < 16; ++j) if ((i + 1) * (j + 1) <= 16) {
                    unsigned x = (sortable(av[i] + bv[j]) & 0xffffff00u) | (unsigned)(255 - (i * 16 + j));
#pragma unroll
                    for (int q = 0; q < 16; ++q) { const unsigned hi = umax_(top[q], x); x = umin_(top[q], x); top[q] = hi; }
                }
            float val[16]; int ex[16]; float mx = -INFINITY;
#pragma unroll
            for (int q = 0; q < 16; ++q) { const int code = 255 - (int)(top[q] & 0xffu); val[q] = unsortable(top[q] & 0xffffff00u); mx = fmaxf(mx, val[q]);
                const int i1 = 127 - (int)(LST[lb + (code >> 4) * 16] & 0x7fu), i2 = 127 - (int)(LST[lb + (16 + (code & 15)) * 16] & 0x7fu); ex[q] = i1 * 128 + i2; }
            float sum = 0.f;
#pragma unroll
            for (int q = 0; q < 16; ++q) { val[q] = __expf(val[q] - mx); sum += val[q]; }
            const float inv = 1.f / sum;
            const size_t o = (size_t)(t0 + tok) * 128 + (hq * 4 + grp) * 16;
            u32x4 e0, e1; e0.x = (unsigned)ex[0] | ((unsigned)ex[1] << 16); e0.y = (unsigned)ex[2] | ((unsigned)ex[3] << 16); e0.z = (unsigned)ex[4] | ((unsigned)ex[5] << 16); e0.w = (unsigned)ex[6] | ((unsigned)ex[7] << 16);
            e1.x = (unsigned)ex[8] | ((unsigned)ex[9] << 16); e1.y = (unsigned)ex[10] | ((unsigned)ex[11] << 16); e1.z = (unsigned)ex[12] | ((unsigned)ex[13] << 16); e1.w = (unsigned)ex[14] | ((unsigned)ex[15] << 16);
            if (!dry) { *(u32x4*)(eidx + o) = e0; *(u32x4*)(eidx + o + 8) = e1;
#pragma unroll
                for (int q = 0; q < 4; ++q) *(f32x4*)(gate + o + 4 * q) = (f32x4){val[4 * q] * inv, val[4 * q + 1] * inv, val[4 * q + 2] * inv, val[4 * q + 3] * inv}; }
            else { KEEP4(e0); KEEP4(e1); KEEP1(inv); }
        }
        asm volatile("s_waitcnt lgkmcnt(0)" ::: "memory");
    }
}

constexpr int EX_WSZ = 1024 + 512 + 512;
__device__ __forceinline__ float gelu_exact(float x) { return 0.5f * x * (1.f + erff(x * 0.7071067811865476f)); }
__device__ __forceinline__ void expert_phase(const Params& p, LAS unsigned char* lds, int bid, int nblk, bool dry) {
    const int tid = threadIdx.x, lane = tid & 63, wid = tid >> 6;
    const bf16_t* h2 = (const bf16_t*)(p.ws + WS_H2); const unsigned char* ut = p.ws + WS_UT; const unsigned char* vt = p.ws + WS_VT;
    const unsigned short* eidx = (const unsigned short*)(p.ws + WS_EIDX); const float* gate = (const float*)(p.ws + WS_GATE); const float* mod = (const float*)(p.ws + WS_MOD);
    LAS unsigned char* H8 = lds + wid * EX_WSZ; LAS float* ACT = (LAS float*)(lds + wid * EX_WSZ + 1024); LAS int* EI = (LAS int*)(lds + wid * EX_WSZ + 1536);
    for (int t = bid * NWAVE + wid; t < T; t += nblk * NWAVE) {
        const int b = t / S;
        {
            f32x4 a0, a1, a2, a3; ld_bf16x8(h2 + (size_t)t * D + 16 * lane, a0, a1); ld_bf16x8(h2 + (size_t)t * D + 16 * lane + 8, a2, a3);
            u32x4 o; int w;
            w = __builtin_amdgcn_cvt_pk_fp8_f32(a0.x, a0.y, 0, false); w = __builtin_amdgcn_cvt_pk_fp8_f32(a0.z, a0.w, w, true); o.x = (unsigned)w;
            w = __builtin_amdgcn_cvt_pk_fp8_f32(a1.x, a1.y, 0, false); w = __builtin_amdgcn_cvt_pk_fp8_f32(a1.z, a1.w, w, true); o.y = (unsigned)w;
            w = __builtin_amdgcn_cvt_pk_fp8_f32(a2.x, a2.y, 0, false); w = __builtin_amdgcn_cvt_pk_fp8_f32(a2.z, a2.w, w, true); o.z = (unsigned)w;
            w = __builtin_amdgcn_cvt_pk_fp8_f32(a3.x, a3.y, 0, false); w = __builtin_amdgcn_cvt_pk_fp8_f32(a3.z, a3.w, w, true); o.w = (unsigned)w;
            *(LAS u32x4*)(H8 + 16 * lane) = o;
        }
        { const unsigned w = *(const unsigned*)(eidx + (size_t)t * 128 + 2 * lane); EI[2 * lane] = (int)(w & 0xffffu); EI[2 * lane + 1] = (int)(w >> 16); }
        asm volatile("s_waitcnt lgkmcnt(0)" ::: "memory");
#pragma unroll 1
        for (int g = 0; g < 8; ++g) {
            const int e = EI[g * 16 + (lane & 15)];
            const unsigned char* up = ut + (size_t)e * D + 16 * (lane >> 4);
            f32x4 acc = (f32x4){0.f, 0.f, 0.f, 0.f};
#pragma unroll
            for (int ks = 0; ks < 16; ++ks) {
                const u32x4 av = *(const u32x4*)(up + 64 * ks); const u32x4 bv = *(const LAS u32x4*)(H8 + 64 * ks + 16 * (lane >> 4));
                const long a0 = (long)(((unsigned long long)av.y << 32) | av.x), a1 = (long)(((unsigned long long)av.w << 32) | av.z);
                const long b0 = (long)(((unsigned long long)bv.y << 32) | bv.x), b1 = (long)(((unsigned long long)bv.w << 32) | bv.z);
                acc = __builtin_amdgcn_mfma_f32_16x16x32_fp8_fp8(a0, b0, acc, 0, 0, 0);
                acc = __builtin_amdgcn_mfma_f32_16x16x32_fp8_fp8(a1, b1, acc, 0, 0, 0);
            }
            if ((lane & 15) == 0) *(LAS f32x4*)(ACT + g * 16 + (lane >> 4) * 4) = acc * (1.f / U_SCALE);
        }
        asm volatile("s_waitcnt lgkmcnt(0)" ::: "memory");
        { const f32x2 dv = *(const LAS f32x2*)(ACT + 2 * lane); const f32x2 gv = *(const f32x2*)(gate + (size_t)t * 128 + 2 * lane);
          asm volatile("s_waitcnt lgkmcnt(0)" ::: "memory");
          *(LAS f32x2*)(ACT + 2 * lane) = (f32x2){gelu_exact(dv.x) * gv.x * (1.f / V_SCALE), gelu_exact(dv.y) * gv.y * (1.f / V_SCALE)}; }
        asm volatile("s_waitcnt lgkmcnt(0)" ::: "memory");
        float y[16];
#pragma unroll
        for (int j = 0; j < 16; ++j) y[j] = 0.f;
        for (int e0 = 0; e0 < 128; e0 += 8) {
            u32x4 w[8]; float a[8];
#pragma unroll
            for (int j = 0; j < 8; ++j) { w[j] = *(const u32x4*)(vt + (size_t)EI[e0 + j] * D + 16 * lane); a[j] = ACT[e0 + j]; }
#pragma unroll
            for (int j = 0; j < 8; ++j)
#pragma unroll
                for (int q = 0; q < 4; ++q) { const f32x2 lo = __builtin_amdgcn_cvt_pk_f32_fp8((int)w[j][q], false), hi = __builtin_amdgcn_cvt_pk_f32_fp8((int)w[j][q], true);
                    y[4 * q + 0] += a[j] * lo.x; y[4 * q + 1] += a[j] * lo.y; y[4 * q + 2] += a[j] * hi.x; y[4 * q + 3] += a[j] * hi.y; }
        }
        float* row = p.out + (size_t)t * D + 16 * lane; const float* g2 = mod + b * 6144 + 5120 + 16 * lane;
        float v[16]; float s = 0.f;
#pragma unroll
        for (int q = 0; q < 4; ++q) { const f32x4 xv = *(const f32x4*)(row + 4 * q), gv = *(const f32x4*)(g2 + 4 * q);
            v[4 * q + 0] = xv.x * DN_ALPHA + gv.x * y[4 * q + 0]; v[4 * q + 1] = xv.y * DN_ALPHA + gv.y * y[4 * q + 1]; v[4 * q + 2] = xv.z * DN_ALPHA + gv.z * y[4 * q + 2]; v[4 * q + 3] = xv.w * DN_ALPHA + gv.w * y[4 * q + 3]; }
#pragma unroll
        for (int j = 0; j < 16; ++j) s += v[j];
        const float mean = wave_sum(s) * (1.f / D); float qq = 0.f;
#pragma unroll
        for (int j = 0; j < 16; ++j) { v[j] -= mean; qq += v[j] * v[j]; }
        const float rstd = rsqrtf(wave_sum(qq) * (1.f / D) + LN_EPS);
#pragma unroll
        for (int q = 0; q < 4; ++q) { const int c = 16 * lane + 4 * q; const f32x4 gv = *(const f32x4*)(p.ln2_g + c), bv = *(const f32x4*)(p.ln2_b + c);
            f32x4 o; o.x = v[4 * q + 0] * rstd * gv.x + bv.x; o.y = v[4 * q + 1] * rstd * gv.y + bv.y; o.z = v[4 * q + 2] * rstd * gv.z + bv.z; o.w = v[4 * q + 3] * rstd * gv.w + bv.w;
            if (!dry) *(f32x4*)(row + 4 * q) = o; else KEEP4(o); }
        asm volatile("s_waitcnt lgkmcnt(0)" ::: "memory");
    }
}

#define XB_TMO      128
#define XB_XCNT(j)  (256  + 64 * (j))
#define XB_XSUB(j)  (1280 + 64 * (j))
#define XB_XGEN(j)  (2304 + 64 * (j))
#define XB_TOP      3328
#define XB_TOPGEN   3392
#define XCD_BAR_WORDS 3456
#define XB_SPIN_CAP (1u << 18)
__device__ __forceinline__ unsigned xb_ld(unsigned* p)              { return __hip_atomic_load(p, __ATOMIC_RELAXED, __HIP_MEMORY_SCOPE_AGENT); }
__device__ __forceinline__ unsigned xb_add(unsigned* p, unsigned v) { return __hip_atomic_fetch_add(p, v, __ATOMIC_RELAXED, __HIP_MEMORY_SCOPE_AGENT); }
__device__ __forceinline__ unsigned xb_xcc_id() { return (unsigned)__builtin_amdgcn_s_getreg((3 << 11) | 20) & 0xFu; }
#define XB_SPIN(cond, bar) do { unsigned _sp = 0; while (cond) { __builtin_amdgcn_s_sleep(1); \
    if ((++_sp & 255u) == 0u) { if (xb_ld(&(bar)[XB_TMO])) break; if (_sp > XB_SPIN_CAP) { atomicAdd(&(bar)[XB_TMO], 1u); break; } } } } while (0)
struct XcdBarrier { unsigned* bar; unsigned x; volatile LAS unsigned* st; };
__device__ __forceinline__ XcdBarrier xcd_barrier_post(unsigned* bar, volatile LAS unsigned* st) {
    XcdBarrier b; b.bar = bar; b.x = xb_xcc_id(); b.st = st;
    if (threadIdx.x == 0) (void)xb_add(&bar[XB_XCNT(b.x)], 1u);
    return b;
}
__device__ __forceinline__ void xcd_barrier_complete(unsigned* bar, unsigned x, unsigned& nloc, unsigned& nx) {
    const unsigned G = gridDim.x * gridDim.y * gridDim.z;
    unsigned sum, cnt, mine, sp = 0u;
    for (;;) {
        sum = 0u; cnt = 0u; mine = 0u;
#pragma unroll
        for (unsigned j = 0; j < 16; ++j) { const unsigned c = xb_ld(&bar[XB_XCNT(j)]); sum += c; cnt += (c > 0u) ? 1u : 0u; mine = (j == x) ? c : mine; }
        if (sum == G) break;
        __builtin_amdgcn_s_sleep(1);
        if ((++sp & 255u) == 0u) { if (xb_ld(&bar[XB_TMO])) break; if (sp > XB_SPIN_CAP) { atomicAdd(&bar[XB_TMO], 1u); break; } }
    }
    nloc = mine > 0u ? mine : 1u; nx = cnt > 0u ? cnt : 1u;
}
__device__ __forceinline__ void xcd_barrier(const XcdBarrier& b) {
    asm volatile("s_waitcnt vmcnt(0)" ::: "memory");
    __syncthreads();
    if (threadIdx.x == 0) {
        unsigned* bar = b.bar;
        __builtin_amdgcn_s_waitcnt(0);
        unsigned nloc = b.st[0], nx = b.st[1];
        if (nloc == 0u) { xcd_barrier_complete(bar, b.x, nloc, nx); b.st[0] = nloc; b.st[1] = nx; }
        const unsigned old = xb_add(&bar[XB_XSUB(b.x)], 1u);
        const unsigned gen = old / nloc;
        if (old + 1u == (gen + 1u) * nloc) {
            __builtin_amdgcn_fence(__ATOMIC_RELEASE, "agent");
            asm volatile("s_waitcnt vmcnt(0)" ::: "memory");
            const unsigned og = xb_add(&bar[XB_TOP], 1u);
            const unsigned tg = og / nx;
            if (og + 1u == (tg + 1u) * nx) xb_add(&bar[XB_TOPGEN], 1u);
            else XB_SPIN(xb_ld(&bar[XB_TOPGEN]) == tg, bar);
            __builtin_amdgcn_fence(__ATOMIC_ACQUIRE, "agent");
            xb_add(&bar[XB_XGEN(b.x)], 1u);
            asm volatile("s_waitcnt vmcnt(0)" ::: "memory");
        } else {
            XB_SPIN(xb_ld(&bar[XB_XGEN(b.x)]) == gen, bar);
            __builtin_amdgcn_fence(__ATOMIC_ACQUIRE, "agent");
            asm volatile("s_waitcnt vmcnt(0)" ::: "memory");
        }
    }
    __syncthreads();
}

constexpr int NPHASE = 13;
__global__ void __launch_bounds__(NTHR) fwd_kernel(Params p) {
    extern __shared__ __attribute__((aligned(16))) unsigned char lds_raw[];
    LAS unsigned char* lds = (LAS unsigned char*)lds_raw;
    const int bid = blockIdx.x, nblk = gridDim.x;
    unsigned char* ws = p.ws;
#if MK_SINGLE
    volatile LAS unsigned* bst = (volatile LAS unsigned*)(lds + LDS_BYTES - 64);
    if (threadIdx.x < 2) bst[threadIdx.x] = 0u;
    __syncthreads();
    const XcdBarrier gbar = xcd_barrier_post((unsigned*)ws, bst);
#define GRID_SYNC() xcd_barrier(gbar)
#else
#define GRID_SYNC() do {} while (0)
#endif
#define PH(k) if (p.ph_lo <= (k) && (k) < p.ph_hi)
#define SEAM(k) if (p.ph_lo <= (k) && (k) + 1 < p.ph_hi) GRID_SYNC()
#define PROBE(k) if (p.probe_ph == (k))
#define PG8_RUN(Aptr, Btptr, Mm, Nn, Kk, FT, ...) PG8_RUN_G(nblk, bid, Aptr, Btptr, Mm, Nn, Kk, FT, __VA_ARGS__)
#define PG8_RUN_G(GG, CC, Aptr, Btptr, Mm, Nn, Kk, FT, ...) { pg8::Gemm g{(const pg8::bf16_t*)(Aptr), (const pg8::bf16_t*)(Btptr), Mm, Nn, Kk}; pg8::StaticOrder so; so.init(Mm, Nn, GG, CC); \
        pg8::EpiRow8<FT> e{FT{__VA_ARGS__}}; pg8::gemm_phase<pg8::EpiRow8<FT>, pg8::StaticOrder, true, true>(lds, g, so, e); }
#define RUN3(dry) PG8_RUN(ws + WS_H1, ws + WS_WIN, T, NPAD, D, FInproj, (bf16_t*)(ws + WS_ZRKV), (bf16_t*)(ws + WS_ZLORA), (bf16_t*)(ws + WS_ZQ), (bf16_t*)(ws + WS_ZMISC), (bf16_t*)(ws + WS_QIDX), (bf16_t*)(ws + WS_GA), (bf16_t*)(ws + WS_GB), dry)
#define RUN4P(dry) { dsa_norm_rows(p, bid, nblk, dry); for (int u = bid; u < (T / 64) * 8; u += nblk) rwkv_chunk_unit(p, lds, u >> 3, u & 7, dry); }
#define DSA_NS 586
#define DSA_ND 3510
#define RUN4(dry) { dsa_tables(p, lds); \
        if (bid < 64) { if (!dry) rwkv_state_out_pass(p, lds, bid >> 3, bid & 7); \
               for (int e = DSA_NS - 1 - bid; e >= 0; e -= 64) dsa_unit(p, lds, 7 * e, dry); } \
        else { for (int e = DSA_ND - 1 - (bid - 64); e >= 0; e -= (nblk - 64)) dsa_unit(p, lds, 7 * (e / 6) + (e % 6) + 1, dry); peer_tables(p, bid - 64, nblk - 64, dry); } }
#define RUN5(dry) PG8_RUN(ws + WS_ZQ, ws + WS_WB, T, D, D, FBrA, (bf16_t*)(ws + WS_GB), dry)
#define RUN6(dry) { PG8_RUN(ws + WS_YA, ws + WS_WA, T, D, 512, FBrB, (bf16_t*)(ws + WS_GA), (const bf16_t*)(ws + WS_GB), dry) }
#define RUN7(dry) PG8_RUN(ws + WS_GA, ws + WS_WO, T, D, D, FOut, p.x, (const float*)(ws + WS_MOD), p.out, dry)
#define RUN9(dry) PG8_RUN(ws + WS_H2, ws + WS_WPQ, T, D, D, FPq, (bf16_t*)(ws + WS_PQ), dry)
    PROBE(100) { phase_prep(p, lds, bid, nblk, false); GRID_SYNC(); }
    PH(0) { phase_prep(p, lds, bid, nblk, false); } SEAM(0);
    PH(1) { phase_modsum(p, bid, nblk); } SEAM(1);
    PROBE(102) { phase_h1(p, bid, nblk); GRID_SYNC(); }
    PH(2) { phase_h1(p, bid, nblk); } SEAM(2);
    PROBE(3) { RUN3(1); GRID_SYNC(); }
    PROBE(103) { RUN3(0); GRID_SYNC(); }
    PH(3) RUN3(0) SEAM(3);
    PROBE(42) { RUN4P(true); GRID_SYNC(); }
    if (p.probe_ph >= 420 && p.probe_ph < 430) { RUN4P(true); GRID_SYNC(); }
    PH(12) RUN4P(false) if (p.ph_lo <= 12 && 12 < p.ph_hi) GRID_SYNC();
    PROBE(4) { RUN4(true); GRID_SYNC(); }
    PROBE(43) { if (bid >= 64) { dsa_tables(p, lds); for (int u = (T / 8 - 1) - (bid - 64); u >= 0; u -= (nblk - 64)) dsa_unit(p, lds, u, true, 1); } GRID_SYNC(); }
    PROBE(44) { if (bid >= 64) { dsa_tables(p, lds); for (int u = (T / 8 - 1) - (bid - 64); u >= 0; u -= (nblk - 64)) dsa_unit(p, lds, u, true, 2); } GRID_SYNC(); }
    PROBE(45) { if (bid >= 64) { dsa_tables(p, lds); for (int u = (T / 8 - 1) - (bid - 64); u >= 0; u -= (nblk - 64)) dsa_unit(p, lds, u, true, 3); } GRID_SYNC(); }
    PROBE(46) { if (bid >= 64) { dsa_tables(p, lds); for (int u = (T / 8 - 1) - (bid - 64); u >= 0; u -= (nblk - 64)) dsa_unit(p, lds, u, true, 4); } GRID_SYNC(); }
    PROBE(41) { if (bid >= 64) { dsa_tables(p, lds); for (int u = (T / 8 - 1) - (bid - 64); u >= 0; u -= (nblk - 64)) dsa_unit(p, lds, u, true); } GRID_SYNC(); }
    PH(4) RUN4(false) SEAM(4);
    PROBE(5) { RUN5(1); GRID_SYNC(); }
    PH(5) RUN5(0)
    PROBE(6) { RUN6(1); GRID_SYNC(); }
    PH(6) RUN6(0) SEAM(6);
    PROBE(7) { RUN7(1); GRID_SYNC(); }
    PH(7) RUN7(0) SEAM(7);
    PH(8) { phase_ln1(p, bid, nblk); } SEAM(8);
    PROBE(9) { RUN9(1); GRID_SYNC(); }
    PH(9) RUN9(0) SEAM(9);
    PROBE(10) { route_phase(p, lds, bid, nblk, true); GRID_SYNC(); }
    PROBE(110) { route_phase(p, lds, bid, nblk, false); GRID_SYNC(); }
    PH(10) { route_phase(p, lds, bid, nblk, false); } SEAM(10);
    PROBE(11) { expert_phase(p, lds, bid, nblk, true); GRID_SYNC(); }
    PH(11) { expert_phase(p, lds, bid, nblk, false); }
}

extern "C" void kernel_launch(void* const* d_in, const int* in_sizes, int n_in, void* d_out, int out_size, void* d_ws, size_t ws_size, hipStream_t stream) {
    static int grid = 0;
    if (grid == 0) {
        if (n_in != 31 || out_size != T * D || ws_size < WS_NEED) { fprintf(stderr, "kernel_launch: unexpected shapes (n_in %d, out %d, ws %zu)\n", n_in, out_size, ws_size); grid = -1; return; }
        int dev = 0, cus = 0, per_cu = 0;
        (void)hipGetDevice(&dev); (void)hipDeviceGetAttribute(&cus, hipDeviceAttributeMultiprocessorCount, dev);
        if (hipFuncSetAttribute((const void*)fwd_kernel, hipFuncAttributeMaxDynamicSharedMemorySize, LDS_BYTES) != hipSuccess) { fprintf(stderr, "kernel_launch: hipFuncSetAttribute failed\n"); grid = -1; return; }
        if (hipOccupancyMaxActiveBlocksPerMultiprocessor(&per_cu, (const void*)fwd_kernel, NTHR, LDS_BYTES) != hipSuccess || per_cu < 1) { fprintf(stderr, "kernel_launch: occupancy query failed (%d)\n", per_cu); grid = -1; return; }
        grid = cus * (per_cu > 1 ? 1 : per_cu);
        fprintf(stderr, "kernel_launch: %d CUs, %d blocks/CU reported, grid %d\n", cus, per_cu, grid);
    }
    if (grid < 0) return;
    if (hipMemsetAsync(d_ws, 0, 16384, stream) != hipSuccess) { fprintf(stderr, "kernel_launch: memset failed\n"); return; }
    Params p{};
    const float** f = (const float**)&p;
    for (int i = 0; i < 31; ++i) f[i] = (const float*)d_in[i];
    p.out = (float*)d_out; p.ws = (unsigned char*)d_ws; p.probe_ph = PROBE_PHASE;
#if MK_SINGLE
    p.ph_lo = 0; p.ph_hi = NPHASE;
    void* args[] = {&p};
    hipError_t e = hipLaunchCooperativeKernel((const void*)fwd_kernel, dim3(grid), dim3(NTHR), args, LDS_BYTES, stream);
    if (e != hipSuccess) fprintf(stderr, "kernel_launch: cooperative launch failed: %s (grid %d)\n", hipGetErrorString(e), grid);
#else
    for (int ph = 0; ph < NPHASE; ++ph) { p.ph_lo = ph; p.ph_hi = ph + 1; hipLaunchKernelGGL(fwd_kernel, dim3(grid), dim3(NTHR), LDS_BYTES, stream, p); }
#endif
}
```

```cpp
#include <hip/hip_runtime.h>
#include <hip/hip_cooperative_groups.h>
#include <cstdio>
#include <cstdint>
namespace cg = cooperative_groups;

#ifndef PROBE_PHASE
#define PROBE_PHASE -1
#endif
#ifndef MK_SINGLE
#define MK_SINGLE 1
#endif

#define LAS __attribute__((address_space(3)))
typedef unsigned short bf16_t;
typedef short bf16x8 __attribute__((ext_vector_type(8)));
typedef float f32x4 __attribute__((ext_vector_type(4)));
typedef float f32x2 __attribute__((ext_vector_type(2)));
typedef unsigned u32x4 __attribute__((ext_vector_type(4)));
typedef unsigned u32x2 __attribute__((ext_vector_type(2)));

constexpr int D = 1024, NB = 8, S = 4096, T = NB * S;
constexpr int RW_H = 8, RW_N = 64, RW_DIM = 512;
constexpr int IN_COLS = 5316, NPAD = 5376;
constexpr int TOPK = 256;
constexpr int PEER_E = 16384;
constexpr float LN_EPS = 1e-5f;
constexpr float DN_ALPHA = 1.189207115002721f;
constexpr float RW_GN_EPS = 64e-5f;
constexpr int NTHR = 512, NWAVE = 8;
constexpr int LDS_BYTES = 147456;

constexpr size_t MiB = 1u << 20;
constexpr size_t WS_MODP = 90 * MiB;
constexpr size_t WS_MOD = 4 * MiB;
constexpr size_t WS_WIN = 5 * MiB;
constexpr size_t WS_WA = 16 * MiB;
constexpr size_t WS_WB = 17 * MiB;
constexpr size_t WS_WO = 19 * MiB;
constexpr size_t WS_WPQ = 21 * MiB;
constexpr size_t WS_W2T = 23 * MiB;
constexpr size_t WS_A2T = WS_W2T + 65536;
constexpr size_t WS_G2T = WS_A2T + 65536;
constexpr size_t WS_KEYS = WS_G2T + 131072;
constexpr size_t WS_UT = 24 * MiB;
constexpr size_t WS_VT = 40 * MiB;
constexpr float U_SCALE = 64.f, V_SCALE = 8.f;
constexpr size_t WS_ZRKV = 88 * MiB;
constexpr size_t WS_ZLORA = 184 * MiB;
constexpr size_t WS_ZQ = 200 * MiB;
constexpr size_t WS_GA = 264 * MiB;
constexpr size_t WS_GB = 328 * MiB;
constexpr size_t WS_CKV = 392 * MiB;
constexpr size_t WS_KIDX = 400 * MiB;
constexpr size_t WS_WIDX = 404 * MiB;
constexpr size_t WS_QIDX = 405 * MiB;
constexpr size_t WS_H1 = 421 * MiB;
constexpr size_t WS_YA = 421 * MiB;
constexpr size_t WS_SEL = 453 * MiB;
constexpr size_t WS_CNT = 469 * MiB;
constexpr size_t WS_H2 = 88 * MiB;
constexpr size_t WS_PQ = 200 * MiB;
constexpr size_t WS_EIDX = 328 * MiB;
constexpr size_t WS_GATE = 336 * MiB;
constexpr size_t WS_RG = 453 * MiB;
constexpr size_t WS_ZMISC = 485 * MiB;
constexpr size_t WS_NEED = 502 * MiB;

__device__ __forceinline__ unsigned f2bf(float f) { unsigned u = __float_as_uint(f); return (u + 0x7fffu + ((u >> 16) & 1u)) >> 16; }
__device__ __forceinline__ unsigned pk2(float lo, float hi) { return f2bf(lo) | (f2bf(hi) << 16); }
__device__ __forceinline__ unsigned pk2h(float lo, float hi) { unsigned r; asm("s_nop 1\n\tv_cvt_pk_bf16_f32 %0, %1, %2" : "=v"(r) : "v"(lo), "v"(hi)); return r; }
__device__ __forceinline__ float bf2f(bf16_t b) { return __uint_as_float((unsigned)b << 16); }
__device__ __forceinline__ float bflo(unsigned w) { return __uint_as_float(w << 16); }
__device__ __forceinline__ float bfhi(unsigned w) { return __uint_as_float(w & 0xffff0000u); }
__device__ __forceinline__ float sigmoidf_(float x) { return __builtin_amdgcn_rcpf(1.f + __expf(-x)); }
__device__ __forceinline__ float tanh_fast(float x) { return 1.f - 2.f * __builtin_amdgcn_rcpf(1.f + __expf(2.f * x)); }
__device__ __forceinline__ float wave_sum(float v) {
#pragma unroll
    for (int o = 1; o < 64; o <<= 1) v += __shfl_xor(v, o);
    return v;
}
template <int CTRL> __device__ __forceinline__ float dppf(float x) {
    return __int_as_float(__builtin_amdgcn_update_dpp(0, __float_as_int(x), CTRL, 0xf, 0xf, true));
}
__device__ __forceinline__ float red8(float x) { x += dppf<0xB1>(x); x += dppf<0x4E>(x); x += dppf<0x141>(x); return x; }
__device__ __forceinline__ float red16_sum(float x) { x += dppf<0xB1>(x); x += dppf<0x4E>(x); x += dppf<0x141>(x); x += dppf<0x140>(x); return x; }
__device__ __forceinline__ float red16_max(float x) { x = fmaxf(x, dppf<0xB1>(x)); x = fmaxf(x, dppf<0x4E>(x)); x = fmaxf(x, dppf<0x141>(x)); x = fmaxf(x, dppf<0x140>(x)); return x; }
__device__ __forceinline__ void st_bf16x4(bf16_t* p, f32x4 v) { u32x2 w; w.x = pk2(v.x, v.y); w.y = pk2(v.z, v.w); *(u32x2*)p = w; }
__device__ __forceinline__ unsigned umax_(unsigned a, unsigned b) { return a > b ? a : b; }
__device__ __forceinline__ unsigned umin_(unsigned a, unsigned b) { return a < b ? a : b; }
__device__ __forceinline__ unsigned sortable(float f) { const unsigned u = __float_as_uint(f); return u ^ ((unsigned)((int)u >> 31) | 0x80000000u); }

__device__ __forceinline__ f32x4 ld_bf16x4(const bf16_t* p) { const u32x2 w = *(const u32x2*)p; return (f32x4){bflo(w.x), bfhi(w.x), bflo(w.y), bfhi(w.y)}; }
__device__ __forceinline__ void ld_bf16x8(const bf16_t* p, f32x4& a, f32x4& b) { const u32x4 w = *(const u32x4*)p; a = (f32x4){bflo(w.x), bfhi(w.x), bflo(w.y), bfhi(w.y)}; b = (f32x4){bflo(w.z), bfhi(w.z), bflo(w.w), bfhi(w.w)}; }
#define KEEP1(x) asm volatile("" :: "v"(x))
#define KEEP4(v) asm volatile("" :: "v"((v).x), "v"((v).y), "v"((v).z), "v"((v).w))
struct Params {
    const float *x, *c, *w_ada, *b_ada, *w_in, *rw_mu, *rw_w0, *rw_w2, *rw_a0, *rw_a2, *rw_g2, *rw_k_k, *rw_k_a, *rw_r_k, *rw_gn_g, *rw_gn_b;
    const float *dsa_kv_g, *idx_k_g, *idx_k_b, *rel_bias, *w_br_a, *w_br_b, *w_out, *ln1_g, *ln1_b, *peer_wq, *peer_keys, *peer_u, *peer_v, *ln2_g, *ln2_b;
    float* out; unsigned char* ws;
    int ph_lo, ph_hi, probe_ph, pad;
};

__device__ __forceinline__ int win_src_col(int r) {
    if (r < 2944) return r;
    if (r < 3008) return r + 256;
    if (r < 3012) return r + 256;
    if (r < 3072) return -1;
    if (r < 3328) return r - 128;
    return r - 60;
}
template <bool WIN>
__device__ __forceinline__ void transpose_item(const float* W, int K, int N, bf16_t* WT, LAS float* scr, int item, int lane, int nrows, bool dry) {
    const int nblk = nrows / 32, kb = item / nblk, nb = item % nblk, k0 = 64 * kb, n0 = 32 * nb;
    const int rr = n0 + (lane & 31);
    const int sc = WIN ? win_src_col(rr) : rr;
#pragma unroll 8
    for (int i = 0; i < 32; ++i) { const int kk = 2 * i + (lane >> 5); scr[kk * 33 + (lane & 31)] = (sc >= 0) ? W[(size_t)(k0 + kk) * N + sc] : 0.f; }
    asm volatile("s_waitcnt lgkmcnt(0)" ::: "memory");
    const int c = lane & 7;
#pragma unroll
    for (int j = 0; j < 4; ++j) { const int n = (lane >> 3) + 8 * j; const LAS float* s = scr + (8 * c) * 33 + n;
        u32x4 o; o.x = pk2(s[0 * 33], s[1 * 33]); o.y = pk2(s[2 * 33], s[3 * 33]); o.z = pk2(s[4 * 33], s[5 * 33]); o.w = pk2(s[6 * 33], s[7 * 33]);
        if (!dry) *(u32x4*)(WT + (size_t)(n0 + n) * K + k0 + 8 * c) = o; }
    asm volatile("s_waitcnt lgkmcnt(0)" ::: "memory");
}

__device__ __forceinline__ void peer_tables(const Params& p, int bid, int nblk, bool dry) {
    const int tid = threadIdx.x; unsigned char* ws = p.ws;
    {
        const size_t gt = (size_t)bid * NTHR + tid, GT = (size_t)nblk * NTHR;
        constexpr size_t NU = (size_t)PEER_E * D / 16, NK = (size_t)8 * 2 * 128 * 64 / 16;
        for (size_t i = gt; i < 2 * NU + NK; i += GT) {
            if (i < 2 * NU) {
                const bool isv = i >= NU; const size_t j = isv ? i - NU : i;
                const float* src = (isv ? p.peer_v : p.peer_u) + j * 16; unsigned char* dst = ws + (isv ? WS_VT : WS_UT) + j * 16; const float sc = isv ? V_SCALE : U_SCALE;
                u32x4 o;
#pragma unroll
                for (int q = 0; q < 4; ++q) { const f32x4 a = *(const f32x4*)(src + 4 * q) * sc; int w = __builtin_amdgcn_cvt_pk_fp8_f32(a.x, a.y, 0, false); w = __builtin_amdgcn_cvt_pk_fp8_f32(a.z, a.w, w, true); o[q] = (unsigned)w; }
                if (!dry) *(u32x4*)dst = o; else KEEP4(o);
            } else {
                const size_t j = i - 2 * NU; const float* src = p.peer_keys + j * 16; bf16_t* dst = (bf16_t*)(ws + WS_KEYS) + j * 16;
#pragma unroll
                for (int hh = 0; hh < 2; ++hh) { const f32x4 a = *(const f32x4*)(src + 8 * hh), b = *(const f32x4*)(src + 8 * hh + 4);
                    u32x4 o; o.x = pk2(a.x, a.y); o.y = pk2(a.z, a.w); o.z = pk2(b.x, b.y); o.w = pk2(b.z, b.w); if (!dry) *(u32x4*)(dst + 8 * hh) = o; else KEEP4(o); }
            }
        }
    }
}
__device__ __forceinline__ void phase_prep(const Params& p, LAS unsigned char* lds, int bid, int nblk, bool dry) {
    const int tid = threadIdx.x, lane = tid & 63, wid = tid >> 6;
    const int gw = bid * NWAVE + wid, NGW = nblk * NWAVE;
    unsigned char* ws = p.ws;
    LAS float* scr = (LAS float*)(lds + wid * 16384);
    constexpr int I_IN = (D / 64) * (NPAD / 32), I_A = (512 / 64) * (D / 32), I_B = (D / 64) * (D / 32), I_W2 = 1 * (512 / 32), I_G2 = 2 * (512 / 32);
    constexpr int NIT = I_IN + I_A + 3 * I_B + 2 * I_W2 + I_G2;
    for (int it = gw; it < NIT; it += NGW) {
        int r = it;
        if (r < I_IN) { transpose_item<true>(p.w_in, D, IN_COLS, (bf16_t*)(ws + WS_WIN), scr, r, lane, NPAD, dry); continue; } r -= I_IN;
        if (r < I_A) { transpose_item<false>(p.w_br_a, 512, D, (bf16_t*)(ws + WS_WA), scr, r, lane, D, dry); continue; } r -= I_A;
        if (r < I_B) { transpose_item<false>(p.w_br_b, D, D, (bf16_t*)(ws + WS_WB), scr, r, lane, D, dry); continue; } r -= I_B;
        if (r < I_B) { transpose_item<false>(p.w_out, D, D, (bf16_t*)(ws + WS_WO), scr, r, lane, D, dry); continue; } r -= I_B;
        if (r < I_B) { transpose_item<false>(p.peer_wq, D, D, (bf16_t*)(ws + WS_WPQ), scr, r, lane, D, dry); continue; } r -= I_B;
        if (r < I_W2) { transpose_item<false>(p.rw_w2, 64, 512, (bf16_t*)(ws + WS_W2T), scr, r, lane, 512, dry); continue; } r -= I_W2;
        if (r < I_W2) { transpose_item<false>(p.rw_a2, 64, 512, (bf16_t*)(ws + WS_A2T), scr, r, lane, 512, dry); continue; } r -= I_W2;
        transpose_item<false>(p.rw_g2, 128, 512, (bf16_t*)(ws + WS_G2T), scr, r, lane, 512, dry);
    }
    {
        float* modp = (float*)(ws + WS_MODP); LAS float* SV = (LAS float*)lds;
        __syncthreads();
        for (int i = tid; i < 8 * D; i += NTHR) { const int b = i >> 10, k = i & 1023; const float cv = p.c[i]; SV[k * 8 + b] = cv * __builtin_amdgcn_rcpf(1.f + __expf(-cv)); }
        __syncthreads();
        for (int it = gw; it < 64 * 24; it += NGW) {
            const int kb = it / 24, jb = it % 24;
            f32x4 w[16];
#pragma unroll
            for (int i = 0; i < 16; ++i) w[i] = *(const f32x4*)(p.w_ada + (size_t)(kb * 16 + i) * 6144 + jb * 256 + 4 * lane);
            f32x4 acc[8];
#pragma unroll
            for (int b = 0; b < 8; ++b) acc[b] = (f32x4){0.f, 0.f, 0.f, 0.f};
#pragma unroll
            for (int i = 0; i < 16; ++i) { const f32x4 s0 = *(const LAS f32x4*)(SV + (kb * 16 + i) * 8), s1 = *(const LAS f32x4*)(SV + (kb * 16 + i) * 8 + 4);
                acc[0] += w[i] * s0.x; acc[1] += w[i] * s0.y; acc[2] += w[i] * s0.z; acc[3] += w[i] * s0.w; acc[4] += w[i] * s1.x; acc[5] += w[i] * s1.y; acc[6] += w[i] * s1.z; acc[7] += w[i] * s1.w; }
#pragma unroll
            for (int b = 0; b < 8; ++b) if (!dry) *(f32x4*)(modp + ((size_t)kb * 8 + b) * 6144 + jb * 256 + 4 * lane) = acc[b];
        }
    }
}
__device__ __forceinline__ void phase_modsum(const Params& p, int bid, int nblk) {
    const float* modp = (const float*)(p.ws + WS_MODP); float* mod = (float*)(p.ws + WS_MOD);
    for (int i = bid * NTHR + threadIdx.x; i < 8 * 6144; i += nblk * NTHR) {
        const int b = i / 6144, j = i % 6144; float s = p.b_ada[j];
#pragma unroll
        for (int kb = 0; kb < 64; ++kb) s += modp[((size_t)kb * 8 + b) * 6144 + j];
        mod[i] = s;
    }
}
__device__ __forceinline__ void phase_h1(const Params& p, int bid, int nblk) {
    const int lane = threadIdx.x & 63, wid = threadIdx.x >> 6;
    const float* mod = (const float*)(p.ws + WS_MOD); bf16_t* h1 = (bf16_t*)(p.ws + WS_H1);
    for (int m = bid * NWAVE + wid; m < T; m += nblk * NWAVE) {
        const int b = m / S; const float* sh = mod + b * 6144, *sc = sh + 1024;
#pragma unroll
        for (int j = 0; j < 4; ++j) { const int c0 = 4 * lane + 256 * j;
            const f32x4 xv = *(const f32x4*)(p.x + (size_t)m * D + c0), s1 = *(const f32x4*)(sc + c0), s0 = *(const f32x4*)(sh + c0);
            st_bf16x4(h1 + (size_t)m * D + c0, xv * (1.f + s1) + s0); }
    }
}

namespace pg8 {
#define PG8_LAS __attribute__((address_space(3)))
typedef unsigned short bf16_t;
typedef short bf16x8 __attribute__((ext_vector_type(8)));
typedef float f32x4 __attribute__((ext_vector_type(4)));
typedef unsigned u32x4 __attribute__((ext_vector_type(4)));
constexpr int BM = 256, BK = 64, HALF = 128, HTB = HALF * BK * 2  , STAGE_BYTES = 8 * HTB, NXCD = 8, WGM = 8;

__host__ __device__ __forceinline__ int lds_byte(int r, int c) { const int st = (r >> 4) * 2 + (c >> 5), rr = r & 15, cc = c & 31, ob = rr * 64 + cc * 2; return st * 1024 + (ob ^ (((ob >> 9) & 1) << 5)); }
__host__ __device__ __forceinline__ void stage_rc(int b, int& R, int& C) { const int st = b / 1024, sb = b % 1024, swz = sb ^ (((sb >> 9) & 1) << 5); R = (st >> 1) * 16 + swz / 64; C = (st & 1) * 32 + (swz % 64) / 2; }
__host__ __device__ __forceinline__ int perm32(int rho) { const int n = rho >> 4, i = rho & 15; return 8 * (i >> 2) + 4 * n + (i & 3); }

struct Unit { int pm, pn; };
struct Gemm { const bf16_t* A; const bf16_t* Bt; int M, N, K; };

struct StaticOrder {
    int nM, nN, nwg, G, c;
    __host__ __device__ void init(int M, int N, int G_, int c_) { nM = M / BM; nN = N / BM; nwg = nM * nN; G = G_; c = c_; }
    __host__ __device__ bool next(int i, Unit& u) const {
        const long L = (long)i * G + c; if (L >= nwg) return false;
        int wgid = (int)L; { const int q = nwg / NXCD, r = nwg % NXCD, xcd = wgid % NXCD, off = wgid / NXCD; wgid = (xcd < r ? xcd * (q + 1) : r * (q + 1) + (xcd - r) * q) + off; }
        const int nig = WGM * nN, gid = wgid / nig, fm = gid * WGM, gsz = (nM - fm) < WGM ? (nM - fm) : WGM;
        u.pm = fm + ((wgid % nig) % gsz); u.pn = (wgid % nig) / gsz; return true;
    }
    __device__ __forceinline__ void a_ready(const Unit&) const {}
    __device__ __forceinline__ void done(const Unit&) const {}
};

__device__ __forceinline__ unsigned cvt_pk_bf16(float lo, float hi) { unsigned r; asm volatile("s_nop 0\n\tv_cvt_pk_bf16_f32 %0, %1, %2" : "=v"(r) : "v"(lo), "v"(hi)); return r; }
template <class Epi, class Sched, bool ALIGN_EPI = false, bool SP2 = false>
__device__ __forceinline__ void gemm_phase(PG8_LAS unsigned char* lds, const Gemm g, const Sched& S, const Epi& E) {
    const int tid = threadIdx.x, wid = __builtin_amdgcn_readfirstlane(tid >> 6), lane = tid & 63, wr = wid >> 2, wc = wid & 3, fr = lane & 15, fq = lane >> 4;
    const int K = g.K, nt = K / BK;
    unsigned voffA[2], voffB[2];
#pragma unroll
    for (int i = 0; i < 2; ++i) { int R, C; stage_rc(tid * 16 + i * 8192, R, C); const int Rb = Epi::PERM ? ((R & ~31) + perm32(R & 31)) : R;
        voffA[i] = (unsigned)(R * K + C) * 2u; voffB[i] = (unsigned)(Rb * K + C) * 2u; }
    const size_t kstep = (size_t)(BK * 2);
    const size_t hstep = (size_t)HALF * K * 2;
    const size_t tstep = 2 * hstep;
    const unsigned ldsw = (unsigned)wid * 1024u;
    const int aoff = lds_byte(wr * 64 + fr, fq * 8), boff = lds_byte(wc * 32 + fr, fq * 8);
#define PG8_SA(b, h) (((b) * 2 + (h)) * HTB)
#define PG8_SB(b, h) ((4 + (b) * 2 + (h)) * HTB)
#define PG8_STAGE(bufoff, gbase, voff) do { _Pragma("unroll") for (int _i = 0; _i < 2; ++_i) \
        __builtin_amdgcn_global_load_lds((const unsigned*)((const char*)(gbase) + (voff)[_i]), (PG8_LAS unsigned*)(lds + (bufoff) + ldsw + _i * 8192), 16, 0, 0); } while (0)
#define PG8_LDA(dst, b, h) do { _Pragma("unroll") for (int m = 0; m < 4; ++m) _Pragma("unroll") for (int k = 0; k < 2; ++k) dst[m][k] = *(const PG8_LAS bf16x8*)(lds + PG8_SA(b, h) + aoff + m * 2048 + k * 1024); } while (0)
#define PG8_LDB(dst, b, h) do { _Pragma("unroll") for (int n = 0; n < 2; ++n) _Pragma("unroll") for (int k = 0; k < 2; ++k) dst[n][k] = *(const PG8_LAS bf16x8*)(lds + PG8_SB(b, h) + boff + n * 2048 + k * 1024); } while (0)
#define PG8_MMA(ai, bj, At, Bt) do { __builtin_amdgcn_s_setprio(1); _Pragma("unroll") for (int m = 0; m < 4; ++m) _Pragma("unroll") for (int n = 0; n < 2; ++n) _Pragma("unroll") for (int k = 0; k < 2; ++k) \
        acc[ai][bj][m][n] = __builtin_amdgcn_mfma_f32_16x16x32_bf16(Bt[n][k], At[m][k], acc[ai][bj][m][n], 0, 0, 0); __builtin_amdgcn_s_setprio(0); } while (0)
#define PG8_WAIT_V(n) asm volatile("s_waitcnt vmcnt(" #n ")" ::: "memory")
#define PG8_WAIT_L(n) asm volatile("s_waitcnt lgkmcnt(" #n ")" ::: "memory")
#define PG8_BAR __builtin_amdgcn_s_barrier()
#define PG8_SCHED __builtin_amdgcn_sched_barrier(0)
    Unit cur, nxt; int ui = 0;
    if (!S.next(0, cur)) return;
    f32x4 acc[2][2][4][2];
#pragma unroll
    for (int a = 0; a < 2; ++a)
#pragma unroll
        for (int b = 0; b < 2; ++b)
#pragma unroll
            for (int m = 0; m < 4; ++m)
#pragma unroll
                for (int n = 0; n < 2; ++n) acc[a][b][m][n] = (f32x4){0.f, 0.f, 0.f, 0.f};
    bf16x8 At[4][2], B0[2][2], B1[2][2];
    const char* cA = (const char*)g.A + (size_t)cur.pm * tstep; const char* cB = (const char*)g.Bt + (size_t)cur.pn * tstep;
    S.a_ready(cur);
    if constexpr (SP2) {
        PG8_STAGE(PG8_SB(0, 0), cB, voffB); PG8_STAGE(PG8_SB(0, 1), cB + hstep, voffB); PG8_STAGE(PG8_SA(0, 0), cA, voffA); PG8_STAGE(PG8_SA(0, 1), cA + hstep, voffA);
        if (wr == 1) PG8_BAR;
        PG8_WAIT_V(2); PG8_BAR;
        PG8_STAGE(PG8_SB(1, 0), cB + kstep, voffB); PG8_STAGE(PG8_SA(1, 0), cA + kstep, voffA); PG8_STAGE(PG8_SB(1, 1), cB + hstep + kstep, voffB);
        PG8_WAIT_V(6); PG8_BAR;
    } else {
        PG8_STAGE(PG8_SB(0, 0), cB, voffB); PG8_STAGE(PG8_SA(0, 0), cA, voffA); PG8_STAGE(PG8_SB(0, 1), cB + hstep, voffB); PG8_STAGE(PG8_SA(0, 1), cA + hstep, voffA);
        if (wr == 1) PG8_BAR;
        PG8_WAIT_V(4); PG8_BAR;
        PG8_STAGE(PG8_SB(1, 0), cB + kstep, voffB); PG8_STAGE(PG8_SA(1, 0), cA + kstep, voffA); PG8_STAGE(PG8_SB(1, 1), cB + hstep + kstep, voffB);
        PG8_WAIT_V(6); PG8_BAR;
    }
    for (;;) {
        const bool has_next = S.next(ui + 1, nxt);
        const char* nA = has_next ? (const char*)g.A + (size_t)nxt.pm * tstep : cA; const char* nB = has_next ? (const char*)g.Bt + (size_t)nxt.pn * tstep : cB;
        for (int t = 0; t < nt; t += 2) {
            const bool last = (t == nt - 2);
            const char* a1 = cA + (size_t)(t + 1) * kstep;
            const char* a2 = last ? nA : cA + (size_t)(t + 2) * kstep; const char* b2 = last ? nB : cB + (size_t)(t + 2) * kstep;
            const char* a3 = a2 + kstep; const char* b3 = b2 + kstep;
            if (last && has_next) S.a_ready(nxt);
            if constexpr (SP2) {
            PG8_LDB(B0, 0, 0); PG8_LDB(B1, 0, 1); PG8_SCHED; PG8_LDA(At, 0, 0); PG8_STAGE(PG8_SA(1, 1), a1 + hstep, voffA);
            PG8_WAIT_V(8); PG8_WAIT_L(0); PG8_BAR; PG8_MMA(0, 0, At, B0); PG8_MMA(0, 1, At, B1); PG8_BAR; PG8_SCHED;
            PG8_LDA(At, 0, 1); PG8_STAGE(PG8_SB(0, 0), b2, voffB); PG8_STAGE(PG8_SB(0, 1), b2 + hstep, voffB); PG8_STAGE(PG8_SA(0, 0), a2, voffA);
            PG8_WAIT_V(8); PG8_WAIT_L(0); PG8_BAR; PG8_MMA(1, 0, At, B0); PG8_MMA(1, 1, At, B1); PG8_BAR; PG8_SCHED;
            PG8_LDB(B0, 1, 0); PG8_LDB(B1, 1, 1); PG8_SCHED; PG8_LDA(At, 1, 0); PG8_STAGE(PG8_SA(0, 1), a2 + hstep, voffA);
            PG8_WAIT_V(8); PG8_WAIT_L(0); PG8_BAR; PG8_MMA(0, 0, At, B0); PG8_MMA(0, 1, At, B1); PG8_BAR; PG8_SCHED;
            PG8_LDA(At, 1, 1); PG8_STAGE(PG8_SB(1, 0), b3, voffB); PG8_STAGE(PG8_SB(1, 1), b3 + hstep, voffB); PG8_STAGE(PG8_SA(1, 0), a3, voffA);
            PG8_WAIT_V(8); PG8_WAIT_L(0); PG8_BAR; PG8_MMA(1, 0, At, B0); PG8_MMA(1, 1, At, B1); PG8_BAR; PG8_SCHED;
            } else {
            PG8_LDB(B0, 0, 0); PG8_SCHED; PG8_LDA(At, 0, 0); PG8_STAGE(PG8_SA(1, 1), a1 + hstep, voffA);
            PG8_WAIT_L(8); PG8_BAR; PG8_WAIT_L(0); PG8_MMA(0, 0, At, B0); PG8_BAR; PG8_SCHED;
            PG8_LDB(B1, 0, 1); PG8_STAGE(PG8_SB(0, 0), b2, voffB);
            PG8_BAR; PG8_WAIT_L(0); PG8_MMA(0, 1, At, B1); PG8_BAR;
            PG8_LDA(At, 0, 1); PG8_STAGE(PG8_SA(0, 0), a2, voffA);
            PG8_BAR; PG8_WAIT_L(0); PG8_MMA(1, 0, At, B0); PG8_BAR; PG8_SCHED;
            PG8_STAGE(PG8_SB(0, 1), b2 + hstep, voffB);
            PG8_WAIT_V(6); PG8_BAR; PG8_MMA(1, 1, At, B1); PG8_BAR;
            PG8_LDB(B0, 1, 0); PG8_SCHED; PG8_LDA(At, 1, 0); PG8_STAGE(PG8_SA(0, 1), a2 + hstep, voffA);
            PG8_WAIT_L(8); PG8_BAR; PG8_WAIT_L(0); PG8_MMA(0, 0, At, B0); PG8_BAR; PG8_SCHED;
            PG8_LDB(B1, 1, 1); PG8_STAGE(PG8_SB(1, 0), b3, voffB);
            PG8_BAR; PG8_WAIT_L(0); PG8_MMA(0, 1, At, B1); PG8_BAR;
            PG8_LDA(At, 1, 1); PG8_STAGE(PG8_SA(1, 0), a3, voffA);
            PG8_BAR; PG8_WAIT_L(0); PG8_MMA(1, 0, At, B0); PG8_BAR; PG8_SCHED;
            PG8_STAGE(PG8_SB(1, 1), b3 + hstep, voffB);
            PG8_WAIT_V(6); PG8_BAR; PG8_MMA(1, 1, At, B1); PG8_BAR;
            }
        }
        if constexpr (ALIGN_EPI) { if (wr == 0) PG8_BAR; }
        if constexpr (!Epi::AFTER_DRAIN) { E(acc, cur, wr, wc, fr, fq); S.done(cur); }
        if (!has_next) break;
#pragma unroll
        for (int a = 0; a < 2; ++a)
#pragma unroll
            for (int b = 0; b < 2; ++b)
#pragma unroll
                for (int m = 0; m < 4; ++m)
#pragma unroll
                    for (int n = 0; n < 2; ++n) acc[a][b][m][n] = (f32x4){0.f, 0.f, 0.f, 0.f};
        cur = nxt; cA = nA; cB = nB; ++ui;
        if constexpr (ALIGN_EPI) { if (wr == 1) PG8_BAR; }
    }
    PG8_WAIT_V(0);
    if constexpr (!ALIGN_EPI) { if (wr == 0) PG8_BAR; }
    PG8_BAR;
    if constexpr (Epi::AFTER_DRAIN) { E.fused(acc, cur, wr, wc, fr, fq, lds, wid, lane); S.done(cur); }
#undef PG8_SA
#undef PG8_SB
#undef PG8_STAGE
#undef PG8_LDA
#undef PG8_LDB
#undef PG8_MMA
#undef PG8_WAIT_V
#undef PG8_WAIT_L
#undef PG8_BAR
#undef PG8_SCHED
}

template <class F> struct EpiRow8 {
    static constexpr bool PERM = true, AFTER_DRAIN = false; F f;
    __device__ __forceinline__ void operator()(const f32x4 (&acc)[2][2][4][2], const Unit& u, int wr, int wc, int fr, int fq) const {
        const int row0 = u.pm * BM + wr * 64 + fr, col0 = u.pn * BM + wc * 32 + 8 * fq;
        asm volatile("s_nop 7\n\ts_nop 7" ::: "memory"); __builtin_amdgcn_sched_barrier(0);
#pragma unroll
        for (int ai = 0; ai < 2; ++ai)
#pragma unroll
            for (int m = 0; m < 4; ++m)
#pragma unroll
                for (int bj = 0; bj < 2; ++bj) f(row0 + ai * HALF + m * 16, col0 + bj * HALF, acc[ai][bj][m][0], acc[ai][bj][m][1]);
    }
};
}
__device__ __forceinline__ u32x4 pk8(f32x4 a, f32x4 b) { u32x4 w; w.x = pg8::cvt_pk_bf16(a.x, a.y); w.y = pg8::cvt_pk_bf16(a.z, a.w); w.z = pg8::cvt_pk_bf16(b.x, b.y); w.w = pg8::cvt_pk_bf16(b.z, b.w); return w; }
__device__ __forceinline__ f32x4 sig4(f32x4 v) { f32x4 s; s.x = sigmoidf_(v.x); s.y = sigmoidf_(v.y); s.z = sigmoidf_(v.z); s.w = sigmoidf_(v.w); return s; }
#define F_DRY if (dry) { KEEP4(v0); KEEP4(v1); return; }
struct FInproj { bf16_t *zrkv, *zlora, *zq, *zmisc, *qidx, *ga, *gb; int dry;
    __device__ __forceinline__ void operator()(int row, int col, f32x4 v0, f32x4 v1) const { F_DRY
        if (col < 1536) *(u32x4*)(zrkv + (size_t)row * 1536 + col) = pk8(v0, v1);
        else if (col < 1792) *(u32x4*)(zlora + (size_t)row * 256 + (col - 1536)) = pk8(v0, v1);
        else if (col < 2816) *(u32x4*)(zq + (size_t)row * 1024 + (col - 1792)) = pk8(v0 * 0.12751743082459868f, v1 * 0.12751743082459868f);
        else if (col < 3072) *(u32x4*)(zmisc + (size_t)row * 256 + (col - 2816)) = pk8(v0, v1);
        else if (col < 3328) *(u32x4*)(qidx + (size_t)row * 256 + (col - 3072)) = pk8(v0, v1);
        else if (col < 4352) *(u32x4*)(ga + (size_t)row * 1024 + (col - 3328)) = pk8(sig4(v0), sig4(v1));
        else *(u32x4*)(gb + (size_t)row * 1024 + (col - 4352)) = pk8(sig4(v0), sig4(v1)); } };
struct FBrA { bf16_t* ga; int dry;
    __device__ __forceinline__ void operator()(int row, int col, f32x4 v0, f32x4 v1) const { F_DRY bf16_t* q = ga + (size_t)row * 1024 + col; f32x4 a, b; ld_bf16x8(q, a, b); *(u32x4*)q = pk8(a * v0, b * v1); } };
struct FBrB { bf16_t* m1; const bf16_t* gb; int dry;
    __device__ __forceinline__ void operator()(int row, int col, f32x4 v0, f32x4 v1) const { F_DRY const size_t o = (size_t)row * 1024 + col; f32x4 a, b, c, d; ld_bf16x8(m1 + o, a, b); ld_bf16x8(gb + o, c, d); *(u32x4*)(m1 + o) = pk8(a * v0 + c, b * v1 + d); } };
struct FOut { const float* x; const float* mod; float* out; int dry;
    __device__ __forceinline__ void operator()(int row, int col, f32x4 v0, f32x4 v1) const { F_DRY const size_t o = (size_t)row * D + col; const float* gt = mod + (row / S) * 6144 + 2048 + col;
        *(f32x4*)(out + o) = *(const f32x4*)(x + o) * DN_ALPHA + *(const f32x4*)gt * v0; *(f32x4*)(out + o + 4) = *(const f32x4*)(x + o + 4) * DN_ALPHA + *(const f32x4*)(gt + 4) * v1; } };
struct FPq { bf16_t* pq; int dry;
    __device__ __forceinline__ void operator()(int row, int col, f32x4 v0, f32x4 v1) const { F_DRY *(u32x4*)(pq + (size_t)row * D + col) = pk8(v0, v1); } };
__device__ __forceinline__ void dsa_norm_rows(const Params& p, int bid, int nblk, bool dry) {
    const int lane = threadIdx.x & 63, wid = threadIdx.x >> 6;
    const bf16_t* zmisc = (const bf16_t*)(p.ws + WS_ZMISC); bf16_t* ckv = (bf16_t*)(p.ws + WS_CKV); bf16_t* kidx = (bf16_t*)(p.ws + WS_KIDX); float* widx = (float*)(p.ws + WS_WIDX);
    for (int row = bid * NWAVE + wid; row < T; row += nblk * NWAVE) {
        const f32x4 v = ld_bf16x4(zmisc + (size_t)row * 256 + 4 * lane);
        float ss = (lane < 32) ? (v.x * v.x + v.y * v.y + v.z * v.z + v.w * v.w) : 0.f;
        ss = wave_sum(ss);
        const float rs = rsqrtf(ss * (1.f / 128.f) + LN_EPS);
        const bool isk = (lane >= 32 && lane < 48);
        float s1 = isk ? (v.x + v.y + v.z + v.w) : 0.f;
        s1 = wave_sum(s1);
        const float mean = s1 * (1.f / 64.f);
        const f32x4 d = v - mean;
        float s2 = isk ? (d.x * d.x + d.y * d.y + d.z * d.z + d.w * d.w) : 0.f;
        s2 = wave_sum(s2);
        const float rstd = rsqrtf(s2 * (1.f / 64.f) + LN_EPS);
        if (dry) { KEEP1(rs); KEEP1(rstd); continue; }
        if (lane < 32) { const f32x4 g = *(const f32x4*)(p.dsa_kv_g + 4 * lane); st_bf16x4(ckv + (size_t)row * 128 + 4 * lane, v * rs * g); }
        else if (isk) { const int c = 4 * (lane - 32); const f32x4 g = *(const f32x4*)(p.idx_k_g + c), b = *(const f32x4*)(p.idx_k_b + c); st_bf16x4(kidx + (size_t)row * 64 + c, d * rstd * g + b); }
        else if (lane == 48) { *(f32x4*)(widx + (size_t)row * 4) = v * (0.5f * 0.125f); }
    }
}

constexpr int RL_R = 0, RL_W = 16384, RL_KP = 32768, RL_KK = 49152, RL_BV = 65536, RL_V = 81920, RL_Y = 98304, RL_SG = 98304, RL_G = 114688, RL_TW = 122880, RL_AL = 131072, RL_RK = 139264;
template <int KD, bool OUT_BF16>
__device__ __forceinline__ void lora_mm(const LAS bf16_t* A, const bf16_t* Bt, LAS unsigned char* dst, int wid, int lane) {
    const int mi = wid >> 1;
#pragma unroll
    for (int nn = 0; nn < 2; ++nn) {
        const int ni = 2 * (wid & 1) + nn;
        f32x4 acc = (f32x4){0.f, 0.f, 0.f, 0.f};
#pragma unroll
        for (int ks = 0; ks < KD / 32; ++ks) {
            const bf16x8 a = *(const LAS bf16x8*)(A + (16 * mi + (lane & 15)) * KD + 32 * ks + 8 * (lane >> 4));
            const bf16x8 b = *(const bf16x8*)(Bt + (size_t)(16 * ni + (lane & 15)) * KD + 32 * ks + 8 * (lane >> 4));
            acc = __builtin_amdgcn_mfma_f32_16x16x32_bf16(a, b, acc, 0, 0, 0);
        }
#pragma unroll
        for (int r = 0; r < 4; ++r) {
            const int row = 16 * mi + (lane >> 4) * 4 + r, col = 16 * ni + (lane & 15);
            if (OUT_BF16) ((LAS bf16_t*)dst)[row * 64 + col] = (bf16_t)f2bf(acc[r]);
            else ((LAS float*)dst)[row * 64 + col] = acc[r];
        }
    }
}
template <int KD> __device__ __forceinline__ void lora_ldb(bf16x8 (&bfr)[2][KD / 32], const bf16_t* Bt, int wid, int lane) {
#pragma unroll
    for (int nn = 0; nn < 2; ++nn)
#pragma unroll
        for (int ks = 0; ks < KD / 32; ++ks) bfr[nn][ks] = *(const bf16x8*)(Bt + (size_t)(16 * (2 * (wid & 1) + nn) + (lane & 15)) * KD + 32 * ks + 8 * (lane >> 4));
}
template <int KD, bool OUT_BF16> __device__ __forceinline__ void lora_mm2(const LAS bf16_t* A, const bf16x8 (&bfr)[2][KD / 32], LAS unsigned char* dst, int wid, int lane) {
    const int mi = wid >> 1;
#pragma unroll
    for (int nn = 0; nn < 2; ++nn) {
        const int ni = 2 * (wid & 1) + nn;
        f32x4 acc = (f32x4){0.f, 0.f, 0.f, 0.f};
#pragma unroll
        for (int ks = 0; ks < KD / 32; ++ks) acc = __builtin_amdgcn_mfma_f32_16x16x32_bf16(*(const LAS bf16x8*)(A + (16 * mi + (lane & 15)) * KD + 32 * ks + 8 * (lane >> 4)), bfr[nn][ks], acc, 0, 0, 0);
#pragma unroll
        for (int r = 0; r < 4; ++r) { const int row = 16 * mi + (lane >> 4) * 4 + r, col = 16 * ni + (lane & 15);
            if (OUT_BF16) ((LAS bf16_t*)dst)[row * 64 + col] = (bf16_t)f2bf(acc[r]); else ((LAS float*)dst)[row * 64 + col] = acc[r]; }
    }
}
__device__ __forceinline__ f32x4 mix4(f32x4 z, f32x4 zp, f32x4 mu) { return z + (zp - z) * mu; }

constexpr size_t PREP_STRIDE = (size_t)T * 512;
constexpr size_t WS_RKG = 501 * MiB;
#define SIDX(row, col) ((row) * 64 + (((((col) >> 3) ^ ((row) & 7)) << 3) | ((col) & 7)))
__device__ __forceinline__ void mm64(f32x4 (&acc)[2], const LAS bf16_t* A, const LAS bf16_t* Bt, int wid, int lane) {
    const int mi = wid >> 1, l15 = lane & 15, g = lane >> 4;
#pragma unroll
    for (int nn = 0; nn < 2; ++nn) { const int ni = 2 * (wid & 1) + nn;
#pragma unroll
        for (int ks = 0; ks < 2; ++ks) acc[nn] = __builtin_amdgcn_mfma_f32_16x16x32_bf16(*(const LAS bf16x8*)(A + (16 * mi + l15) * 64 + (((4 * ks + g) ^ (l15 & 7)) << 3)), *(const LAS bf16x8*)(Bt + (16 * ni + l15) * 64 + (((4 * ks + g) ^ (l15 & 7)) << 3)), acc[nn], 0, 0, 0); }
}
#define MMT(acc, A, Bt) mm64(acc, Bt, A, wid, lane)
#define MM4_EACH(acc, BODY) do { _Pragma("unroll") for (int nn_ = 0; nn_ < 2; ++nn_) { const int i = 16 * (2 * (wid & 1) + nn_) + (lane & 15), j0 = 16 * (wid >> 1) + 4 * (lane >> 4); f32x4 v4 = acc[nn_]; \
        asm volatile("s_nop 7\n\ts_nop 4" : "+v"(v4.x), "+v"(v4.y), "+v"(v4.z), "+v"(v4.w)); BODY acc[nn_] = v4; } } while (0)
#define ST4S(slot, ii, jj, v) do { u32x2 w_; w_.x = pk2h((v).x, (v).y); w_.y = pk2h((v).z, (v).w); *(LAS u32x2*)(SLOT(slot) + SIDX(ii, jj)) = w_; } while (0)
__device__ __forceinline__ f32x4 ld4s(const LAS bf16_t* q) { const u32x2 w = *(const LAS u32x2*)q; return (f32x4){bflo(w.x), bfhi(w.x), bflo(w.y), bfhi(w.y)}; }
#define LBAR() do { asm volatile("s_waitcnt lgkmcnt(0)" ::: "memory"); __builtin_amdgcn_s_barrier(); asm volatile("" ::: "memory"); } while (0)
#define MM_ZERO(acc) do { acc[0] = (f32x4){0.f, 0.f, 0.f, 0.f}; acc[1] = acc[0]; } while (0)
#define MM_EACH(acc, BODY) do { _Pragma("unroll") for (int nn_ = 0; nn_ < 2; ++nn_) _Pragma("unroll") for (int r_ = 0; r_ < 4; ++r_) { \
        const int row = 16 * (wid >> 1) + 4 * (lane >> 4) + r_, col = 16 * (2 * (wid & 1) + nn_) + (lane & 15); float val = acc[nn_][r_]; BODY acc[nn_][r_] = val; } } while (0)
#define SLOT(i) ((LAS bf16_t*)(lds + (i) * 8192))
__device__ __forceinline__ void rwkv_chunk_unit(const Params& p, LAS unsigned char* lds, int tile, int h, bool dry) {
    const int tid = threadIdx.x, lane = tid & 63, wid = tid >> 6;
    const bf16_t* zrkv = (const bf16_t*)(p.ws + WS_ZRKV); const bf16_t* zlora = (const bf16_t*)(p.ws + WS_ZLORA);
    bf16_t* pre = (bf16_t*)p.out; bf16_t* gout = (bf16_t*)(p.ws + WS_RG); float* rkg = (float*)(p.ws + WS_RKG);
    const bf16_t* w2t = (const bf16_t*)(p.ws + WS_W2T) + (size_t)h * 64 * 64;
    const bf16_t* a2t = (const bf16_t*)(p.ws + WS_A2T) + (size_t)h * 64 * 64;
    const bf16_t* g2t = (const bf16_t*)(p.ws + WS_G2T) + (size_t)h * 64 * 128;
    LAS float* W = (LAS float*)(lds + RL_W); LAS float* KP = (LAS float*)(lds + RL_KP); LAS float* BV = (LAS float*)(lds + RL_BV);
    LAS bf16_t* SG = (LAS bf16_t*)(lds + RL_SG); LAS bf16_t* G = (LAS bf16_t*)(lds + RL_G); LAS bf16_t* TW = (LAS bf16_t*)(lds + RL_TW); LAS bf16_t* AL = (LAS bf16_t*)(lds + RL_AL);
    const int pt = tid >> 3, pc = (tid & 7) * 8, hc = h * 64 + pc;
    const size_t row = (size_t)tile * 64 + pt; const bool hasp = (row % S) > 0;
    f32x4 rm0, rm1, vm0, vm1;
    bf16x8 bw2[2][2], ba2[2][2];
    lora_ldb<64>(bw2, w2t, wid, lane); lora_ldb<64>(ba2, a2t, wid, lane);
    const f32x4 pw0a = *(const f32x4*)(p.rw_w0 + hc), pw0b = *(const f32x4*)(p.rw_w0 + hc + 4), pa0a = *(const f32x4*)(p.rw_a0 + hc), pa0b = *(const f32x4*)(p.rw_a0 + hc + 4);
    const f32x4 pkka = *(const f32x4*)(p.rw_k_k + hc), pkkb = *(const f32x4*)(p.rw_k_k + hc + 4), pkaa = *(const f32x4*)(p.rw_k_a + hc), pkab = *(const f32x4*)(p.rw_k_a + hc + 4);
    const f32x4 prka = *(const f32x4*)(p.rw_r_k + hc), prkb = *(const f32x4*)(p.rw_r_k + hc + 4);
    {
        const bf16_t* zr = zrkv + row * 1536; const bf16_t* zl = zlora + row * 256;
        f32x4 c0, c1, p0, p1, m0, m1; const f32x4 zero = (f32x4){0.f, 0.f, 0.f, 0.f};
        ld_bf16x8(zr + hc, c0, c1); if (hasp) ld_bf16x8(zr - 1536 + hc, p0, p1); else { p0 = zero; p1 = zero; }
        m0 = *(const f32x4*)(p.rw_mu + hc); m1 = *(const f32x4*)(p.rw_mu + hc + 4); rm0 = mix4(c0, p0, m0); rm1 = mix4(c1, p1, m1);
        ld_bf16x8(zr + 1024 + hc, c0, c1); if (hasp) ld_bf16x8(zr - 1536 + 1024 + hc, p0, p1); else { p0 = zero; p1 = zero; }
        m0 = *(const f32x4*)(p.rw_mu + 1024 + hc); m1 = *(const f32x4*)(p.rw_mu + 1024 + hc + 4); vm0 = mix4(c0, p0, m0); vm1 = mix4(c1, p1, m1);
        ld_bf16x8(zr + 512 + hc, c0, c1); if (hasp) ld_bf16x8(zr - 1536 + 512 + hc, p0, p1); else { p0 = zero; p1 = zero; }
        m0 = *(const f32x4*)(p.rw_mu + 512 + hc); m1 = *(const f32x4*)(p.rw_mu + 512 + hc + 4);
        *(LAS f32x4*)(KP + pt * 64 + pc) = mix4(c0, p0, m0); *(LAS f32x4*)(KP + pt * 64 + pc + 4) = mix4(c1, p1, m1);
        ld_bf16x8(zl + pc, c0, c1); if (hasp) ld_bf16x8(zl - 256 + pc, p0, p1); else { p0 = zero; p1 = zero; }
        m0 = *(const f32x4*)(p.rw_mu + 1536 + pc); m1 = *(const f32x4*)(p.rw_mu + 1536 + pc + 4);
        { const f32x4 a = mix4(c0, p0, m0), bb = mix4(c1, p1, m1); u32x4 o; o.x = pk2h(tanh_fast(a.x), tanh_fast(a.y)); o.y = pk2h(tanh_fast(a.z), tanh_fast(a.w)); o.z = pk2h(tanh_fast(bb.x), tanh_fast(bb.y)); o.w = pk2h(tanh_fast(bb.z), tanh_fast(bb.w));
          *(LAS u32x4*)(TW + pt * 64 + pc) = o; }
        ld_bf16x8(zl + 64 + pc, c0, c1); if (hasp) ld_bf16x8(zl - 256 + 64 + pc, p0, p1); else { p0 = zero; p1 = zero; }
        m0 = *(const f32x4*)(p.rw_mu + 1600 + pc); m1 = *(const f32x4*)(p.rw_mu + 1600 + pc + 4);
        { const f32x4 a = mix4(c0, p0, m0), bb = mix4(c1, p1, m1); u32x4 o; o.x = pk2h(a.x, a.y); o.y = pk2h(a.z, a.w); o.z = pk2h(bb.x, bb.y); o.w = pk2h(bb.z, bb.w);
          *(LAS u32x4*)(AL + pt * 64 + pc) = o; }
#pragma unroll
        for (int hh = 0; hh < 2; ++hh) {
            const int gc = 2 * pc + 8 * hh;
            ld_bf16x8(zl + 128 + gc, c0, c1); if (hasp) ld_bf16x8(zl - 256 + 128 + gc, p0, p1); else { p0 = zero; p1 = zero; }
            m0 = *(const f32x4*)(p.rw_mu + 1664 + gc); m1 = *(const f32x4*)(p.rw_mu + 1664 + gc + 4);
            const f32x4 a = mix4(c0, p0, m0), bb = mix4(c1, p1, m1); u32x4 o;
            o.x = pk2h(sigmoidf_(a.x), sigmoidf_(a.y)); o.y = pk2h(sigmoidf_(a.z), sigmoidf_(a.w)); o.z = pk2h(sigmoidf_(bb.x), sigmoidf_(bb.y)); o.w = pk2h(sigmoidf_(bb.z), sigmoidf_(bb.w));
            *(LAS u32x4*)(SG + pt * 128 + gc) = o;
        }
    }
    __syncthreads();
    lora_mm2<64, false>(TW, bw2, lds + RL_W, wid, lane);
    lora_mm2<64, false>(AL, ba2, lds + RL_BV, wid, lane);
    lora_mm<128, true>(SG, g2t, lds + RL_G, wid, lane);
    __syncthreads();
    float ew[8], kk[8], bv[8], kp[8];
    {
        float ssq = 0.f; float kkv[8], av[8], kraw[8];
        const float pw0[8] = {pw0a.x, pw0a.y, pw0a.z, pw0a.w, pw0b.x, pw0b.y, pw0b.z, pw0b.w}, pa0[8] = {pa0a.x, pa0a.y, pa0a.z, pa0a.w, pa0b.x, pa0b.y, pa0b.z, pa0b.w};
        const float pkk[8] = {pkka.x, pkka.y, pkka.z, pkka.w, pkkb.x, pkkb.y, pkkb.z, pkkb.w}, pka[8] = {pkaa.x, pkaa.y, pkaa.z, pkaa.w, pkab.x, pkab.y, pkab.z, pkab.w}, prk[8] = {prka.x, prka.y, prka.z, prka.w, prkb.x, prkb.y, prkb.z, prkb.w};
#pragma unroll
        for (int j = 0; j < 8; ++j) {
            const int c = pc + j;
            const float xw = pw0[j] + W[pt * 64 + c];
            const float sp = fmaxf(-xw, 0.f) + __logf(1.f + __expf(-fabsf(xw)));
            ew[j] = __expf(-sp - 0.5f);
            av[j] = sigmoidf_(pa0[j] + BV[pt * 64 + c]);
            kraw[j] = KP[pt * 64 + c];
            kkv[j] = kraw[j] * pkk[j];
            ssq += kkv[j] * kkv[j];
        }
        ssq = red8(ssq);
        const float inv = rsqrtf(fmaxf(ssq, 1e-24f));
        float rkp = 0.f; const float rr[8] = {rm0.x, rm0.y, rm0.z, rm0.w, rm1.x, rm1.y, rm1.z, rm1.w};
#pragma unroll
        for (int j = 0; j < 8; ++j) { kk[j] = kkv[j] * inv; bv[j] = kk[j] * av[j]; kp[j] = kraw[j] * (1.f + (av[j] - 1.f) * pka[j]); rkp += rr[j] * kp[j] * prk[j]; }
        rkp = red8(rkp);
        const u32x4 og = *(const LAS u32x4*)(G + pt * 64 + pc);
        if (!dry) { *(u32x4*)(gout + row * 512 + hc) = og; if ((tid & 7) == 0) rkg[row * 8 + h] = rkp; } else { KEEP4(og); KEEP1(rkp); }
    }
    __syncthreads();
    const int stg = dry ? p.probe_ph - 420 : 99;
    if (stg == 0) return;
    LAS float* LG = (LAS float*)(lds + 10 * 8192); LAS float* SEG = (LAS float*)(lds + 12 * 8192); LAS float* GCv = (LAS float*)(lds + 131072);
    *(LAS f32x4*)(LG + pt * 64 + pc) = (f32x4){ew[0], ew[1], ew[2], ew[3]}; *(LAS f32x4*)(LG + pt * 64 + pc + 4) = (f32x4){ew[4], ew[5], ew[6], ew[7]};
    __syncthreads();
    { const int k = tid & 63, seg = tid >> 6; float sm = 0.f;
#pragma unroll
      for (int i = 0; i < 8; ++i) sm += LG[(seg * 8 + i) * 64 + k];
      SEG[seg * 64 + k] = sm; }
    __syncthreads();
    { const int k = tid & 63, seg = tid >> 6; float acc = 0.f;
#pragma unroll
      for (int q = 0; q < 8; ++q) acc += (q < seg) ? SEG[q * 64 + k] : 0.f;
#pragma unroll
      for (int i = 0; i < 8; ++i) { acc += LG[(seg * 8 + i) * 64 + k]; LG[(seg * 8 + i) * 64 + k] = -acc; } }
    __syncthreads();
    {
        const f32x4 l0 = *(const LAS f32x4*)(LG + pt * 64 + pc), l1 = *(const LAS f32x4*)(LG + pt * 64 + pc + 4), c0 = *(const LAS f32x4*)(LG + 63 * 64 + pc), c1 = *(const LAS f32x4*)(LG + 63 * 64 + pc + 4);
        const float lg[8] = {l0.x, l0.y, l0.z, l0.w, l1.x, l1.y, l1.z, l1.w}, lc[8] = {c0.x, c0.y, c0.z, c0.w, c1.x, c1.y, c1.z, c1.w};
        const float rr[8] = {rm0.x, rm0.y, rm0.z, rm0.w, rm1.x, rm1.y, rm1.z, rm1.w}, vv[8] = {vm0.x, vm0.y, vm0.z, vm0.w, vm1.x, vm1.y, vm1.z, vm1.w};
        float am[8], rmv[8], bm[8], km[8], bh[8], kh[8];
#pragma unroll
        for (int j = 0; j < 8; ++j) { const float gam = __expf(lg[j]), gm1 = __expf(lg[j] + ew[j]), gi = __expf(-lg[j]), gcr = __expf(lc[j] - lg[j]);
            am[j] = -kk[j] * gm1; rmv[j] = rr[j] * gam; bm[j] = bv[j] * gi; km[j] = kp[j] * gi; bh[j] = bv[j] * gcr; kh[j] = kp[j] * gcr;
            if (pt == 63) GCv[pc + j] = gam; }
#define ST8(slot, a) do { u32x4 o_; o_.x = pk2h(a[0], a[1]); o_.y = pk2h(a[2], a[3]); o_.z = pk2h(a[4], a[5]); o_.w = pk2h(a[6], a[7]); *(LAS u32x4*)(SLOT(slot) + SIDX(pt, pc)) = o_; } while (0)
        ST8(0, am); ST8(1, rmv); ST8(2, bm); ST8(3, km);
#undef ST8
#pragma unroll
        for (int j = 0; j < 8; ++j) { SLOT(4)[SIDX(pc + j, pt)] = (bf16_t)f2bf(am[j]); SLOT(5)[SIDX(pc + j, pt)] = (bf16_t)f2bf(bh[j]); SLOT(6)[SIDX(pc + j, pt)] = (bf16_t)f2bf(kh[j]); SLOT(7)[SIDX(pc + j, pt)] = (bf16_t)f2bf(vv[j]); }
    }
    LBAR();
    if (stg == 1) return;
    f32x4 acc[2];
    MM_ZERO(acc); MMT(acc, SLOT(2), SLOT(0));
    MM4_EACH(acc, { v4.x = (i < j0) ? v4.x : 0.f; v4.y = (i < j0 + 1) ? v4.y : 0.f; v4.z = (i < j0 + 2) ? v4.z : 0.f; v4.w = (i < j0 + 3) ? v4.w : 0.f; ST4S(10, i, j0, v4);
                    f32x4 t4 = v4; if (i == j0) t4.x += 1.f; if (i == j0 + 1) t4.y += 1.f; if (i == j0 + 2) t4.z += 1.f; if (i == j0 + 3) t4.w += 1.f; ST4S(14, i, j0, t4); });
    MM_ZERO(acc); MMT(acc, SLOT(0), SLOT(2));
    MM4_EACH(acc, { v4.x = (j0 < i) ? v4.x : 0.f; v4.y = (j0 + 1 < i) ? v4.y : 0.f; v4.z = (j0 + 2 < i) ? v4.z : 0.f; v4.w = (j0 + 3 < i) ? v4.w : 0.f; ST4S(11, i, j0, v4); });
    MM_ZERO(acc); MMT(acc, SLOT(3), SLOT(0));
    MM4_EACH(acc, { v4.x = (i < j0) ? v4.x : 0.f; v4.y = (i < j0 + 1) ? v4.y : 0.f; v4.z = (i < j0 + 2) ? v4.z : 0.f; v4.w = (i < j0 + 3) ? v4.w : 0.f; ST4S(8, i, j0, v4); });
    MM_ZERO(acc); MMT(acc, SLOT(1), SLOT(2));
    MM4_EACH(acc, { v4.x = (j0 <= i) ? v4.x : 0.f; v4.y = (j0 + 1 <= i) ? v4.y : 0.f; v4.z = (j0 + 2 <= i) ? v4.z : 0.f; v4.w = (j0 + 3 <= i) ? v4.w : 0.f; ST4S(9, i, j0, v4); });
    LBAR();
    if (stg == 2) return;
    {
        int pc_ = 10, pn_ = 12, tc_ = 14, tn_ = 15;
        MM_ZERO(acc); MMT(acc, SLOT(pc_), SLOT(pc_ + 1)); MM4_EACH(acc, { ST4S(pn_, i, j0, v4); });
        MM_ZERO(acc); MMT(acc, SLOT(pc_ + 1), SLOT(pc_)); MM4_EACH(acc, { ST4S(pn_ + 1, i, j0, v4); });
        LBAR();
        { const int t_ = pc_; pc_ = pn_; pn_ = t_; }
#pragma unroll 1
        for (int j = 0; j < 5; ++j) {
            if (j < 4) {
                MM_ZERO(acc); MMT(acc, SLOT(pc_), SLOT(pc_ + 1)); MM4_EACH(acc, { ST4S(pn_, i, j0, v4); });
                MM_ZERO(acc); MMT(acc, SLOT(pc_ + 1), SLOT(pc_)); MM4_EACH(acc, { ST4S(pn_ + 1, i, j0, v4); });
            }
            MM_ZERO(acc); MMT(acc, SLOT(tc_), SLOT(pc_ + 1));
            MM4_EACH(acc, { v4 = v4 + ld4s(SLOT(tc_) + SIDX(i, j0)); ST4S(tn_, i, j0, v4); });
            LBAR();
            { const int t_ = pc_; pc_ = pn_; pn_ = t_; } { const int t_ = tc_; tc_ = tn_; tn_ = t_; }
        }
    }
    if (stg == 3) return;
    MM_ZERO(acc); MMT(acc, SLOT(9), SLOT(15));
    MM4_EACH(acc, { ST4S(0, i, j0, v4); });
    MM_ZERO(acc); MMT(acc, SLOT(5), SLOT(15));
    MM4_EACH(acc, { ST4S(2, i, j0, v4); });
    LBAR();
    if (stg == 4) return;
    bf16_t* gbase = pre + ((size_t)tile * 64) * 512 + h * 64;
#define GST4(arr, ii, jj, v) do { u32x2 w_; w_.x = pk2h((v).x, (v).y); w_.y = pk2h((v).z, (v).w); if (!dry) *(u32x2*)(gbase + (size_t)(arr) * PREP_STRIDE + (size_t)(ii) * 512 + (jj)) = w_; else { KEEP1(w_.x); KEEP1(w_.y); } } while (0)
    MM_ZERO(acc); MMT(acc, SLOT(0), SLOT(4));
    MM4_EACH(acc, { v4 = v4 + ld4s(SLOT(1) + SIDX(i, j0)); GST4(0, i, j0, v4); });
    MM_ZERO(acc); MMT(acc, SLOT(1), SLOT(3));
    MM4_EACH(acc, { v4.x = (j0 <= i) ? v4.x : 0.f; v4.y = (j0 + 1 <= i) ? v4.y : 0.f; v4.z = (j0 + 2 <= i) ? v4.z : 0.f; v4.w = (j0 + 3 <= i) ? v4.w : 0.f; });
    MMT(acc, SLOT(0), SLOT(8));
    MM4_EACH(acc, { GST4(1, i, j0, v4); });
    MM_ZERO(acc); MMT(acc, SLOT(2), SLOT(4));
    MM4_EACH(acc, { const float gc_ = GCv[i]; if (i == j0) v4.x += gc_; if (i == j0 + 1) v4.y += gc_; if (i == j0 + 2) v4.z += gc_; if (i == j0 + 3) v4.w += gc_; GST4(2, i, j0, v4); });
    MM_ZERO(acc); MMT(acc, SLOT(2), SLOT(8));
    MM4_EACH(acc, { v4 = v4 + ld4s(SLOT(6) + SIDX(i, j0)); ST4S(5, i, j0, v4); });
    LBAR();
    MM_ZERO(acc); MMT(acc, SLOT(7), SLOT(5));
    MM4_EACH(acc, { GST4(3, i, j0, v4); });
#undef GST4
    LBAR();
}
__device__ __forceinline__ void up8(const u32x4 w, f32x4& a, f32x4& b) { a = (f32x4){bflo(w.x), bfhi(w.x), bflo(w.y), bfhi(w.y)}; b = (f32x4){bflo(w.z), bfhi(w.z), bflo(w.w), bfhi(w.w)}; }
__device__ __forceinline__ void rwkv_state_out_pass(const Params& p, LAS unsigned char* lds, int b, int h) {
    const int tid = threadIdx.x, lane = tid & 63, wid = tid >> 6;
    const bf16_t* zrkv = (const bf16_t*)(p.ws + WS_ZRKV); const bf16_t* pre = (const bf16_t*)p.out; const bf16_t* gin = (const bf16_t*)(p.ws + WS_RG); const float* rkg = (const float*)(p.ws + WS_RKG);
    bf16_t* ya = (bf16_t*)(p.ws + WS_YA);
    LAS bf16_t* SL = (LAS bf16_t*)lds; LAS bf16_t* VT = (LAS bf16_t*)(lds + 8192);
    LAS float* V = (LAS float*)(lds + RL_V); LAS float* Y = (LAS float*)(lds + RL_Y); LAS float* RK = (LAS float*)(lds + RL_RK); LAS bf16_t* G = (LAS bf16_t*)(lds + RL_G);
    const int pt = tid >> 3, pc = (tid & 7) * 8, hc = h * 64 + pc;
    const int mi = wid >> 1, l15 = lane & 15, g = lane >> 4;
    const f32x4 muv0 = *(const f32x4*)(p.rw_mu + 1024 + hc), muv1 = *(const f32x4*)(p.rw_mu + 1024 + hc + 4);
    *(LAS u32x4*)(SL + tid * 8) = (u32x4){0u, 0u, 0u, 0u};
    bf16x8 gt[2][2], pa[2], qa[2]; unsigned short hm[2][4]; u32x4 vcq, vpq, gq; float rkq;
#define SO_LOAD(cc) do { const size_t r0_ = (size_t)b * S + (cc) * 64; const bf16_t* gb_ = pre + r0_ * 512 + h * 64; \
        _Pragma("unroll") for (int ks = 0; ks < 2; ++ks) { pa[ks] = *(const bf16x8*)(gb_ + (size_t)(16 * mi + l15) * 512 + 32 * ks + 8 * g); qa[ks] = *(const bf16x8*)(gb_ + PREP_STRIDE + (size_t)(16 * mi + l15) * 512 + 32 * ks + 8 * g); } \
        _Pragma("unroll") for (int nn = 0; nn < 2; ++nn) { const int ni = 2 * (wid & 1) + nn; \
            _Pragma("unroll") for (int ks = 0; ks < 2; ++ks) gt[nn][ks] = *(const bf16x8*)(gb_ + 2 * PREP_STRIDE + (size_t)(16 * ni + l15) * 512 + 32 * ks + 8 * g); \
            _Pragma("unroll") for (int r = 0; r < 4; ++r) hm[nn][r] = gb_[3 * PREP_STRIDE + (size_t)(16 * mi + 4 * g + r) * 512 + 16 * ni + l15]; } \
        const bf16_t* zr_ = zrkv + (r0_ + pt) * 1536 + 1024 + hc; vcq = *(const u32x4*)zr_; vpq = ((cc) * 64 + pt > 0) ? *(const u32x4*)(zr_ - 1536) : (u32x4){0u, 0u, 0u, 0u}; \
        gq = *(const u32x4*)(gin + (r0_ + pt) * 512 + hc); rkq = rkg[(r0_ + pt) * 8 + h]; } while (0)
    SO_LOAD(0);
    for (int c = 0; c < S / 64; ++c) {
        { f32x4 a0, a1, b0, b1; up8(vcq, a0, a1); up8(vpq, b0, b1);
          const f32x4 v0 = mix4(a0, b0, muv0), v1 = mix4(a1, b1, muv1);
          *(LAS f32x4*)(V + pt * 64 + pc) = v0; *(LAS f32x4*)(V + pt * 64 + pc + 4) = v1;
          const float vv[8] = {v0.x, v0.y, v0.z, v0.w, v1.x, v1.y, v1.z, v1.w};
#pragma unroll
          for (int j = 0; j < 8; ++j) VT[(pc + j) * 64 + pt] = (bf16_t)f2bf(vv[j]);
          *(LAS u32x4*)(G + pt * 64 + pc) = gq; if ((tid & 7) == 0) RK[pt] = rkq; }
        LBAR();
        f32x4 ay[2], as[2];
#pragma unroll
        for (int nn = 0; nn < 2; ++nn) { const int ni = 2 * (wid & 1) + nn;
            ay[nn] = (f32x4){0.f, 0.f, 0.f, 0.f}; as[nn] = (f32x4){bf2f(hm[nn][0]), bf2f(hm[nn][1]), bf2f(hm[nn][2]), bf2f(hm[nn][3])};
#pragma unroll
            for (int ks = 0; ks < 2; ++ks) {
                const bf16x8 sb = *(const LAS bf16x8*)(SL + (16 * ni + l15) * 64 + 32 * ks + 8 * g);
                ay[nn] = __builtin_amdgcn_mfma_f32_16x16x32_bf16(pa[ks], sb, ay[nn], 0, 0, 0);
                ay[nn] = __builtin_amdgcn_mfma_f32_16x16x32_bf16(qa[ks], *(const LAS bf16x8*)(VT + (16 * ni + l15) * 64 + 32 * ks + 8 * g), ay[nn], 0, 0, 0);
                as[nn] = __builtin_amdgcn_mfma_f32_16x16x32_bf16(*(const LAS bf16x8*)(SL + (16 * mi + l15) * 64 + 32 * ks + 8 * g), gt[nn][ks], as[nn], 0, 0, 0); } }
        MM_EACH(ay, { Y[row * 64 + col] = val; });
        if (c + 1 < S / 64) SO_LOAD(c + 1);
        LBAR();
        MM_EACH(as, { SL[row * 64 + col] = (bf16_t)f2bf(val); });
        {
            float yv[8]; float sm = 0.f;
#pragma unroll
            for (int j = 0; j < 8; ++j) { yv[j] = Y[pt * 64 + pc + j]; sm += yv[j]; }
            const float mean = red8(sm) * (1.f / 64.f); float qq = 0.f;
#pragma unroll
            for (int j = 0; j < 8; ++j) { yv[j] -= mean; qq += yv[j] * yv[j]; }
            const float rstd = rsqrtf(red8(qq) * (1.f / 64.f) + RW_GN_EPS);
            const float rk = RK[pt]; float o[8];
#pragma unroll
            for (int j = 0; j < 8; ++j) { const int gc = hc + j;
                o[j] = (yv[j] * rstd * p.rw_gn_g[gc] + p.rw_gn_b[gc] + rk * V[pt * 64 + pc + j]) * bf2f(G[pt * 64 + pc + j]); }
            u32x4 w; w.x = pk2(o[0], o[1]); w.y = pk2(o[2], o[3]); w.z = pk2(o[4], o[5]); w.w = pk2(o[6], o[7]);
            *(u32x4*)(ya + ((size_t)b * S + c * 64 + pt) * 512 + hc) = w;
        }
        LBAR();
    }
#undef SO_LOAD
}

__device__ __forceinline__ int mbcnt64(unsigned long long m) { return (int)__builtin_amdgcn_mbcnt_hi((unsigned)(m >> 32), __builtin_amdgcn_mbcnt_lo((unsigned)m, 0u)); }
template <int NV> __device__ __forceinline__ int wave_count_ge(const unsigned (&u)[NV], unsigned cand) {
    if (NV <= 8) { int c = 0;
#pragma unroll
        for (int i = 0; i < NV; ++i) c += (int)__builtin_popcountll(__ballot(u[i] >= cand));
        return c; }
    else { int c = 0;
#pragma unroll
        for (int i = 0; i < NV; ++i) c += (u[i] >= cand) ? 1 : 0;
        c += __builtin_amdgcn_update_dpp(0, c, 0xB1, 0xf, 0xf, true); c += __builtin_amdgcn_update_dpp(0, c, 0x4E, 0xf, 0xf, true);
        c += __builtin_amdgcn_update_dpp(0, c, 0x141, 0xf, 0xf, true); c += __builtin_amdgcn_update_dpp(0, c, 0x140, 0xf, 0xf, true);
        return __builtin_amdgcn_readlane(c, 0) + __builtin_amdgcn_readlane(c, 16) + __builtin_amdgcn_readlane(c, 32) + __builtin_amdgcn_readlane(c, 48); }
}
template <int NV, int K> __device__ __forceinline__ unsigned wave_kth(const unsigned (&u)[NV]) {
    unsigned Tt = 0u;
    for (int bit = 31; bit >= 0; --bit) {
        const unsigned cand = Tt | (1u << bit);
        const int c = wave_count_ge<NV>(u, cand);
        if (c >= K) Tt = cand;
        if (c == K) break;
    }
    return Tt;
}

__device__ __forceinline__ int cnt4_ge(int c, unsigned a, unsigned b, unsigned d, unsigned e, unsigned x) {
    asm volatile("v_cmp_ge_u32_e64 s[20:21], %1, %5\n\tv_cmp_ge_u32_e64 s[22:23], %2, %5\n\tv_cmp_ge_u32_e64 s[24:25], %3, %5\n\tv_cmp_ge_u32_e64 s[26:27], %4, %5\n\t"
                 "v_addc_co_u32_e64 %0, s[28:29], %0, 0, s[20:21]\n\tv_addc_co_u32_e64 %0, s[28:29], %0, 0, s[22:23]\n\tv_addc_co_u32_e64 %0, s[28:29], %0, 0, s[24:25]\n\tv_addc_co_u32_e64 %0, s[28:29], %0, 0, s[26:27]"
                 : "+v"(c) : "v"(a), "v"(b), "v"(d), "v"(e), "v"(x) : "s20", "s21", "s22", "s23", "s24", "s25", "s26", "s27", "s28", "s29");
    return c;
}
__device__ __forceinline__ int wave_count_ge64(const unsigned (&u)[64], unsigned cand, int ngrp) {
    int c = 0;
#pragma unroll
    for (int gq = 0; gq < 4; ++gq) if (gq < ngrp) {
#pragma unroll
        for (int i = 0; i < 16; i += 4) c = cnt4_ge(c, u[gq * 16 + i], u[gq * 16 + i + 1], u[gq * 16 + i + 2], u[gq * 16 + i + 3], cand);
    }
    c += __builtin_amdgcn_update_dpp(0, c, 0xB1, 0xf, 0xf, true); c += __builtin_amdgcn_update_dpp(0, c, 0x4E, 0xf, 0xf, true);
    c += __builtin_amdgcn_update_dpp(0, c, 0x141, 0xf, 0xf, true); c += __builtin_amdgcn_update_dpp(0, c, 0x140, 0xf, 0xf, true);
    return __builtin_amdgcn_readlane(c, 0) + __builtin_amdgcn_readlane(c, 16) + __builtin_amdgcn_readlane(c, 32) + __builtin_amdgcn_readlane(c, 48);
}
template <int K> __device__ __forceinline__ unsigned wave_kth_interp(const unsigned (&u)[64], int ngrp, bool& allge, int& cgt) {
    unsigned mx = 0u;
#pragma unroll
    for (int gq = 0; gq < 4; ++gq) if (gq < ngrp) {
#pragma unroll
        for (int i = 0; i < 16; ++i) mx = umax_(mx, u[gq * 16 + i]);
    }
    { int m = (int)mx;
      unsigned o;
      o = (unsigned)__builtin_amdgcn_update_dpp(0, m, 0xB1, 0xf, 0xf, true); mx = umax_(mx, o); m = (int)mx;
      o = (unsigned)__builtin_amdgcn_update_dpp(0, m, 0x4E, 0xf, 0xf, true); mx = umax_(mx, o); m = (int)mx;
      o = (unsigned)__builtin_amdgcn_update_dpp(0, m, 0x141, 0xf, 0xf, true); mx = umax_(mx, o); m = (int)mx;
      o = (unsigned)__builtin_amdgcn_update_dpp(0, m, 0x140, 0xf, 0xf, true); mx = umax_(mx, o); m = (int)mx;
      mx = umax_(umax_((unsigned)__builtin_amdgcn_readlane(m, 0), (unsigned)__builtin_amdgcn_readlane(m, 16)), umax_((unsigned)__builtin_amdgcn_readlane(m, 32), (unsigned)__builtin_amdgcn_readlane(m, 48))); }
    unsigned Tt = 0u; allge = false; int startbit = 31 - __builtin_clz(mx | 1u);
    {
        unsigned P = mx & 0xff800000u;
        for (int j = 0; j < 4; ++j) {
            const int c = wave_count_ge64(u, P | (P == 0u ? 1u : 0u), ngrp);
            if (c >= K) { Tt = P; startbit = 22; if (c == K && P != 0u) allge = true; break; }
            if (P < 0x00800000u) break;
            P -= 0x00800000u;
        }
    }
    if (!allge) {
        for (int bit = startbit; bit >= 0; --bit) {
            const unsigned cand = Tt | (1u << bit);
            const int c = wave_count_ge64(u, cand, ngrp);
            if (c >= K) { Tt = cand; if (c == K) { allge = true; break; } }
        }
    }
    cgt = allge ? 0 : wave_count_ge64(u, Tt + 1u, ngrp);
    return Tt;
}

constexpr int IX_LD = 4112;
constexpr int IX_LUT = 8 * IX_LD * 4, IX_FAR = IX_LUT + 4096;
typedef short v4i16_t __attribute__((ext_vector_type(4)));
__device__ __forceinline__ void attn_query(int lane, int t, int cnt, LAS unsigned char* WL, const LAS float* LUT, const LAS float* FAR, bf16_t* zq, const bf16_t* ckv, bool dry, int fake = 0) {
    const int b = t / S, tp = t % S;
    LAS unsigned short* SEL = (LAS unsigned short*)WL; LAS bf16_t* PT = (LAS bf16_t*)(WL + 512); LAS unsigned char* VI = WL + 2048;
    const int l15 = lane & 15, g = lane >> 4;
    bf16x8 qf[4];
#pragma unroll
    for (int ks = 0; ks < 4; ++ks) { if (l15 < 8) qf[ks] = *(const bf16x8*)(zq + (size_t)t * 1024 + l15 * 128 + 32 * ks + 8 * g); else qf[ks] = (bf16x8){0, 0, 0, 0, 0, 0, 0, 0}; }
    const bf16_t* kb = ckv + (size_t)b * S * 128 + 8 * l15;
    const int nch = (cnt + 31) >> 5;
    u32x4 pre[8];
#pragma unroll
    for (int i = 0; i < 8; ++i) pre[i] = *(const u32x4*)(kb + (size_t)(fake ? (SEL[4 * i + g] & 31) : SEL[4 * i + g]) * 128);
    f32x4 O[8];
#pragma unroll
    for (int nt = 0; nt < 8; ++nt) O[nt] = (f32x4){0.f, 0.f, 0.f, 0.f};
    float mrun[4], lrun[4];
#pragma unroll
    for (int r = 0; r < 4; ++r) { mrun[r] = -INFINITY; lrun[r] = 0.f; }
    for (int ch = 0; ch < nch; ++ch) {
#pragma unroll
        for (int i = 0; i < 8; ++i) { const int r = 4 * i + g; *(LAS u32x4*)(VI + r * 256 + ((l15 ^ (r & 15)) << 4)) = pre[i]; }
        if (ch + 1 < nch) {
#pragma unroll
            for (int i = 0; i < 8; ++i) pre[i] = *(const u32x4*)(kb + (size_t)(fake ? (SEL[(ch + 1) * 32 + 4 * i + g] & 31) : SEL[(ch + 1) * 32 + 4 * i + g]) * 128);
        }
        asm volatile("s_waitcnt lgkmcnt(0)" ::: "memory");
        f32x4 sc[2];
#pragma unroll
        for (int nt2 = 0; nt2 < 2; ++nt2) {
            const int row = 16 * nt2 + l15; f32x4 acc = (f32x4){0.f, 0.f, 0.f, 0.f};
#pragma unroll
            for (int ks = 0; ks < 4; ++ks) acc = __builtin_amdgcn_mfma_f32_16x16x32_bf16(qf[ks], *(const LAS bf16x8*)(VI + row * 256 + (((4 * ks + g) ^ l15) << 4)), acc, 0, 0, 0);
            const int slot = ch * 32 + row; const int key = SEL[slot]; const int n = tp - key; const bool ok = slot < cnt;
            const f32x4 bias = (n < 128) ? *(const LAS f32x4*)(LUT + n * 8 + ((4 * g) & 7)) : *(const LAS f32x4*)(FAR + ((4 * g) & 7));
#pragma unroll
            for (int r = 0; r < 4; ++r) acc[r] = ok ? acc[r] + bias[r] : -INFINITY;
            sc[nt2] = acc;
        }
        float alpha[4];
#pragma unroll
        for (int r = 0; r < 4; ++r) {
            const float cm = red16_max(fmaxf(sc[0][r], sc[1][r]));
            const float mn = fmaxf(mrun[r], cm);
            alpha[r] = __builtin_amdgcn_exp2f(mrun[r] - mn); mrun[r] = mn;
            sc[0][r] = __builtin_amdgcn_exp2f(sc[0][r] - mn); sc[1][r] = __builtin_amdgcn_exp2f(sc[1][r] - mn);
            lrun[r] = lrun[r] * alpha[r] + red16_sum(sc[0][r] + sc[1][r]);
        }
        if (!__all(alpha[0] == 1.f && alpha[1] == 1.f && alpha[2] == 1.f && alpha[3] == 1.f)) {
#pragma unroll
            for (int nt = 0; nt < 8; ++nt) { O[nt].x *= alpha[0]; O[nt].y *= alpha[1]; O[nt].z *= alpha[2]; O[nt].w *= alpha[3]; }
        }
        if (g < 2) {
#pragma unroll
            for (int nt2 = 0; nt2 < 2; ++nt2)
#pragma unroll
                for (int r = 0; r < 4; ++r) PT[(4 * g + r) * 32 + 16 * nt2 + l15] = (bf16_t)(pk2h(sc[nt2][r], sc[nt2][r]) & 0xffffu);
        }
        asm volatile("s_waitcnt lgkmcnt(0)" ::: "memory");
        const bf16x8 pa = *(const LAS bf16x8*)(PT + l15 * 32 + 8 * g);
        const int q4 = l15 >> 2, p4 = l15 & 3;
#pragma unroll
        for (int nt = 0; nt < 8; ++nt) {
            const int r0 = 8 * g + q4, r1 = r0 + 4, chn = 2 * nt + (p4 >> 1);
            const v4i16_t lo = __builtin_amdgcn_ds_read_tr16_b64_v4i16((LAS v4i16_t*)(VI + r0 * 256 + ((chn ^ (r0 & 15)) << 4) + (p4 & 1) * 8));
            const v4i16_t hi = __builtin_amdgcn_ds_read_tr16_b64_v4i16((LAS v4i16_t*)(VI + r1 * 256 + ((chn ^ (r1 & 15)) << 4) + (p4 & 1) * 8));
            const bf16x8 vb = (bf16x8){lo[0], lo[1], lo[2], lo[3], hi[0], hi[1], hi[2], hi[3]};
            O[nt] = __builtin_amdgcn_mfma_f32_16x16x32_bf16(pa, vb, O[nt], 0, 0, 0);
        }
        asm volatile("s_waitcnt lgkmcnt(0)" ::: "memory");
    }
    if (g < 2) {
        float inv[4];
#pragma unroll
        for (int r = 0; r < 4; ++r) inv[r] = 1.f / lrun[r];
#pragma unroll
        for (int nt = 0; nt < 8; ++nt)
#pragma unroll
            for (int r = 0; r < 4; ++r) { const float ov = O[nt][r] * inv[r]; const bf16_t o = (bf16_t)(pk2h(ov, ov) & 0xffffu); if (!dry) zq[(size_t)t * 1024 + (4 * g + r) * 128 + 16 * nt + l15] = o; else KEEP1(o); }
    }
}
__device__ __forceinline__ void dsa_tables(const Params& p, LAS unsigned char* lds) {
    LAS float* LUT = (LAS float*)(lds + IX_LUT); LAS float* FAR = (LAS float*)(lds + IX_FAR);
    for (int i = threadIdx.x; i < 1024; i += NTHR) { const int n = i >> 3, hh = i & 7; int bk;
        if (n < 16) bk = n; else { bk = 16 + (int)(logf((float)n / 16.f) / 2.0794415416798357f * 16.f); bk = bk < 31 ? bk : 31; }
        LUT[i] = p.rel_bias[bk * 8 + hh] * 1.4426950408889634f; }
    if (threadIdx.x < 8) FAR[threadIdx.x] = p.rel_bias[31 * 8 + threadIdx.x] * 1.4426950408889634f;
    __syncthreads();
}
__device__ __forceinline__ void dsa_unit(const Params& p, LAS unsigned char* lds, int unit, bool dry, int fake = 0) {
    const int tid = threadIdx.x, lane = tid & 63, wid = tid >> 6;
    const int b = unit >> 9, t0 = (unit & 511) * 8;
    const bf16_t* qidx = (const bf16_t*)(p.ws + WS_QIDX); const bf16_t* kidx = (const bf16_t*)(p.ws + WS_KIDX); const float* widx = (const float*)(p.ws + WS_WIDX);
    bf16_t* zq = (bf16_t*)(p.ws + WS_ZQ); const bf16_t* ckv = (const bf16_t*)(p.ws + WS_CKV);
    LAS float* SC = (LAS float*)lds;
    const LAS float* LUT = (const LAS float*)(lds + IX_LUT); const LAS float* FAR = (const LAS float*)(lds + IX_FAR);
    LAS unsigned char* WL = (LAS unsigned char*)(SC + wid * IX_LD);
    LAS unsigned short* SEL = (LAS unsigned short*)WL;
    const int t = t0 + wid;
    int cnt;
    if (t0 < TOPK) {
#pragma unroll
        for (int i = 0; i < 4; ++i) { const int idx = i * 64 + lane; SEL[idx] = (unsigned short)(idx <= t ? idx : 0); }
        cnt = t + 1;
    } else {
        bf16x8 afr[2][2]; f32x4 wv[2];
#pragma unroll
        for (int rt = 0; rt < 2; ++rt) {
            const size_t row = (size_t)b * S + t0 + 4 * rt + ((lane & 15) >> 2);
#pragma unroll
            for (int ks = 0; ks < 2; ++ks) afr[rt][ks] = *(const bf16x8*)(qidx + row * 256 + (lane & 3) * 64 + 32 * ks + 8 * (lane >> 4));
            wv[rt] = *(const f32x4*)(widx + ((size_t)b * S + t0 + 4 * rt + (lane >> 4)) * 4);
        }
        const int ntiles = (t0 + 8 + 15) >> 4;
        for (int kt0 = wid; kt0 < ntiles; kt0 += 4 * NWAVE) {
            bf16x8 kb0[4], kb1[4];
#pragma unroll
            for (int q = 0; q < 4; ++q) { const int kt = kt0 + q * NWAVE; const int ktc = kt < ntiles ? kt : kt0;
                const bf16_t* kp = kidx + ((size_t)b * S + ktc * 16 + (lane & 15)) * 64 + 8 * (lane >> 4); kb0[q] = *(const bf16x8*)kp; kb1[q] = *(const bf16x8*)(kp + 32); }
#pragma unroll
            for (int q = 0; q < 4; ++q) { const int kt = kt0 + q * NWAVE;
#pragma unroll
                for (int rt = 0; rt < 2; ++rt) {
                    f32x4 acc = (f32x4){0.f, 0.f, 0.f, 0.f};
                    acc = __builtin_amdgcn_mfma_f32_16x16x32_bf16(afr[rt][0], kb0[q], acc, 0, 0, 0);
                    acc = __builtin_amdgcn_mfma_f32_16x16x32_bf16(afr[rt][1], kb1[q], acc, 0, 0, 0);
                    const float sv = wv[rt].x * fmaxf(acc.x, 0.f) + wv[rt].y * fmaxf(acc.y, 0.f) + wv[rt].z * fmaxf(acc.z, 0.f) + wv[rt].w * fmaxf(acc.w, 0.f);
                    if (kt < ntiles) SC[(4 * rt + (lane >> 4)) * IX_LD + kt * 16 + (lane & 15)] = sv;
                }
            }
        }
        __syncthreads();
        const int n = t + 1;
        unsigned u[64];
#pragma unroll
        for (int i = 0; i < 64; ++i) { const int idx = i * 64 + lane; u[i] = (idx < n) ? sortable(SC[wid * IX_LD + idx]) : 0u; }
        asm volatile("s_waitcnt lgkmcnt(0)" ::: "memory");
        const int ngrp = (n + 1023) >> 10;
        bool allge = true; int cgt = 0;
        unsigned Tt = u[0];
        if (fake != 3) Tt = wave_kth_interp<TOPK>(u, ngrp, allge, cgt);
        int base = 0;
        if (fake >= 3) { KEEP1(Tt); KEEP1(cgt); }
        else if (allge) {
#pragma unroll
            for (int i = 0; i < 64; ++i) {
                if (i * 64 < n) {
                    const bool take = u[i] >= Tt;
                    const unsigned long long mt = __ballot(take);
                    if (take) SEL[base + mbcnt64(mt)] = (unsigned short)(i * 64 + lane);
                    base += (int)__builtin_popcountll(mt);
                }
            }
        } else {
            const int need_eq = TOPK - cgt; int eqb = 0;
#pragma unroll
            for (int i = 0; i < 64; ++i) {
                if (i * 64 < n) {
                    const bool gt = u[i] > Tt, eq = u[i] == Tt;
                    const unsigned long long meq = __ballot(eq);
                    const bool take = gt || (eq && (eqb + mbcnt64(meq)) < need_eq);
                    const unsigned long long mt = __ballot(take);
                    if (take) SEL[base + mbcnt64(mt)] = (unsigned short)(i * 64 + lane);
                    base += (int)__builtin_popcountll(mt); eqb += (int)__builtin_popcountll(meq);
                }
            }
        }
        cnt = TOPK;
    }
    asm volatile("s_waitcnt lgkmcnt(0)" ::: "memory");
    if (fake < 2) attn_query(lane, b * S + t, cnt, WL, LUT, FAR, zq, ckv, dry, fake);
    __syncthreads();
}

__device__ __forceinline__ void phase_ln1(const Params& p, int bid, int nblk) {
    const int lane = threadIdx.x & 63, wid = threadIdx.x >> 6;
    const float* mod = (const float*)(p.ws + WS_MOD); bf16_t* h2 = (bf16_t*)(p.ws + WS_H2);
    for (int m = bid * NWAVE + wid; m < T; m += nblk * NWAVE) {
        const int b = m / S; float* row = p.out + (size_t)m * D;
        f32x4 v[4]; float s = 0.f;
#pragma unroll
        for (int j = 0; j < 4; ++j) { v[j] = *(const f32x4*)(row + 4 * lane + 256 * j); s += (v[j].x + v[j].y) + (v[j].z + v[j].w); }
        const float mean = wave_sum(s) * (1.f / D); float q = 0.f;
#pragma unroll
        for (int j = 0; j < 4; ++j) { v[j] = v[j] - mean; q += (v[j].x * v[j].x + v[j].y * v[j].y) + (v[j].z * v[j].z + v[j].w * v[j].w); }
        const float rstd = rsqrtf(wave_sum(q) * (1.f / D) + LN_EPS);
#pragma unroll
        for (int j = 0; j < 4; ++j) { const int c = 4 * lane + 256 * j;
            const f32x4 x1 = v[j] * rstd * *(const f32x4*)(p.ln1_g + c) + *(const f32x4*)(p.ln1_b + c);
            *(f32x4*)(row + c) = x1;
            st_bf16x4(h2 + (size_t)m * D + c, x1 * (1.f + *(const f32x4*)(mod + b * 6144 + 4096 + c)) + *(const f32x4*)(mod + b * 6144 + 3072 + c)); }
    }
}

__device__ __forceinline__ float unsortable(unsigned u) { return __uint_as_float((u & 0x80000000u) ? (u & 0x7fffffffu) : ~u); }
template <int N> __device__ __forceinline__ void bitonic_sort_desc(unsigned (&v)[N]) {
#pragma unroll
    for (int k = 2; k <= N; k <<= 1)
#pragma unroll
        for (int j = k >> 1; j > 0; j >>= 1)
#pragma unroll
            for (int i = 0; i < N; ++i) { const int l = i ^ j; if (l > i) { const unsigned hi = umax_(v[i], v[l]), lo = umin_(v[i], v[l]); if ((i & k) == 0) { v[i] = hi; v[l] = lo; } else { v[i] = lo; v[l] = hi; } } }
}
__device__ __forceinline__ void bitonic_merge16_desc(unsigned (&m)[16]) {
#pragma unroll
    for (int j = 8; j > 0; j >>= 1)
#pragma unroll
        for (int i = 0; i < 16; ++i) { const int l = i ^ j; if (l > i) { const unsigned hi = umax_(m[i], m[l]), lo = umin_(m[i], m[l]); m[i] = hi; m[l] = lo; } }
}
constexpr int RT2_WSZ = (4 * 32 * 16 + 64) * 4;
__device__ __forceinline__ void route_phase(const Params& p, LAS unsigned char* lds, int bid, int nblk, bool dry) {
    const int tid = threadIdx.x, lane = tid & 63, wid = tid >> 6;
    const bf16_t* pq = (const bf16_t*)(p.ws + WS_PQ); const bf16_t* keys = (const bf16_t*)(p.ws + WS_KEYS);
    unsigned short* eidx = (unsigned short*)(p.ws + WS_EIDX); float* gate = (float*)(p.ws + WS_GATE);
    LAS unsigned* LST = (LAS unsigned*)(lds + wid * RT2_WSZ);
    const int tok = lane & 15, grp = lane >> 4;
    for (int task = bid * NWAVE + wid; task < (T / 16) * 2; task += nblk * NWAVE) {
        const int t0 = (task >> 1) * 16, hq = task & 1;
#pragma unroll 1
        for (int hl = 0; hl < 4; ++hl) {
            const int h = hq * 4 + hl;
#pragma unroll 1
            for (int c = 0; c < 2; ++c) {
                const bf16_t* qp = pq + (size_t)(t0 + tok) * D + h * 128 + c * 64 + 8 * grp;
                bf16x8 bq[2];
#pragma unroll
                for (int ks = 0; ks < 2; ++ks) bq[ks] = *(const bf16x8*)(qp + 32 * ks);
                unsigned v[32];
#pragma unroll
                for (int mt = 0; mt < 8; ++mt) {
                    const bf16_t* kp = keys + ((size_t)(h * 2 + c) * 128 + 16 * mt + tok) * 64 + 8 * grp;
                    f32x4 acc = (f32x4){0.f, 0.f, 0.f, 0.f};
                    acc = __builtin_amdgcn_mfma_f32_16x16x32_bf16(*(const bf16x8*)kp, bq[0], acc, 0, 0, 0);
                    acc = __builtin_amdgcn_mfma_f32_16x16x32_bf16(*(const bf16x8*)(kp + 32), bq[1], acc, 0, 0, 0);
#pragma unroll
                    for (int r = 0; r < 4; ++r) { const int n = 16 * mt + 4 * grp + r; v[4 * mt + r] = (sortable(acc[r]) & 0xffffff80u) | (unsigned)(127 - n); }
                }
                bitonic_sort_desc<32>(v);
                unsigned m[16];
#pragma unroll
                for (int i = 0; i < 16; ++i) m[i] = umax_(v[i], (unsigned)__shfl_xor((int)v[15 - i], 16));
                bitonic_merge16_desc(m);
                unsigned m2[16];
#pragma unroll
                for (int i = 0; i < 16; ++i) m2[i] = umax_(m[i], (unsigned)__shfl_xor((int)m[15 - i], 32));
                bitonic_merge16_desc(m2);
                if (grp == 0) {
#pragma unroll
                    for (int i = 0; i < 16; ++i) LST[(hl * 32 + c * 16 + i) * 16 + hl * 16 + tok] = m2[i];
                }
            }
        }
        asm volatile("s_waitcnt lgkmcnt(0)" ::: "memory");
        {
            const int lb = grp * 32 * 16 + grp * 16 + tok;
            float av[16], bv[16];
#pragma unroll
            for (int i = 0; i < 16; ++i) { av[i] = unsortable(LST[lb + i * 16] & 0xffffff80u); bv[i] = unsortable(LST[lb + (16 + i) * 16] & 0xffffff80u); }
            unsigned top[16];
#pragma unroll
            for (int i = 0; i < 16; ++i) top[i] = 0u;
#pragma unroll
            for (int i = 0; i < 16; ++i)
#pragma unroll
                for (int j = 0; j < 16; ++j) if ((i + 1) * (j + 1) <= 16) {
                    unsigned x = (sortable(av[i] + bv[j]) & 0xffffff00u) | (unsigned)(255 - (i * 16 + j));
#pragma unroll
                    for (int q = 0; q < 16; ++q) { const unsigned hi = umax_(top[q], x); x = umin_(top[q], x); top[q] = hi; }
                }
            float val[16]; int ex[16]; float mx = -INFINITY;
#pragma unroll
            for (int q = 0; q < 16; ++q) { const int code = 255 - (int)(top[q] & 0xffu); val[q] = unsortable(top[q] & 0xffffff00u); mx = fmaxf(mx, val[q]);
                const int i1 = 127 - (int)(LST[lb + (code >> 4) * 16] & 0x7fu), i2 = 127 - (int)(LST[lb + (16 + (code & 15)) * 16] & 0x7fu); ex[q] = i1 * 128 + i2; }
            float sum = 0.f;
#pragma unroll
            for (int q = 0; q < 16; ++q) { val[q] = __expf(val[q] - mx); sum += val[q]; }
            const float inv = 1.f / sum;
            const size_t o = (size_t)(t0 + tok) * 128 + (hq * 4 + grp) * 16;
            u32x4 e0, e1; e0.x = (unsigned)ex[0] | ((unsigned)ex[1] << 16); e0.y = (unsigned)ex[2] | ((unsigned)ex[3] << 16); e0.z = (unsigned)ex[4] | ((unsigned)ex[5] << 16); e0.w = (unsigned)ex[6] | ((unsigned)ex[7] << 16);
            e1.x = (unsigned)ex[8] | ((unsigned)ex[9] << 16); e1.y = (unsigned)ex[10] | ((unsigned)ex[11] << 16); e1.z = (unsigned)ex[12] | ((unsigned)ex[13] << 16); e1.w = (unsigned)ex[14] | ((unsigned)ex[15] << 16);
            if (!dry) { *(u32x4*)(eidx + o) = e0; *(u32x4*)(eidx + o + 8) = e1;
#pragma unroll
                for (int q = 0; q < 4; ++q) *(f32x4*)(gate + o + 4 * q) = (f32x4){val[4 * q] * inv, val[4 * q + 1] * inv, val[4 * q + 2] * inv, val[4 * q + 3] * inv}; }
            else { KEEP4(e0); KEEP4(e1); KEEP1(inv); }
        }
        asm volatile("s_waitcnt lgkmcnt(0)" ::: "memory");
    }
}

constexpr int EX_WSZ = 1024 + 512 + 512;
__device__ __forceinline__ float gelu_exact(float x) { return 0.5f * x * (1.f + erff(x * 0.7071067811865476f)); }
__device__ __forceinline__ void expert_phase(const Params& p, LAS unsigned char* lds, int bid, int nblk, bool dry) {
    const int tid = threadIdx.x, lane = tid & 63, wid = tid >> 6;
    const bf16_t* h2 = (const bf16_t*)(p.ws + WS_H2); const unsigned char* ut = p.ws + WS_UT; const unsigned char* vt = p.ws + WS_VT;
    const unsigned short* eidx = (const unsigned short*)(p.ws + WS_EIDX); const float* gate = (const float*)(p.ws + WS_GATE); const float* mod = (const float*)(p.ws + WS_MOD);
    LAS unsigned char* H8 = lds + wid * EX_WSZ; LAS float* ACT = (LAS float*)(lds + wid * EX_WSZ + 1024); LAS int* EI = (LAS int*)(lds + wid * EX_WSZ + 1536);
    for (int t = bid * NWAVE + wid; t < T; t += nblk * NWAVE) {
        const int b = t / S;
        {
            f32x4 a0, a1, a2, a3; ld_bf16x8(h2 + (size_t)t * D + 16 * lane, a0, a1); ld_bf16x8(h2 + (size_t)t * D + 16 * lane + 8, a2, a3);
            u32x4 o; int w;
            w = __builtin_amdgcn_cvt_pk_fp8_f32(a0.x, a0.y, 0, false); w = __builtin_amdgcn_cvt_pk_fp8_f32(a0.z, a0.w, w, true); o.x = (unsigned)w;
            w = __builtin_amdgcn_cvt_pk_fp8_f32(a1.x, a1.y, 0, false); w = __builtin_amdgcn_cvt_pk_fp8_f32(a1.z, a1.w, w, true); o.y = (unsigned)w;
            w = __builtin_amdgcn_cvt_pk_fp8_f32(a2.x, a2.y, 0, false); w = __builtin_amdgcn_cvt_pk_fp8_f32(a2.z, a2.w, w, true); o.z = (unsigned)w;
            w = __builtin_amdgcn_cvt_pk_fp8_f32(a3.x, a3.y, 0, false); w = __builtin_amdgcn_cvt_pk_fp8_f32(a3.z, a3.w, w, true); o.w = (unsigned)w;
            *(LAS u32x4*)(H8 + 16 * lane) = o;
        }
        float g0v, g1v;
        {
            const unsigned short e0 = eidx[(size_t)t * 128 + lane], e1 = eidx[(size_t)t * 128 + 64 + lane];
            unsigned k0 = ((unsigned)e0 << 7) | (unsigned)lane, k1 = ((unsigned)e1 << 7) | (unsigned)(lane + 64);
#pragma unroll
            for (int k = 2; k <= 128; k <<= 1) {
#pragma unroll
                for (int j = k >> 1; j > 0; j >>= 1) {
                    if (j == 64) { const unsigned lo_ = umin_(k0, k1), hi_ = umax_(k0, k1); k0 = lo_; k1 = hi_; }
                    else {
                        const unsigned p0 = (unsigned)__shfl_xor((int)k0, j), p1 = (unsigned)__shfl_xor((int)k1, j);
                        const bool lower = (lane & j) == 0;
                        const bool asc0 = (lane & k) == 0, asc1 = ((lane + 64) & k) == 0;
                        k0 = (lower == asc0) ? umin_(k0, p0) : umax_(k0, p0);
                        k1 = (lower == asc1) ? umin_(k1, p1) : umax_(k1, p1);
                    }
                }
            }
            EI[lane] = (int)(k0 >> 7); EI[lane + 64] = (int)(k1 >> 7);
            g0v = gate[(size_t)t * 128 + (k0 & 127u)]; g1v = gate[(size_t)t * 128 + (k1 & 127u)];
        }
        asm volatile("s_waitcnt lgkmcnt(0)" ::: "memory");
#pragma unroll 1
        for (int g = 0; g < 8; ++g) {
            const int e = EI[g * 16 + (lane & 15)];
            const unsigned char* up = ut + (size_t)e * D + 16 * (lane >> 4);
            f32x4 acc = (f32x4){0.f, 0.f, 0.f, 0.f};
#pragma unroll
            for (int ks = 0; ks < 16; ++ks) {
                const u32x4 av = *(const u32x4*)(up + 64 * ks); const u32x4 bv = *(const LAS u32x4*)(H8 + 64 * ks + 16 * (lane >> 4));
                const long a0 = (long)(((unsigned long long)av.y << 32) | av.x), a1 = (long)(((unsigned long long)av.w << 32) | av.z);
                const long b0 = (long)(((unsigned long long)bv.y << 32) | bv.x), b1 = (long)(((unsigned long long)bv.w << 32) | bv.z);
                acc = __builtin_amdgcn_mfma_f32_16x16x32_fp8_fp8(a0, b0, acc, 0, 0, 0);
                acc = __builtin_amdgcn_mfma_f32_16x16x32_fp8_fp8(a1, b1, acc, 0, 0, 0);
            }
            if ((lane & 15) == 0) *(LAS f32x4*)(ACT + g * 16 + (lane >> 4) * 4) = acc * (1.f / U_SCALE);
        }
        asm volatile("s_waitcnt lgkmcnt(0)" ::: "memory");
        { const float d0 = ACT[lane], d1 = ACT[lane + 64];
          asm volatile("s_waitcnt lgkmcnt(0)" ::: "memory");
          ACT[lane] = gelu_exact(d0) * g0v * (1.f / V_SCALE); ACT[lane + 64] = gelu_exact(d1) * g1v * (1.f / V_SCALE); }
        asm volatile("s_waitcnt lgkmcnt(0)" ::: "memory");
        float y[16];
#pragma unroll
        for (int j = 0; j < 16; ++j) y[j] = 0.f;
        for (int e0 = 0; e0 < 128; e0 += 8) {
            u32x4 w[8]; float a[8];
#pragma unroll
            for (int j = 0; j < 8; ++j) { w[j] = *(const u32x4*)(vt + (size_t)EI[e0 + j] * D + 16 * lane); a[j] = ACT[e0 + j]; }
#pragma unroll
            for (int j = 0; j < 8; ++j)
#pragma unroll
                for (int q = 0; q < 4; ++q) { const f32x2 lo = __builtin_amdgcn_cvt_pk_f32_fp8((int)w[j][q], false), hi = __builtin_amdgcn_cvt_pk_f32_fp8((int)w[j][q], true);
                    y[4 * q + 0] += a[j] * lo.x; y[4 * q + 1] += a[j] * lo.y; y[4 * q + 2] += a[j] * hi.x; y[4 * q + 3] += a[j] * hi.y; }
        }
        float* row = p.out + (size_t)t * D + 16 * lane; const float* g2 = mod + b * 6144 + 5120 + 16 * lane;
        float v[16]; float s = 0.f;
#pragma unroll
        for (int q = 0; q < 4; ++q) { const f32x4 xv = *(const f32x4*)(row + 4 * q), gv = *(const f32x4*)(g2 + 4 * q);
            v[4 * q + 0] = xv.x * DN_ALPHA + gv.x * y[4 * q + 0]; v[4 * q + 1] = xv.y * DN_ALPHA + gv.y * y[4 * q + 1]; v[4 * q + 2] = xv.z * DN_ALPHA + gv.z * y[4 * q + 2]; v[4 * q + 3] = xv.w * DN_ALPHA + gv.w * y[4 * q + 3]; }
#pragma unroll
        for (int j = 0; j < 16; ++j) s += v[j];
        const float mean = wave_sum(s) * (1.f / D); float qq = 0.f;
#pragma unroll
        for (int j = 0; j < 16; ++j) { v[j] -= mean; qq += v[j] * v[j]; }
        const float rstd = rsqrtf(wave_sum(qq) * (1.f / D) + LN_EPS);
#pragma unroll
        for (int q = 0; q < 4; ++q) { const int c = 16 * lane + 4 * q; const f32x4 gv = *(const f32x4*)(p.ln2_g + c), bv = *(const f32x4*)(p.ln2_b + c);
            f32x4 o; o.x = v[4 * q + 0] * rstd * gv.x + bv.x; o.y = v[4 * q + 1] * rstd * gv.y + bv.y; o.z = v[4 * q + 2] * rstd * gv.z + bv.z; o.w = v[4 * q + 3] * rstd * gv.w + bv.w;
            if (!dry) *(f32x4*)(row + 4 * q) = o; else KEEP4(o); }
        asm volatile("s_waitcnt lgkmcnt(0)" ::: "memory");
    }
}

#define XB_TMO      128
#define XB_XCNT(j)  (256  + 64 * (j))
#define XB_XSUB(j)  (1280 + 64 * (j))
#define XB_XGEN(j)  (2304 + 64 * (j))
#define XB_TOP      3328
#define XB_TOPGEN   3392
#define XCD_BAR_WORDS 3456
#define XB_SPIN_CAP (1u << 18)
__device__ __forceinline__ unsigned xb_ld(unsigned* p)              { return __hip_atomic_load(p, __ATOMIC_RELAXED, __HIP_MEMORY_SCOPE_AGENT); }
__device__ __forceinline__ unsigned xb_add(unsigned* p, unsigned v) { return __hip_atomic_fetch_add(p, v, __ATOMIC_RELAXED, __HIP_MEMORY_SCOPE_AGENT); }
__device__ __forceinline__ unsigned xb_xcc_id() { return (unsigned)__builtin_amdgcn_s_getreg((3 << 11) | 20) & 0xFu; }
#define XB_SPIN(cond, bar) do { unsigned _sp = 0; while (cond) { __builtin_amdgcn_s_sleep(1); \
    if ((++_sp & 255u) == 0u) { if (xb_ld(&(bar)[XB_TMO])) break; if (_sp > XB_SPIN_CAP) { atomicAdd(&(bar)[XB_TMO], 1u); break; } } } } while (0)
struct XcdBarrier { unsigned* bar; unsigned x; volatile LAS unsigned* st; };
__device__ __forceinline__ XcdBarrier xcd_barrier_post(unsigned* bar, volatile LAS unsigned* st) {
    XcdBarrier b; b.bar = bar; b.x = xb_xcc_id(); b.st = st;
    if (threadIdx.x == 0) (void)xb_add(&bar[XB_XCNT(b.x)], 1u);
    return b;
}
__device__ __forceinline__ void xcd_barrier_complete(unsigned* bar, unsigned x, unsigned& nloc, unsigned& nx) {
    const unsigned G = gridDim.x * gridDim.y * gridDim.z;
    unsigned sum, cnt, mine, sp = 0u;
    for (;;) {
        sum = 0u; cnt = 0u; mine = 0u;
#pragma unroll
        for (unsigned j = 0; j < 16; ++j) { const unsigned c = xb_ld(&bar[XB_XCNT(j)]); sum += c; cnt += (c > 0u) ? 1u : 0u; mine = (j == x) ? c : mine; }
        if (sum == G) break;
        __builtin_amdgcn_s_sleep(1);
        if ((++sp & 255u) == 0u) { if (xb_ld(&bar[XB_TMO])) break; if (sp > XB_SPIN_CAP) { atomicAdd(&bar[XB_TMO], 1u); break; } }
    }
    nloc = mine > 0u ? mine : 1u; nx = cnt > 0u ? cnt : 1u;
}
__device__ __forceinline__ void xcd_barrier(const XcdBarrier& b) {
    asm volatile("s_waitcnt vmcnt(0)" ::: "memory");
    __syncthreads();
    if (threadIdx.x == 0) {
        unsigned* bar = b.bar;
        __builtin_amdgcn_s_waitcnt(0);
        unsigned nloc = b.st[0], nx = b.st[1];
        if (nloc == 0u) { xcd_barrier_complete(bar, b.x, nloc, nx); b.st[0] = nloc; b.st[1] = nx; }
        const unsigned old = xb_add(&bar[XB_XSUB(b.x)], 1u);
        const unsigned gen = old / nloc;
        if (old + 1u == (gen + 1u) * nloc) {
            __builtin_amdgcn_fence(__ATOMIC_RELEASE, "agent");
            asm volatile("s_waitcnt vmcnt(0)" ::: "memory");
            const unsigned og = xb_add(&bar[XB_TOP], 1u);
            const unsigned tg = og / nx;
            if (og + 1u == (tg + 1u) * nx) xb_add(&bar[XB_TOPGEN], 1u);
            else XB_SPIN(xb_ld(&bar[XB_TOPGEN]) == tg, bar);
            __builtin_amdgcn_fence(__ATOMIC_ACQUIRE, "agent");
            xb_add(&bar[XB_XGEN(b.x)], 1u);
            asm volatile("s_waitcnt vmcnt(0)" ::: "memory");
        } else {
            XB_SPIN(xb_ld(&bar[XB_XGEN(b.x)]) == gen, bar);
            __builtin_amdgcn_fence(__ATOMIC_ACQUIRE, "agent");
            asm volatile("s_waitcnt vmcnt(0)" ::: "memory");
        }
    }
    __syncthreads();
}

constexpr int NPHASE = 13;
__global__ void __launch_bounds__(NTHR) fwd_kernel(Params p) {
    extern __shared__ __attribute__((aligned(16))) unsigned char lds_raw[];
    LAS unsigned char* lds = (LAS unsigned char*)lds_raw;
    const int bid = blockIdx.x, nblk = gridDim.x;
    unsigned char* ws = p.ws;
#if MK_SINGLE
    volatile LAS unsigned* bst = (volatile LAS unsigned*)(lds + LDS_BYTES - 64);
    if (threadIdx.x < 2) bst[threadIdx.x] = 0u;
    __syncthreads();
    const XcdBarrier gbar = xcd_barrier_post((unsigned*)ws, bst);
#define GRID_SYNC() xcd_barrier(gbar)
#else
#define GRID_SYNC() do {} while (0)
#endif
#define PH(k) if (p.ph_lo <= (k) && (k) < p.ph_hi)
#define SEAM(k) if (p.ph_lo <= (k) && (k) + 1 < p.ph_hi) GRID_SYNC()
#define PROBE(k) if (p.probe_ph == (k))
#define PG8_RUN(Aptr, Btptr, Mm, Nn, Kk, FT, ...) PG8_RUN_G(nblk, bid, Aptr, Btptr, Mm, Nn, Kk, FT, __VA_ARGS__)
#define PG8_RUN_G(GG, CC, Aptr, Btptr, Mm, Nn, Kk, FT, ...) { pg8::Gemm g{(const pg8::bf16_t*)(Aptr), (const pg8::bf16_t*)(Btptr), Mm, Nn, Kk}; pg8::StaticOrder so; so.init(Mm, Nn, GG, CC); \
        pg8::EpiRow8<FT> e{FT{__VA_ARGS__}}; pg8::gemm_phase<pg8::EpiRow8<FT>, pg8::StaticOrder, true, true>(lds, g, so, e); }
#define RUN3(dry) PG8_RUN(ws + WS_H1, ws + WS_WIN, T, NPAD, D, FInproj, (bf16_t*)(ws + WS_ZRKV), (bf16_t*)(ws + WS_ZLORA), (bf16_t*)(ws + WS_ZQ), (bf16_t*)(ws + WS_ZMISC), (bf16_t*)(ws + WS_QIDX), (bf16_t*)(ws + WS_GA), (bf16_t*)(ws + WS_GB), dry)
#define RUN4P(dry) { dsa_norm_rows(p, bid, nblk, dry); for (int u = bid; u < (T / 64) * 8; u += nblk) rwkv_chunk_unit(p, lds, u >> 3, u & 7, dry); }
#define DSA_NS 586
#define DSA_ND 3510
#define RUN4(dry) { dsa_tables(p, lds); \
        if (bid < 64) { if (!dry) rwkv_state_out_pass(p, lds, bid >> 3, bid & 7); \
               for (int e = DSA_NS - 1 - bid; e >= 0; e -= 64) dsa_unit(p, lds, 7 * e, dry); } \
        else { for (int e = DSA_ND - 1 - (bid - 64); e >= 0; e -= (nblk - 64)) dsa_unit(p, lds, 7 * (e / 6) + (e % 6) + 1, dry); peer_tables(p, bid - 64, nblk - 64, dry); } }
#define RUN5(dry) PG8_RUN(ws + WS_ZQ, ws + WS_WB, T, D, D, FBrA, (bf16_t*)(ws + WS_GB), dry)
#define RUN6(dry) { PG8_RUN(ws + WS_YA, ws + WS_WA, T, D, 512, FBrB, (bf16_t*)(ws + WS_GA), (const bf16_t*)(ws + WS_GB), dry) }
#define RUN7(dry) PG8_RUN(ws + WS_GA, ws + WS_WO, T, D, D, FOut, p.x, (const float*)(ws + WS_MOD), p.out, dry)
#define RUN9(dry) PG8_RUN(ws + WS_H2, ws + WS_WPQ, T, D, D, FPq, (bf16_t*)(ws + WS_PQ), dry)
    PROBE(100) { phase_prep(p, lds, bid, nblk, false); GRID_SYNC(); }
    PH(0) { phase_prep(p, lds, bid, nblk, false); } SEAM(0);
    PH(1) { phase_modsum(p, bid, nblk); } SEAM(1);
    PROBE(102) { phase_h1(p, bid, nblk); GRID_SYNC(); }
    PH(2) { phase_h1(p, bid, nblk); } SEAM(2);
    PROBE(3) { RUN3(1); GRID_SYNC(); }
    PROBE(103) { RUN3(0); GRID_SYNC(); }
    PH(3) RUN3(0) SEAM(3);
    PROBE(42) { RUN4P(true); GRID_SYNC(); }
    if (p.probe_ph >= 420 && p.probe_ph < 430) { RUN4P(true); GRID_SYNC(); }
    PH(12) RUN4P(false) if (p.ph_lo <= 12 && 12 < p.ph_hi) GRID_SYNC();
    PROBE(4) { RUN4(true); GRID_SYNC(); }
    PROBE(43) { if (bid >= 64) { dsa_tables(p, lds); for (int u = (T / 8 - 1) - (bid - 64); u >= 0; u -= (nblk - 64)) dsa_unit(p, lds, u, true, 1); } GRID_SYNC(); }
    PROBE(44) { if (bid >= 64) { dsa_tables(p, lds); for (int u = (T / 8 - 1) - (bid - 64); u >= 0; u -= (nblk - 64)) dsa_unit(p, lds, u, true, 2); } GRID_SYNC(); }
    PROBE(45) { if (bid >= 64) { dsa_tables(p, lds); for (int u = (T / 8 - 1) - (bid - 64); u >= 0; u -= (nblk - 64)) dsa_unit(p, lds, u, true, 3); } GRID_SYNC(); }
    PROBE(46) { if (bid >= 64) { dsa_tables(p, lds); for (int u = (T / 8 - 1) - (bid - 64); u >= 0; u -= (nblk - 64)) dsa_unit(p, lds, u, true, 4); } GRID_SYNC(); }
    PROBE(41) { if (bid >= 64) { dsa_tables(p, lds); for (int u = (T / 8 - 1) - (bid - 64); u >= 0; u -= (nblk - 64)) dsa_unit(p, lds, u, true); } GRID_SYNC(); }
    PH(4) RUN4(false) SEAM(4);
    PROBE(5) { RUN5(1); GRID_SYNC(); }
    PH(5) RUN5(0)
    PROBE(6) { RUN6(1); GRID_SYNC(); }
    PH(6) RUN6(0) SEAM(6);
    PROBE(7) { RUN7(1); GRID_SYNC(); }
    PH(7) RUN7(0) SEAM(7);
    PH(8) { phase_ln1(p, bid, nblk); } SEAM(8);
    PROBE(9) { RUN9(1); GRID_SYNC(); }
    PH(9) RUN9(0) SEAM(9);
    PROBE(10) { route_phase(p, lds, bid, nblk, true); GRID_SYNC(); }
    PROBE(110) { route_phase(p, lds, bid, nblk, false); GRID_SYNC(); }
    PH(10) { route_phase(p, lds, bid, nblk, false); } SEAM(10);
    PROBE(11) { expert_phase(p, lds, bid, nblk, true); GRID_SYNC(); }
    PH(11) { expert_phase(p, lds, bid, nblk, false); }
}

extern "C" void kernel_launch(void* const* d_in, const int* in_sizes, int n_in, void* d_out, int out_size, void* d_ws, size_t ws_size, hipStream_t stream) {
    static int grid = 0;
    if (grid == 0) {
        if (n_in != 31 || out_size != T * D || ws_size < WS_NEED) { fprintf(stderr, "kernel_launch: unexpected shapes (n_in %d, out %d, ws %zu)\n", n_in, out_size, ws_size); grid = -1; return; }
        int dev = 0, cus = 0, per_cu = 0;
        (void)hipGetDevice(&dev); (void)hipDeviceGetAttribute(&cus, hipDeviceAttributeMultiprocessorCount, dev);
        if (hipFuncSetAttribute((const void*)fwd_kernel, hipFuncAttributeMaxDynamicSharedMemorySize, LDS_BYTES) != hipSuccess) { fprintf(stderr, "kernel_launch: hipFuncSetAttribute failed\n"); grid = -1; return; }
        if (hipOccupancyMaxActiveBlocksPerMultiprocessor(&per_cu, (const void*)fwd_kernel, NTHR, LDS_BYTES) != hipSuccess || per_cu < 1) { fprintf(stderr, "kernel_launch: occupancy query failed (%d)\n", per_cu); grid = -1; return; }
        grid = cus * (per_cu > 1 ? 1 : per_cu);
        fprintf(stderr, "kernel_launch: %d CUs, %d blocks/CU reported, grid %d\n", cus, per_cu, grid);
    }
    if (grid < 0) return;
    if (hipMemsetAsync(d_ws, 0, 16384, stream) != hipSuccess) { fprintf(stderr, "kernel_launch: memset failed\n"); return; }
    Params p{};
    const float** f = (const float**)&p;
    for (int i = 0; i < 31; ++i) f[i] = (const float*)d_in[i];
    p.out = (float*)d_out; p.ws = (unsigned char*)d_ws; p.probe_ph = PROBE_PHASE;
#if MK_SINGLE
    p.ph_lo = 0; p.ph_hi = NPHASE;
    void* args[] = {&p};
    hipError_t e = hipLaunchCooperativeKernel((const void*)fwd_kernel, dim3(grid), dim3(NTHR), args, LDS_BYTES, stream);
    if (e != hipSuccess) fprintf(stderr, "kernel_launch: cooperative launch failed: %s (grid %d)\n", hipGetErrorString(e), grid);
#else
    for (int ph = 0; ph < NPHASE; ++ph) { p.ph_lo = ph; p.ph_hi = ph + 1; hipLaunchKernelGGL(fwd_kernel, dim3(grid), dim3(NTHR), LDS_BYTES, stream, p); }
#endif
}
```

```cpp
#include <hip/hip_runtime.h>
#include <hip/hip_cooperative_groups.h>
#include <cstdio>
#include <cstdint>
namespace cg = cooperative_groups;

#ifndef PROBE_PHASE
#define PROBE_PHASE -1
#endif
#ifndef MK_SINGLE
#define MK_SINGLE 1
#endif

#define LAS __attribute__((address_space(3)))
typedef unsigned short bf16_t;
typedef short bf16x8 __attribute__((ext_vector_type(8)));
typedef float f32x4 __attribute__((ext_vector_type(4)));
typedef float f32x2 __attribute__((ext_vector_type(2)));
typedef unsigned u32x4 __attribute__((ext_vector_type(4)));
typedef unsigned u32x2 __attribute__((ext_vector_type(2)));

constexpr int D = 1024, NB = 8, S = 4096, T = NB * S;
constexpr int RW_H = 8, RW_N = 64, RW_DIM = 512;
constexpr int IN_COLS = 5316, NPAD = 5376;
constexpr int TOPK = 256;
constexpr int PEER_E = 16384;
constexpr float LN_EPS = 1e-5f;
constexpr float DN_ALPHA = 1.189207115002721f;
constexpr float RW_GN_EPS = 64e-5f;
constexpr int NTHR = 512, NWAVE = 8;
constexpr int LDS_BYTES = 147456;

constexpr size_t MiB = 1u << 20;
constexpr size_t WS_MODP = 90 * MiB;
constexpr size_t WS_MOD = 4 * MiB;
constexpr size_t WS_WIN = 5 * MiB;
constexpr size_t WS_WA = 16 * MiB;
constexpr size_t WS_WB = 17 * MiB;
constexpr size_t WS_WO = 19 * MiB;
constexpr size_t WS_WPQ = 21 * MiB;
constexpr size_t WS_W2T = 23 * MiB;
constexpr size_t WS_A2T = WS_W2T + 65536;
constexpr size_t WS_G2T = WS_A2T + 65536;
constexpr size_t WS_KEYS = WS_G2T + 131072;
constexpr size_t WS_UT = 24 * MiB;
constexpr size_t WS_VT = 40 * MiB;
constexpr float U_SCALE = 64.f, V_SCALE = 8.f;
constexpr size_t WS_ZRKV = 88 * MiB;
constexpr size_t WS_ZLORA = 184 * MiB;
constexpr size_t WS_ZQ = 200 * MiB;
constexpr size_t WS_GA = 264 * MiB;
constexpr size_t WS_GB = 328 * MiB;
constexpr size_t WS_CKV = 392 * MiB;
constexpr size_t WS_KIDX = 400 * MiB;
constexpr size_t WS_WIDX = 404 * MiB;
constexpr size_t WS_QIDX = 405 * MiB;
constexpr size_t WS_H1 = 421 * MiB;
constexpr size_t WS_YA = 421 * MiB;
constexpr size_t WS_SEL = 453 * MiB;
constexpr size_t WS_CNT = 469 * MiB;
constexpr size_t WS_H2 = 88 * MiB;
constexpr size_t WS_PQ = 200 * MiB;
constexpr size_t WS_EIDX = 328 * MiB;
constexpr size_t WS_GATE = 336 * MiB;
constexpr size_t WS_RG = 453 * MiB;
constexpr size_t WS_ZMISC = 485 * MiB;
constexpr size_t WS_NEED = 502 * MiB;

__device__ __forceinline__ unsigned f2bf(float f) { unsigned u = __float_as_uint(f); return (u + 0x7fffu + ((u >> 16) & 1u)) >> 16; }
__device__ __forceinline__ unsigned pk2(float lo, float hi) { return f2bf(lo) | (f2bf(hi) << 16); }
__device__ __forceinline__ unsigned pk2h(float lo, float hi) { unsigned r; asm("s_nop 1\n\tv_cvt_pk_bf16_f32 %0, %1, %2" : "=v"(r) : "v"(lo), "v"(hi)); return r; }
__device__ __forceinline__ float bf2f(bf16_t b) { return __uint_as_float((unsigned)b << 16); }
__device__ __forceinline__ float bflo(unsigned w) { return __uint_as_float(w << 16); }
__device__ __forceinline__ float bfhi(unsigned w) { return __uint_as_float(w & 0xffff0000u); }
__device__ __forceinline__ float sigmoidf_(float x) { return __builtin_amdgcn_rcpf(1.f + __expf(-x)); }
__device__ __forceinline__ float tanh_fast(float x) { return 1.f - 2.f * __builtin_amdgcn_rcpf(1.f + __expf(2.f * x)); }
__device__ __forceinline__ float wave_sum(float v) {
#pragma unroll
    for (int o = 1; o < 64; o <<= 1) v += __shfl_xor(v, o);
    return v;
}
template <int CTRL> __device__ __forceinline__ float dppf(float x) {
    return __int_as_float(__builtin_amdgcn_update_dpp(0, __float_as_int(x), CTRL, 0xf, 0xf, true));
}
__device__ __forceinline__ float red8(float x) { x += dppf<0xB1>(x); x += dppf<0x4E>(x); x += dppf<0x141>(x); return x; }
__device__ __forceinline__ float red16_sum(float x) { x += dppf<0xB1>(x); x += dppf<0x4E>(x); x += dppf<0x141>(x); x += dppf<0x140>(x); return x; }
__device__ __forceinline__ float red16_max(float x) { x = fmaxf(x, dppf<0xB1>(x)); x = fmaxf(x, dppf<0x4E>(x)); x = fmaxf(x, dppf<0x141>(x)); x = fmaxf(x, dppf<0x140>(x)); return x; }
__device__ __forceinline__ void st_bf16x4(bf16_t* p, f32x4 v) { u32x2 w; w.x = pk2(v.x, v.y); w.y = pk2(v.z, v.w); *(u32x2*)p = w; }
__device__ __forceinline__ unsigned umax_(unsigned a, unsigned b) { return a > b ? a : b; }
__device__ __forceinline__ unsigned umin_(unsigned a, unsigned b) { return a < b ? a : b; }
__device__ __forceinline__ unsigned sortable(float f) { const unsigned u = __float_as_uint(f); return u ^ ((unsigned)((int)u >> 31) | 0x80000000u); }

__device__ __forceinline__ f32x4 ld_bf16x4(const bf16_t* p) { const u32x2 w = *(const u32x2*)p; return (f32x4){bflo(w.x), bfhi(w.x), bflo(w.y), bfhi(w.y)}; }
__device__ __forceinline__ void ld_bf16x8(const bf16_t* p, f32x4& a, f32x4& b) { const u32x4 w = *(const u32x4*)p; a = (f32x4){bflo(w.x), bfhi(w.x), bflo(w.y), bfhi(w.y)}; b = (f32x4){bflo(w.z), bfhi(w.z), bflo(w.w), bfhi(w.w)}; }
#define KEEP1(x) asm volatile("" :: "v"(x))
#define KEEP4(v) asm volatile("" :: "v"((v).x), "v"((v).y), "v"((v).z), "v"((v).w))
struct Params {
    const float *x, *c, *w_ada, *b_ada, *w_in, *rw_mu, *rw_w0, *rw_w2, *rw_a0, *rw_a2, *rw_g2, *rw_k_k, *rw_k_a, *rw_r_k, *rw_gn_g, *rw_gn_b;
    const float *dsa_kv_g, *idx_k_g, *idx_k_b, *rel_bias, *w_br_a, *w_br_b, *w_out, *ln1_g, *ln1_b, *peer_wq, *peer_keys, *peer_u, *peer_v, *ln2_g, *ln2_b;
    float* out; unsigned char* ws;
    int ph_lo, ph_hi, probe_ph, pad;
};

__device__ __forceinline__ int win_src_col(int r) {
    if (r < 2944) return r;
    if (r < 3008) return r + 256;
    if (r < 3012) return r + 256;
    if (r < 3072) return -1;
    if (r < 3328) return r - 128;
    return r - 60;
}
template <bool WIN>
__device__ __forceinline__ void transpose_item(const float* W, int K, int N, bf16_t* WT, LAS float* scr, int item, int lane, int nrows, bool dry) {
    const int nblk = nrows / 32, kb = item / nblk, nb = item % nblk, k0 = 64 * kb, n0 = 32 * nb;
    const int rr = n0 + (lane & 31);
    const int sc = WIN ? win_src_col(rr) : rr;
#pragma unroll 8
    for (int i = 0; i < 32; ++i) { const int kk = 2 * i + (lane >> 5); scr[kk * 33 + (lane & 31)] = (sc >= 0) ? W[(size_t)(k0 + kk) * N + sc] : 0.f; }
    asm volatile("s_waitcnt lgkmcnt(0)" ::: "memory");
    const int c = lane & 7;
#pragma unroll
    for (int j = 0; j < 4; ++j) { const int n = (lane >> 3) + 8 * j; const LAS float* s = scr + (8 * c) * 33 + n;
        u32x4 o; o.x = pk2(s[0 * 33], s[1 * 33]); o.y = pk2(s[2 * 33], s[3 * 33]); o.z = pk2(s[4 * 33], s[5 * 33]); o.w = pk2(s[6 * 33], s[7 * 33]);
        if (!dry) *(u32x4*)(WT + (size_t)(n0 + n) * K + k0 + 8 * c) = o; }
    asm volatile("s_waitcnt lgkmcnt(0)" ::: "memory");
}

__device__ __forceinline__ void peer_tables(const Params& p, int bid, int nblk, bool dry) {
    const int tid = threadIdx.x; unsigned char* ws = p.ws;
    {
        const size_t gt = (size_t)bid * NTHR + tid, GT = (size_t)nblk * NTHR;
        constexpr size_t NU = (size_t)PEER_E * D / 16, NK = (size_t)8 * 2 * 128 * 64 / 16;
        for (size_t i = gt; i < 2 * NU + NK; i += GT) {
            if (i < 2 * NU) {
                const bool isv = i >= NU; const size_t j = isv ? i - NU : i;
                const float* src = (isv ? p.peer_v : p.peer_u) + j * 16; unsigned char* dst = ws + (isv ? WS_VT : WS_UT) + j * 16; const float sc = isv ? V_SCALE : U_SCALE;
                u32x4 o;
#pragma unroll
                for (int q = 0; q < 4; ++q) { const f32x4 a = *(const f32x4*)(src + 4 * q) * sc; int w = __builtin_amdgcn_cvt_pk_fp8_f32(a.x, a.y, 0, false); w = __builtin_amdgcn_cvt_pk_fp8_f32(a.z, a.w, w, true); o[q] = (unsigned)w; }
                if (!dry) *(u32x4*)dst = o; else KEEP4(o);
            } else {
                const size_t j = i - 2 * NU; const float* src = p.peer_keys + j * 16; bf16_t* dst = (bf16_t*)(ws + WS_KEYS) + j * 16;
#pragma unroll
                for (int hh = 0; hh < 2; ++hh) { const f32x4 a = *(const f32x4*)(src + 8 * hh), b = *(const f32x4*)(src + 8 * hh + 4);
                    u32x4 o; o.x = pk2(a.x, a.y); o.y = pk2(a.z, a.w); o.z = pk2(b.x, b.y); o.w = pk2(b.z, b.w); if (!dry) *(u32x4*)(dst + 8 * hh) = o; else KEEP4(o); }
            }
        }
    }
}
__device__ __forceinline__ void phase_prep(const Params& p, LAS unsigned char* lds, int bid, int nblk, bool dry) {
    const int tid = threadIdx.x, lane = tid & 63, wid = tid >> 6;
    const int gw = bid * NWAVE + wid, NGW = nblk * NWAVE;
    unsigned char* ws = p.ws;
    LAS float* scr = (LAS float*)(lds + wid * 16384);
    constexpr int I_IN = (D / 64) * (NPAD / 32), I_A = (512 / 64) * (D / 32), I_B = (D / 64) * (D / 32), I_W2 = 1 * (512 / 32), I_G2 = 2 * (512 / 32);
    constexpr int NIT = I_IN + I_A + 3 * I_B + 2 * I_W2 + I_G2;
    for (int it = gw; it < NIT; it += NGW) {
        int r = it;
        if (r < I_IN) { transpose_item<true>(p.w_in, D, IN_COLS, (bf16_t*)(ws + WS_WIN), scr, r, lane, NPAD, dry); continue; } r -= I_IN;
        if (r < I_A) { transpose_item<false>(p.w_br_a, 512, D, (bf16_t*)(ws + WS_WA), scr, r, lane, D, dry); continue; } r -= I_A;
        if (r < I_B) { transpose_item<false>(p.w_br_b, D, D, (bf16_t*)(ws + WS_WB), scr, r, lane, D, dry); continue; } r -= I_B;
        if (r < I_B) { transpose_item<false>(p.w_out, D, D, (bf16_t*)(ws + WS_WO), scr, r, lane, D, dry); continue; } r -= I_B;
        if (r < I_B) { transpose_item<false>(p.peer_wq, D, D, (bf16_t*)(ws + WS_WPQ), scr, r, lane, D, dry); continue; } r -= I_B;
        if (r < I_W2) { transpose_item<false>(p.rw_w2, 64, 512, (bf16_t*)(ws + WS_W2T), scr, r, lane, 512, dry); continue; } r -= I_W2;
        if (r < I_W2) { transpose_item<false>(p.rw_a2, 64, 512, (bf16_t*)(ws + WS_A2T), scr, r, lane, 512, dry); continue; } r -= I_W2;
        transpose_item<false>(p.rw_g2, 128, 512, (bf16_t*)(ws + WS_G2T), scr, r, lane, 512, dry);
    }
    {
        float* modp = (float*)(ws + WS_MODP); LAS float* SV = (LAS float*)lds;
        __syncthreads();
        for (int i = tid; i < 8 * D; i += NTHR) { const int b = i >> 10, k = i & 1023; const float cv = p.c[i]; SV[k * 8 + b] = cv * __builtin_amdgcn_rcpf(1.f + __expf(-cv)); }
        __syncthreads();
        for (int it = gw; it < 64 * 24; it += NGW) {
            const int kb = it / 24, jb = it % 24;
            f32x4 w[16];
#pragma unroll
            for (int i = 0; i < 16; ++i) w[i] = *(const f32x4*)(p.w_ada + (size_t)(kb * 16 + i) * 6144 + jb * 256 + 4 * lane);
            f32x4 acc[8];
#pragma unroll
            for (int b = 0; b < 8; ++b) acc[b] = (f32x4){0.f, 0.f, 0.f, 0.f};
#pragma unroll
            for (int i = 0; i < 16; ++i) { const f32x4 s0 = *(const LAS f32x4*)(SV + (kb * 16 + i) * 8), s1 = *(const LAS f32x4*)(SV + (kb * 16 + i) * 8 + 4);
                acc[0] += w[i] * s0.x; acc[1] += w[i] * s0.y; acc[2] += w[i] * s0.z; acc[3] += w[i] * s0.w; acc[4] += w[i] * s1.x; acc[5] += w[i] * s1.y; acc[6] += w[i] * s1.z; acc[7] += w[i] * s1.w; }
#pragma unroll
            for (int b = 0; b < 8; ++b) if (!dry) *(f32x4*)(modp + ((size_t)kb * 8 + b) * 6144 + jb * 256 + 4 * lane) = acc[b];
        }
    }
}
__device__ __forceinline__ void phase_modsum(const Params& p, int bid, int nblk) {
    const float* modp = (const float*)(p.ws + WS_MODP); float* mod = (float*)(p.ws + WS_MOD);
    for (int i = bid * NTHR + threadIdx.x; i < 8 * 6144; i += nblk * NTHR) {
        const int b = i / 6144, j = i % 6144; float s = p.b_ada[j];
#pragma unroll
        for (int kb = 0; kb < 64; ++kb) s += modp[((size_t)kb * 8 + b) * 6144 + j];
        mod[i] = s;
    }
}
__device__ __forceinline__ void phase_h1(const Params& p, int bid, int nblk) {
    const int lane = threadIdx.x & 63, wid = threadIdx.x >> 6;
    const float* mod = (const float*)(p.ws + WS_MOD); bf16_t* h1 = (bf16_t*)(p.ws + WS_H1);
    for (int m = bid * NWAVE + wid; m < T; m += nblk * NWAVE) {
        const int b = m / S; const float* sh = mod + b * 6144, *sc = sh + 1024;
#pragma unroll
        for (int j = 0; j < 4; ++j) { const int c0 = 4 * lane + 256 * j;
            const f32x4 xv = *(const f32x4*)(p.x + (size_t)m * D + c0), s1 = *(const f32x4*)(sc + c0), s0 = *(const f32x4*)(sh + c0);
            st_bf16x4(h1 + (size_t)m * D + c0, xv * (1.f + s1) + s0); }
    }
}

namespace pg8 {
#define PG8_LAS __attribute__((address_space(3)))
typedef unsigned short bf16_t;
typedef short bf16x8 __attribute__((ext_vector_type(8)));
typedef float f32x4 __attribute__((ext_vector_type(4)));
typedef unsigned u32x4 __attribute__((ext_vector_type(4)));
constexpr int BM = 256, BK = 64, HALF = 128, HTB = HALF * BK * 2  , STAGE_BYTES = 8 * HTB, NXCD = 8, WGM = 8;

__host__ __device__ __forceinline__ int lds_byte(int r, int c) { const int st = (r >> 4) * 2 + (c >> 5), rr = r & 15, cc = c & 31, ob = rr * 64 + cc * 2; return st * 1024 + (ob ^ (((ob >> 9) & 1) << 5)); }
__host__ __device__ __forceinline__ void stage_rc(int b, int& R, int& C) { const int st = b / 1024, sb = b % 1024, swz = sb ^ (((sb >> 9) & 1) << 5); R = (st >> 1) * 16 + swz / 64; C = (st & 1) * 32 + (swz % 64) / 2; }
__host__ __device__ __forceinline__ int perm32(int rho) { const int n = rho >> 4, i = rho & 15; return 8 * (i >> 2) + 4 * n + (i & 3); }

struct Unit { int pm, pn; };
struct Gemm { const bf16_t* A; const bf16_t* Bt; int M, N, K; };

struct StaticOrder {
    int nM, nN, nwg, G, c;
    __host__ __device__ void init(int M, int N, int G_, int c_) { nM = M / BM; nN = N / BM; nwg = nM * nN; G = G_; c = c_; }
    __host__ __device__ bool next(int i, Unit& u) const {
        const long L = (long)i * G + c; if (L >= nwg) return false;
        int wgid = (int)L; { const int q = nwg / NXCD, r = nwg % NXCD, xcd = wgid % NXCD, off = wgid / NXCD; wgid = (xcd < r ? xcd * (q + 1) : r * (q + 1) + (xcd - r) * q) + off; }
        const int nig = WGM * nN, gid = wgid / nig, fm = gid * WGM, gsz = (nM - fm) < WGM ? (nM - fm) : WGM;
        u.pm = fm + ((wgid % nig) % gsz); u.pn = (wgid % nig) / gsz; return true;
    }
    __device__ __forceinline__ void a_ready(const Unit&) const {}
    __device__ __forceinline__ void done(const Unit&) const {}
};

__device__ __forceinline__ unsigned cvt_pk_bf16(float lo, float hi) { unsigned r; asm volatile("s_nop 0\n\tv_cvt_pk_bf16_f32 %0, %1, %2" : "=v"(r) : "v"(lo), "v"(hi)); return r; }
template <class Epi, class Sched, bool ALIGN_EPI = false, bool SP2 = false>
__device__ __forceinline__ void gemm_phase(PG8_LAS unsigned char* lds, const Gemm g, const Sched& S, const Epi& E) {
    const int tid = threadIdx.x, wid = __builtin_amdgcn_readfirstlane(tid >> 6), lane = tid & 63, wr = wid >> 2, wc = wid & 3, fr = lane & 15, fq = lane >> 4;
    const int K = g.K, nt = K / BK;
    unsigned voffA[2], voffB[2];
#pragma unroll
    for (int i = 0; i < 2; ++i) { int R, C; stage_rc(tid * 16 + i * 8192, R, C); const int Rb = Epi::PERM ? ((R & ~31) + perm32(R & 31)) : R;
        voffA[i] = (unsigned)(R * K + C) * 2u; voffB[i] = (unsigned)(Rb * K + C) * 2u; }
    const size_t kstep = (size_t)(BK * 2);
    const size_t hstep = (size_t)HALF * K * 2;
    const size_t tstep = 2 * hstep;
    const unsigned ldsw = (unsigned)wid * 1024u;
    const int aoff = lds_byte(wr * 64 + fr, fq * 8), boff = lds_byte(wc * 32 + fr, fq * 8);
#define PG8_SA(b, h) (((b) * 2 + (h)) * HTB)
#define PG8_SB(b, h) ((4 + (b) * 2 + (h)) * HTB)
#define PG8_STAGE(bufoff, gbase, voff) do { _Pragma("unroll") for (int _i = 0; _i < 2; ++_i) \
        __builtin_amdgcn_global_load_lds((const unsigned*)((const char*)(gbase) + (voff)[_i]), (PG8_LAS unsigned*)(lds + (bufoff) + ldsw + _i * 8192), 16, 0, 0); } while (0)
#define PG8_LDA(dst, b, h) do { _Pragma("unroll") for (int m = 0; m < 4; ++m) _Pragma("unroll") for (int k = 0; k < 2; ++k) dst[m][k] = *(const PG8_LAS bf16x8*)(lds + PG8_SA(b, h) + aoff + m * 2048 + k * 1024); } while (0)
#define PG8_LDB(dst, b, h) do { _Pragma("unroll") for (int n = 0; n < 2; ++n) _Pragma("unroll") for (int k = 0; k < 2; ++k) dst[n][k] = *(const PG8_LAS bf16x8*)(lds + PG8_SB(b, h) + boff + n * 2048 + k * 1024); } while (0)
#define PG8_MMA(ai, bj, At, Bt) do { __builtin_amdgcn_s_setprio(1); _Pragma("unroll") for (int m = 0; m < 4; ++m) _Pragma("unroll") for (int n = 0; n < 2; ++n) _Pragma("unroll") for (int k = 0; k < 2; ++k) \
        acc[ai][bj][m][n] = __builtin_amdgcn_mfma_f32_16x16x32_bf16(Bt[n][k], At[m][k], acc[ai][bj][m][n], 0, 0, 0); __builtin_amdgcn_s_setprio(0); } while (0)
#define PG8_WAIT_V(n) asm volatile("s_waitcnt vmcnt(" #n ")" ::: "memory")
#define PG8_WAIT_L(n) asm volatile("s_waitcnt lgkmcnt(" #n ")" ::: "memory")
#define PG8_BAR __builtin_amdgcn_s_barrier()
#define PG8_SCHED __builtin_amdgcn_sched_barrier(0)
    Unit cur, nxt; int ui = 0;
    if (!S.next(0, cur)) return;
    f32x4 acc[2][2][4][2];
#pragma unroll
    for (int a = 0; a < 2; ++a)
#pragma unroll
        for (int b = 0; b < 2; ++b)
#pragma unroll
            for (int m = 0; m < 4; ++m)
#pragma unroll
                for (int n = 0; n < 2; ++n) acc[a][b][m][n] = (f32x4){0.f, 0.f, 0.f, 0.f};
    bf16x8 At[4][2], B0[2][2], B1[2][2];
    const char* cA = (const char*)g.A + (size_t)cur.pm * tstep; const char* cB = (const char*)g.Bt + (size_t)cur.pn * tstep;
    S.a_ready(cur);
    if constexpr (SP2) {
        PG8_STAGE(PG8_SB(0, 0), cB, voffB); PG8_STAGE(PG8_SB(0, 1), cB + hstep, voffB); PG8_STAGE(PG8_SA(0, 0), cA, voffA); PG8_STAGE(PG8_SA(0, 1), cA + hstep, voffA);
        if (wr == 1) PG8_BAR;
        PG8_WAIT_V(2); PG8_BAR;
        PG8_STAGE(PG8_SB(1, 0), cB + kstep, voffB); PG8_STAGE(PG8_SA(1, 0), cA + kstep, voffA); PG8_STAGE(PG8_SB(1, 1), cB + hstep + kstep, voffB);
        PG8_WAIT_V(6); PG8_BAR;
    } else {
        PG8_STAGE(PG8_SB(0, 0), cB, voffB); PG8_STAGE(PG8_SA(0, 0), cA, voffA); PG8_STAGE(PG8_SB(0, 1), cB + hstep, voffB); PG8_STAGE(PG8_SA(0, 1), cA + hstep, voffA);
        if (wr == 1) PG8_BAR;
        PG8_WAIT_V(4); PG8_BAR;
        PG8_STAGE(PG8_SB(1, 0), cB + kstep, voffB); PG8_STAGE(PG8_SA(1, 0), cA + kstep, voffA); PG8_STAGE(PG8_SB(1, 1), cB + hstep + kstep, voffB);
        PG8_WAIT_V(6); PG8_BAR;
    }
    for (;;) {
        const bool has_next = S.next(ui + 1, nxt);
        const char* nA = has_next ? (const char*)g.A + (size_t)nxt.pm * tstep : cA; const char* nB = has_next ? (const char*)g.Bt + (size_t)nxt.pn * tstep : cB;
        for (int t = 0; t < nt; t += 2) {
            const bool last = (t == nt - 2);
            const char* a1 = cA + (size_t)(t + 1) * kstep;
            const char* a2 = last ? nA : cA + (size_t)(t + 2) * kstep; const char* b2 = last ? nB : cB + (size_t)(t + 2) * kstep;
            const char* a3 = a2 + kstep; const char* b3 = b2 + kstep;
            if (last && has_next) S.a_ready(nxt);
            if constexpr (SP2) {
            PG8_LDB(B0, 0, 0); PG8_LDB(B1, 0, 1); PG8_SCHED; PG8_LDA(At, 0, 0); PG8_STAGE(PG8_SA(1, 1), a1 + hstep, voffA);
            PG8_WAIT_V(8); PG8_WAIT_L(0); PG8_BAR; PG8_MMA(0, 0, At, B0); PG8_MMA(0, 1, At, B1); PG8_BAR; PG8_SCHED;
            PG8_LDA(At, 0, 1); PG8_STAGE(PG8_SB(0, 0), b2, voffB); PG8_STAGE(PG8_SB(0, 1), b2 + hstep, voffB); PG8_STAGE(PG8_SA(0, 0), a2, voffA);
            PG8_WAIT_V(8); PG8_WAIT_L(0); PG8_BAR; PG8_MMA(1, 0, At, B0); PG8_MMA(1, 1, At, B1); PG8_BAR; PG8_SCHED;
            PG8_LDB(B0, 1, 0); PG8_LDB(B1, 1, 1); PG8_SCHED; PG8_LDA(At, 1, 0); PG8_STAGE(PG8_SA(0, 1), a2 + hstep, voffA);
            PG8_WAIT_V(8); PG8_WAIT_L(0); PG8_BAR; PG8_MMA(0, 0, At, B0); PG8_MMA(0, 1, At, B1); PG8_BAR; PG8_SCHED;
            PG8_LDA(At, 1, 1); PG8_STAGE(PG8_SB(1, 0), b3, voffB); PG8_STAGE(PG8_SB(1, 1), b3 + hstep, voffB); PG8_STAGE(PG8_SA(1, 0), a3, voffA);
            PG8_WAIT_V(8); PG8_WAIT_L(0); PG8_BAR; PG8_MMA(1, 0, At, B0); PG8_MMA(1, 1, At, B1); PG8_BAR; PG8_SCHED;
            } else {
            PG8_LDB(B0, 0, 0); PG8_SCHED; PG8_LDA(At, 0, 0); PG8_STAGE(PG8_SA(1, 1), a1 + hstep, voffA);
            PG8_WAIT_L(8); PG8_BAR; PG8_WAIT_L(0); PG8_MMA(0, 0, At, B0); PG8_BAR; PG8_SCHED;
            PG8_LDB(B1, 0, 1); PG8_STAGE(PG8_SB(0, 0), b2, voffB);
            PG8_BAR; PG8_WAIT_L(0); PG8_MMA(0, 1, At, B1); PG8_BAR;
            PG8_LDA(At, 0, 1); PG8_STAGE(PG8_SA(0, 0), a2, voffA);
            PG8_BAR; PG8_WAIT_L(0); PG8_MMA(1, 0, At, B0); PG8_BAR; PG8_SCHED;
            PG8_STAGE(PG8_SB(0, 1), b2 + hstep, voffB);
            PG8_WAIT_V(6); PG8_BAR; PG8_MMA(1, 1, At, B1); PG8_BAR;
            PG8_LDB(B0, 1, 0); PG8_SCHED; PG8_LDA(At, 1, 0); PG8_STAGE(PG8_SA(0, 1), a2 + hstep, voffA);
            PG8_WAIT_L(8); PG8_BAR; PG8_WAIT_L(0); PG8_MMA(0, 0, At, B0); PG8_BAR; PG8_SCHED;
            PG8_LDB(B1, 1, 1); PG8_STAGE(PG8_SB(1, 0), b3, voffB);
            PG8_BAR; PG8_WAIT_L(0); PG8_MMA(0, 1, At, B1); PG8_BAR;
            PG8_LDA(At, 1, 1); PG8_STAGE(PG8_SA(1, 0), a3, voffA);
            PG8_BAR; PG8_WAIT_L(0); PG8_MMA(1, 0, At, B0); PG8_BAR; PG8_SCHED;
            PG8_STAGE(PG8_SB(1, 1), b3 + hstep, voffB);
            PG8_WAIT_V(6); PG8_BAR; PG8_MMA(1, 1, At, B1); PG8_BAR;
            }
        }
        if constexpr (ALIGN_EPI) { if (wr == 0) PG8_BAR; }
        if constexpr (!Epi::AFTER_DRAIN) { E(acc, cur, wr, wc, fr, fq); S.done(cur); }
        if (!has_next) break;
#pragma unroll
        for (int a = 0; a < 2; ++a)
#pragma unroll
            for (int b = 0; b < 2; ++b)
#pragma unroll
                for (int m = 0; m < 4; ++m)
#pragma unroll
                    for (int n = 0; n < 2; ++n) acc[a][b][m][n] = (f32x4){0.f, 0.f, 0.f, 0.f};
        cur = nxt; cA = nA; cB = nB; ++ui;
        if constexpr (ALIGN_EPI) { if (wr == 1) PG8_BAR; }
    }
    PG8_WAIT_V(0);
    if constexpr (!ALIGN_EPI) { if (wr == 0) PG8_BAR; }
    PG8_BAR;
    if constexpr (Epi::AFTER_DRAIN) { E.fused(acc, cur, wr, wc, fr, fq, lds, wid, lane); S.done(cur); }
#undef PG8_SA
#undef PG8_SB
#undef PG8_STAGE
#undef PG8_LDA
#undef PG8_LDB
#undef PG8_MMA
#undef PG8_WAIT_V
#undef PG8_WAIT_L
#undef PG8_BAR
#undef PG8_SCHED
}

template <class F> struct EpiRow8 {
    static constexpr bool PERM = true, AFTER_DRAIN = false; F f;
    __device__ __forceinline__ void operator()(const f32x4 (&acc)[2][2][4][2], const Unit& u, int wr, int wc, int fr, int fq) const {
        const int row0 = u.pm * BM + wr * 64 + fr, col0 = u.pn * BM + wc * 32 + 8 * fq;
        asm volatile("s_nop 7\n\ts_nop 7" ::: "memory"); __builtin_amdgcn_sched_barrier(0);
#pragma unroll
        for (int ai = 0; ai < 2; ++ai)
#pragma unroll
            for (int m = 0; m < 4; ++m)
#pragma unroll
                for (int bj = 0; bj < 2; ++bj) f(row0 + ai * HALF + m * 16, col0 + bj * HALF, acc[ai][bj][m][0], acc[ai][bj][m][1]);
    }
};
}
__device__ __forceinline__ u32x4 pk8(f32x4 a, f32x4 b) { u32x4 w; w.x = pg8::cvt_pk_bf16(a.x, a.y); w.y = pg8::cvt_pk_bf16(a.z, a.w); w.z = pg8::cvt_pk_bf16(b.x, b.y); w.w = pg8::cvt_pk_bf16(b.z, b.w); return w; }
__device__ __forceinline__ f32x4 sig4(f32x4 v) { f32x4 s; s.x = sigmoidf_(v.x); s.y = sigmoidf_(v.y); s.z = sigmoidf_(v.z); s.w = sigmoidf_(v.w); return s; }
#define F_DRY if (dry) { KEEP4(v0); KEEP4(v1); return; }
struct FInproj { bf16_t *zrkv, *zlora, *zq, *zmisc, *qidx, *ga, *gb; int dry;
    __device__ __forceinline__ void operator()(int row, int col, f32x4 v0, f32x4 v1) const { F_DRY
        if (col < 1536) *(u32x4*)(zrkv + (size_t)row * 1536 + col) = pk8(v0, v1);
        else if (col < 1792) *(u32x4*)(zlora + (size_t)row * 256 + (col - 1536)) = pk8(v0, v1);
        else if (col < 2816) *(u32x4*)(zq + (size_t)row * 1024 + (col - 1792)) = pk8(v0 * 0.12751743082459868f, v1 * 0.12751743082459868f);
        else if (col < 3072) *(u32x4*)(zmisc + (size_t)row * 256 + (col - 2816)) = pk8(v0, v1);
        else if (col < 3328) *(u32x4*)(qidx + (size_t)row * 256 + (col - 3072)) = pk8(v0, v1);
        else if (col < 4352) *(u32x4*)(ga + (size_t)row * 1024 + (col - 3328)) = pk8(sig4(v0), sig4(v1));
        else *(u32x4*)(gb + (size_t)row * 1024 + (col - 4352)) = pk8(sig4(v0), sig4(v1)); } };
struct FBrA { bf16_t* ga; int dry;
    __device__ __forceinline__ void operator()(int row, int col, f32x4 v0, f32x4 v1) const { F_DRY bf16_t* q = ga + (size_t)row * 1024 + col; f32x4 a, b; ld_bf16x8(q, a, b); *(u32x4*)q = pk8(a * v0, b * v1); } };
struct FBrB { bf16_t* m1; const bf16_t* gb; int dry;
    __device__ __forceinline__ void operator()(int row, int col, f32x4 v0, f32x4 v1) const { F_DRY const size_t o = (size_t)row * 1024 + col; f32x4 a, b, c, d; ld_bf16x8(m1 + o, a, b); ld_bf16x8(gb + o, c, d); *(u32x4*)(m1 + o) = pk8(a * v0 + c, b * v1 + d); } };
struct FOut { const float* x; const float* mod; float* out; int dry;
    __device__ __forceinline__ void operator()(int row, int col, f32x4 v0, f32x4 v1) const { F_DRY const size_t o = (size_t)row * D + col; const float* gt = mod + (row / S) * 6144 + 2048 + col;
        *(f32x4*)(out + o) = *(const f32x4*)(x + o) * DN_ALPHA + *(const f32x4*)gt * v0; *(f32x4*)(out + o + 4) = *(const f32x4*)(x + o + 4) * DN_ALPHA + *(const f32x4*)(gt + 4) * v1; } };
struct FPq { bf16_t* pq; int dry;
    __device__ __forceinline__ void operator()(int row, int col, f32x4 v0, f32x4 v1) const { F_DRY *(u32x4*)(pq + (size_t)row * D + col) = pk8(v0, v1); } };
__device__ __forceinline__ void dsa_norm_rows(const Params& p, int bid, int nblk, bool dry) {
    const int lane = threadIdx.x & 63, wid = threadIdx.x >> 6;
    const bf16_t* zmisc = (const bf16_t*)(p.ws + WS_ZMISC); bf16_t* ckv = (bf16_t*)(p.ws + WS_CKV); bf16_t* kidx = (bf16_t*)(p.ws + WS_KIDX); float* widx = (float*)(p.ws + WS_WIDX);
    for (int row = bid * NWAVE + wid; row < T; row += nblk * NWAVE) {
        const f32x4 v = ld_bf16x4(zmisc + (size_t)row * 256 + 4 * lane);
        float ss = (lane < 32) ? (v.x * v.x + v.y * v.y + v.z * v.z + v.w * v.w) : 0.f;
        ss = wave_sum(ss);
        const float rs = rsqrtf(ss * (1.f / 128.f) + LN_EPS);
        const bool isk = (lane >= 32 && lane < 48);
        float s1 = isk ? (v.x + v.y + v.z + v.w) : 0.f;
        s1 = wave_sum(s1);
        const float mean = s1 * (1.f / 64.f);
        const f32x4 d = v - mean;
        float s2 = isk ? (d.x * d.x + d.y * d.y + d.z * d.z + d.w * d.w) : 0.f;
        s2 = wave_sum(s2);
        const float rstd = rsqrtf(s2 * (1.f / 64.f) + LN_EPS);
        if (dry) { KEEP1(rs); KEEP1(rstd); continue; }
        if (lane < 32) { const f32x4 g = *(const f32x4*)(p.dsa_kv_g + 4 * lane); st_bf16x4(ckv + (size_t)row * 128 + 4 * lane, v * rs * g); }
        else if (isk) { const int c = 4 * (lane - 32); const f32x4 g = *(const f32x4*)(p.idx_k_g + c), b = *(const f32x4*)(p.idx_k_b + c); st_bf16x4(kidx + (size_t)row * 64 + c, d * rstd * g + b); }
        else if (lane == 48) { *(f32x4*)(widx + (size_t)row * 4) = v * (0.5f * 0.125f); }
    }
}

constexpr int RL_R = 0, RL_W = 16384, RL_KP = 32768, RL_KK = 49152, RL_BV = 65536, RL_V = 81920, RL_Y = 98304, RL_SG = 98304, RL_G = 114688, RL_TW = 122880, RL_AL = 131072, RL_RK = 139264;
template <int KD, bool OUT_BF16>
__device__ __forceinline__ void lora_mm(const LAS bf16_t* A, const bf16_t* Bt, LAS unsigned char* dst, int wid, int lane) {
    const int mi = wid >> 1;
#pragma unroll
    for (int nn = 0; nn < 2; ++nn) {
        const int ni = 2 * (wid & 1) + nn;
        f32x4 acc = (f32x4){0.f, 0.f, 0.f, 0.f};
#pragma unroll
        for (int ks = 0; ks < KD / 32; ++ks) {
            const bf16x8 a = *(const LAS bf16x8*)(A + (16 * mi + (lane & 15)) * KD + 32 * ks + 8 * (lane >> 4));
            const bf16x8 b = *(const bf16x8*)(Bt + (size_t)(16 * ni + (lane & 15)) * KD + 32 * ks + 8 * (lane >> 4));
            acc = __builtin_amdgcn_mfma_f32_16x16x32_bf16(a, b, acc, 0, 0, 0);
        }
#pragma unroll
        for (int r = 0; r < 4; ++r) {
            const int row = 16 * mi + (lane >> 4) * 4 + r, col = 16 * ni + (lane & 15);
            if (OUT_BF16) ((LAS bf16_t*)dst)[row * 64 + col] = (bf16_t)f2bf(acc[r]);
            else ((LAS float*)dst)[row * 64 + col] = acc[r];
        }
    }
}
template <int KD> __device__ __forceinline__ void lora_ldb(bf16x8 (&bfr)[2][KD / 32], const bf16_t* Bt, int wid, int lane) {
#pragma unroll
    for (int nn = 0; nn < 2; ++nn)
#pragma unroll
        for (int ks = 0; ks < KD / 32; ++ks) bfr[nn][ks] = *(const bf16x8*)(Bt + (size_t)(16 * (2 * (wid & 1) + nn) + (lane & 15)) * KD + 32 * ks + 8 * (lane >> 4));
}
template <int KD, bool OUT_BF16> __device__ __forceinline__ void lora_mm2(const LAS bf16_t* A, const bf16x8 (&bfr)[2][KD / 32], LAS unsigned char* dst, int wid, int lane) {
    const int mi = wid >> 1;
#pragma unroll
    for (int nn = 0; nn < 2; ++nn) {
        const int ni = 2 * (wid & 1) + nn;
        f32x4 acc = (f32x4){0.f, 0.f, 0.f, 0.f};
#pragma unroll
        for (int ks = 0; ks < KD / 32; ++ks) acc = __builtin_amdgcn_mfma_f32_16x16x32_bf16(*(const LAS bf16x8*)(A + (16 * mi + (lane & 15)) * KD + 32 * ks + 8 * (lane >> 4)), bfr[nn][ks], acc, 0, 0, 0);
#pragma unroll
        for (int r = 0; r < 4; ++r) { const int row = 16 * mi + (lane >> 4) * 4 + r, col = 16 * ni + (lane & 15);
            if (OUT_BF16) ((LAS bf16_t*)dst)[row * 64 + col] = (bf16_t)f2bf(acc[r]); else ((LAS float*)dst)[row * 64 + col] = acc[r]; }
    }
}
__device__ __forceinline__ f32x4 mix4(f32x4 z, f32x4 zp, f32x4 mu) { return z + (zp - z) * mu; }

constexpr size_t PREP_STRIDE = (size_t)T * 512;
constexpr size_t WS_RKG = 501 * MiB;
#define SIDX(row, col) ((row) * 64 + (((((col) >> 3) ^ ((row) & 7)) << 3) | ((col) & 7)))
__device__ __forceinline__ void mm64(f32x4 (&acc)[2], const LAS bf16_t* A, const LAS bf16_t* Bt, int wid, int lane) {
    const int mi = wid >> 1, l15 = lane & 15, g = lane >> 4;
#pragma unroll
    for (int nn = 0; nn < 2; ++nn) { const int ni = 2 * (wid & 1) + nn;
#pragma unroll
        for (int ks = 0; ks < 2; ++ks) acc[nn] = __builtin_amdgcn_mfma_f32_16x16x32_bf16(*(const LAS bf16x8*)(A + (16 * mi + l15) * 64 + (((4 * ks + g) ^ (l15 & 7)) << 3)), *(const LAS bf16x8*)(Bt + (16 * ni + l15) * 64 + (((4 * ks + g) ^ (l15 & 7)) << 3)), acc[nn], 0, 0, 0); }
}
#define MMT(acc, A, Bt) mm64(acc, Bt, A, wid, lane)
#define MM4_EACH(acc, BODY) do { _Pragma("unroll") for (int nn_ = 0; nn_ < 2; ++nn_) { const int i = 16 * (2 * (wid & 1) + nn_) + (lane & 15), j0 = 16 * (wid >> 1) + 4 * (lane >> 4); f32x4 v4 = acc[nn_]; \
        asm volatile("s_nop 7\n\ts_nop 4" : "+v"(v4.x), "+v"(v4.y), "+v"(v4.z), "+v"(v4.w)); BODY acc[nn_] = v4; } } while (0)
#define ST4S(slot, ii, jj, v) do { u32x2 w_; w_.x = pk2h((v).x, (v).y); w_.y = pk2h((v).z, (v).w); *(LAS u32x2*)(SLOT(slot) + SIDX(ii, jj)) = w_; } while (0)
__device__ __forceinline__ f32x4 ld4s(const LAS bf16_t* q) { const u32x2 w = *(const LAS u32x2*)q; return (f32x4){bflo(w.x), bfhi(w.x), bflo(w.y), bfhi(w.y)}; }
#define LBAR() do { asm volatile("s_waitcnt lgkmcnt(0)" ::: "memory"); __builtin_amdgcn_s_barrier(); asm volatile("" ::: "memory"); } while (0)
#define MM_ZERO(acc) do { acc[0] = (f32x4){0.f, 0.f, 0.f, 0.f}; acc[1] = acc[0]; } while (0)
#define MM_EACH(acc, BODY) do { _Pragma("unroll") for (int nn_ = 0; nn_ < 2; ++nn_) _Pragma("unroll") for (int r_ = 0; r_ < 4; ++r_) { \
        const int row = 16 * (wid >> 1) + 4 * (lane >> 4) + r_, col = 16 * (2 * (wid & 1) + nn_) + (lane & 15); float val = acc[nn_][r_]; BODY acc[nn_][r_] = val; } } while (0)
#define SLOT(i) ((LAS bf16_t*)(lds + (i) * 8192))
__device__ __forceinline__ void rwkv_chunk_unit(const Params& p, LAS unsigned char* lds, int tile, int h, bool dry) {
    const int tid = threadIdx.x, lane = tid & 63, wid = tid >> 6;
    const bf16_t* zrkv = (const bf16_t*)(p.ws + WS_ZRKV); const bf16_t* zlora = (const bf16_t*)(p.ws + WS_ZLORA);
    bf16_t* pre = (bf16_t*)p.out; bf16_t* gout = (bf16_t*)(p.ws + WS_RG); float* rkg = (float*)(p.ws + WS_RKG);
    const bf16_t* w2t = (const bf16_t*)(p.ws + WS_W2T) + (size_t)h * 64 * 64;
    const bf16_t* a2t = (const bf16_t*)(p.ws + WS_A2T) + (size_t)h * 64 * 64;
    const bf16_t* g2t = (const bf16_t*)(p.ws + WS_G2T) + (size_t)h * 64 * 128;
    LAS float* W = (LAS float*)(lds + RL_W); LAS float* KP = (LAS float*)(lds + RL_KP); LAS float* BV = (LAS float*)(lds + RL_BV);
    LAS bf16_t* SG = (LAS bf16_t*)(lds + RL_SG); LAS bf16_t* G = (LAS bf16_t*)(lds + RL_G); LAS bf16_t* TW = (LAS bf16_t*)(lds + RL_TW); LAS bf16_t* AL = (LAS bf16_t*)(lds + RL_AL);
    const int pt = tid >> 3, pc = (tid & 7) * 8, hc = h * 64 + pc;
    const size_t row = (size_t)tile * 64 + pt; const bool hasp = (row % S) > 0;
    f32x4 rm0, rm1, vm0, vm1;
    bf16x8 bw2[2][2], ba2[2][2];
    lora_ldb<64>(bw2, w2t, wid, lane); lora_ldb<64>(ba2, a2t, wid, lane);
    const f32x4 pw0a = *(const f32x4*)(p.rw_w0 + hc), pw0b = *(const f32x4*)(p.rw_w0 + hc + 4), pa0a = *(const f32x4*)(p.rw_a0 + hc), pa0b = *(const f32x4*)(p.rw_a0 + hc + 4);
    const f32x4 pkka = *(const f32x4*)(p.rw_k_k + hc), pkkb = *(const f32x4*)(p.rw_k_k + hc + 4), pkaa = *(const f32x4*)(p.rw_k_a + hc), pkab = *(const f32x4*)(p.rw_k_a + hc + 4);
    const f32x4 prka = *(const f32x4*)(p.rw_r_k + hc), prkb = *(const f32x4*)(p.rw_r_k + hc + 4);
    {
        const bf16_t* zr = zrkv + row * 1536; const bf16_t* zl = zlora + row * 256;
        f32x4 c0, c1, p0, p1, m0, m1; const f32x4 zero = (f32x4){0.f, 0.f, 0.f, 0.f};
        ld_bf16x8(zr + hc, c0, c1); if (hasp) ld_bf16x8(zr - 1536 + hc, p0, p1); else { p0 = zero; p1 = zero; }
        m0 = *(const f32x4*)(p.rw_mu + hc); m1 = *(const f32x4*)(p.rw_mu + hc + 4); rm0 = mix4(c0, p0, m0); rm1 = mix4(c1, p1, m1);
        ld_bf16x8(zr + 1024 + hc, c0, c1); if (hasp) ld_bf16x8(zr - 1536 + 1024 + hc, p0, p1); else { p0 = zero; p1 = zero; }
        m0 = *(const f32x4*)(p.rw_mu + 1024 + hc); m1 = *(const f32x4*)(p.rw_mu + 1024 + hc + 4); vm0 = mix4(c0, p0, m0); vm1 = mix4(c1, p1, m1);
        ld_bf16x8(zr + 512 + hc, c0, c1); if (hasp) ld_bf16x8(zr - 1536 + 512 + hc, p0, p1); else { p0 = zero; p1 = zero; }
        m0 = *(const f32x4*)(p.rw_mu + 512 + hc); m1 = *(const f32x4*)(p.rw_mu + 512 + hc + 4);
        *(LAS f32x4*)(KP + pt * 64 + pc) = mix4(c0, p0, m0); *(LAS f32x4*)(KP + pt * 64 + pc + 4) = mix4(c1, p1, m1);
        ld_bf16x8(zl + pc, c0, c1); if (hasp) ld_bf16x8(zl - 256 + pc, p0, p1); else { p0 = zero; p1 = zero; }
        m0 = *(const f32x4*)(p.rw_mu + 1536 + pc); m1 = *(const f32x4*)(p.rw_mu + 1536 + pc + 4);
        { const f32x4 a = mix4(c0, p0, m0), bb = mix4(c1, p1, m1); u32x4 o; o.x = pk2h(tanh_fast(a.x), tanh_fast(a.y)); o.y = pk2h(tanh_fast(a.z), tanh_fast(a.w)); o.z = pk2h(tanh_fast(bb.x), tanh_fast(bb.y)); o.w = pk2h(tanh_fast(bb.z), tanh_fast(bb.w));
          *(LAS u32x4*)(TW + pt * 64 + pc) = o; }
        ld_bf16x8(zl + 64 + pc, c0, c1); if (hasp) ld_bf16x8(zl - 256 + 64 + pc, p0, p1); else { p0 = zero; p1 = zero; }
        m0 = *(const f32x4*)(p.rw_mu + 1600 + pc); m1 = *(const f32x4*)(p.rw_mu + 1600 + pc + 4);
        { const f32x4 a = mix4(c0, p0, m0), bb = mix4(c1, p1, m1); u32x4 o; o.x = pk2h(a.x, a.y); o.y = pk2h(a.z, a.w); o.z = pk2h(bb.x, bb.y); o.w = pk2h(bb.z, bb.w);
          *(LAS u32x4*)(AL + pt * 64 + pc) = o; }
#pragma unroll
        for (int hh = 0; hh < 2; ++hh) {
            const int gc = 2 * pc + 8 * hh;
            ld_bf16x8(zl + 128 + gc, c0, c1); if (hasp) ld_bf16x8(zl - 256 + 128 + gc, p0, p1); else { p0 = zero; p1 = zero; }
            m0 = *(const f32x4*)(p.rw_mu + 1664 + gc); m1 = *(const f32x4*)(p.rw_mu + 1664 + gc + 4);
            const f32x4 a = mix4(c0, p0, m0), bb = mix4(c1, p1, m1); u32x4 o;
            o.x = pk2h(sigmoidf_(a.x), sigmoidf_(a.y)); o.y = pk2h(sigmoidf_(a.z), sigmoidf_(a.w)); o.z = pk2h(sigmoidf_(bb.x), sigmoidf_(bb.y)); o.w = pk2h(sigmoidf_(bb.z), sigmoidf_(bb.w));
            *(LAS u32x4*)(SG + pt * 128 + gc) = o;
        }
    }
    __syncthreads();
    lora_mm2<64, false>(TW, bw2, lds + RL_W, wid, lane);
    lora_mm2<64, false>(AL, ba2, lds + RL_BV, wid, lane);
    lora_mm<128, true>(SG, g2t, lds + RL_G, wid, lane);
    __syncthreads();
    float ew[8], kk[8], bv[8], kp[8];
    {
        float ssq = 0.f; float kkv[8], av[8], kraw[8];
        const float pw0[8] = {pw0a.x, pw0a.y, pw0a.z, pw0a.w, pw0b.x, pw0b.y, pw0b.z, pw0b.w}, pa0[8] = {pa0a.x, pa0a.y, pa0a.z, pa0a.w, pa0b.x, pa0b.y, pa0b.z, pa0b.w};
        const float pkk[8] = {pkka.x, pkka.y, pkka.z, pkka.w, pkkb.x, pkkb.y, pkkb.z, pkkb.w}, pka[8] = {pkaa.x, pkaa.y, pkaa.z, pkaa.w, pkab.x, pkab.y, pkab.z, pkab.w}, prk[8] = {prka.x, prka.y, prka.z, prka.w, prkb.x, prkb.y, prkb.z, prkb.w};
#pragma unroll
        for (int j = 0; j < 8; ++j) {
            const int c = pc + j;
            const float xw = pw0[j] + W[pt * 64 + c];
            const float sp = fmaxf(-xw, 0.f) + __logf(1.f + __expf(-fabsf(xw)));
            ew[j] = __expf(-sp - 0.5f);
            av[j] = sigmoidf_(pa0[j] + BV[pt * 64 + c]);
            kraw[j] = KP[pt * 64 + c];
            kkv[j] = kraw[j] * pkk[j];
            ssq += kkv[j] * kkv[j];
        }
        ssq = red8(ssq);
        const float inv = rsqrtf(fmaxf(ssq, 1e-24f));
        float rkp = 0.f; const float rr[8] = {rm0.x, rm0.y, rm0.z, rm0.w, rm1.x, rm1.y, rm1.z, rm1.w};
#pragma unroll
        for (int j = 0; j < 8; ++j) { kk[j] = kkv[j] * inv; bv[j] = kk[j] * av[j]; kp[j] = kraw[j] * (1.f + (av[j] - 1.f) * pka[j]); rkp += rr[j] * kp[j] * prk[j]; }
        rkp = red8(rkp);
        const u32x4 og = *(const LAS u32x4*)(G + pt * 64 + pc);
        if (!dry) { *(u32x4*)(gout + row * 512 + hc) = og; if ((tid & 7) == 0) rkg[row * 8 + h] = rkp; } else { KEEP4(og); KEEP1(rkp); }
    }
    __syncthreads();
    const int stg = dry ? p.probe_ph - 420 : 99;
    if (stg == 0) return;
    LAS float* LG = (LAS float*)(lds + 10 * 8192); LAS float* SEG = (LAS float*)(lds + 12 * 8192); LAS float* GCv = (LAS float*)(lds + 131072);
    *(LAS f32x4*)(LG + pt * 64 + pc) = (f32x4){ew[0], ew[1], ew[2], ew[3]}; *(LAS f32x4*)(LG + pt * 64 + pc + 4) = (f32x4){ew[4], ew[5], ew[6], ew[7]};
    __syncthreads();
    { const int k = tid & 63, seg = tid >> 6; float sm = 0.f;
#pragma unroll
      for (int i = 0; i < 8; ++i) sm += LG[(seg * 8 + i) * 64 + k];
      SEG[seg * 64 + k] = sm; }
    __syncthreads();
    { const int k = tid & 63, seg = tid >> 6; float acc = 0.f;
#pragma unroll
      for (int q = 0; q < 8; ++q) acc += (q < seg) ? SEG[q * 64 + k] : 0.f;
#pragma unroll
      for (int i = 0; i < 8; ++i) { acc += LG[(seg * 8 + i) * 64 + k]; LG[(seg * 8 + i) * 64 + k] = -acc; } }
    __syncthreads();
    {
        const f32x4 l0 = *(const LAS f32x4*)(LG + pt * 64 + pc), l1 = *(const LAS f32x4*)(LG + pt * 64 + pc + 4), c0 = *(const LAS f32x4*)(LG + 63 * 64 + pc), c1 = *(const LAS f32x4*)(LG + 63 * 64 + pc + 4);
        const float lg[8] = {l0.x, l0.y, l0.z, l0.w, l1.x, l1.y, l1.z, l1.w}, lc[8] = {c0.x, c0.y, c0.z, c0.w, c1.x, c1.y, c1.z, c1.w};
        const float rr[8] = {rm0.x, rm0.y, rm0.z, rm0.w, rm1.x, rm1.y, rm1.z, rm1.w}, vv[8] = {vm0.x, vm0.y, vm0.z, vm0.w, vm1.x, vm1.y, vm1.z, vm1.w};
        float am[8], rmv[8], bm[8], km[8], bh[8], kh[8];
#pragma unroll
        for (int j = 0; j < 8; ++j) { const float gam = __expf(lg[j]), gm1 = __expf(lg[j] + ew[j]), gi = __expf(-lg[j]), gcr = __expf(lc[j] - lg[j]);
            am[j] = -kk[j] * gm1; rmv[j] = rr[j] * gam; bm[j] = bv[j] * gi; km[j] = kp[j] * gi; bh[j] = bv[j] * gcr; kh[j] = kp[j] * gcr;
            if (pt == 63) GCv[pc + j] = gam; }
#define ST8(slot, a) do { u32x4 o_; o_.x = pk2h(a[0], a[1]); o_.y = pk2h(a[2], a[3]); o_.z = pk2h(a[4], a[5]); o_.w = pk2h(a[6], a[7]); *(LAS u32x4*)(SLOT(slot) + SIDX(pt, pc)) = o_; } while (0)
        ST8(0, am); ST8(1, rmv); ST8(2, bm); ST8(3, km);
#undef ST8
#pragma unroll
        for (int j = 0; j < 8; ++j) { SLOT(4)[SIDX(pc + j, pt)] = (bf16_t)f2bf(am[j]); SLOT(5)[SIDX(pc + j, pt)] = (bf16_t)f2bf(bh[j]); SLOT(6)[SIDX(pc + j, pt)] = (bf16_t)f2bf(kh[j]); SLOT(7)[SIDX(pc + j, pt)] = (bf16_t)f2bf(vv[j]); }
    }
    LBAR();
    if (stg == 1) return;
    f32x4 acc[2];
    MM_ZERO(acc); MMT(acc, SLOT(2), SLOT(0));
    MM4_EACH(acc, { v4.x = (i < j0) ? v4.x : 0.f; v4.y = (i < j0 + 1) ? v4.y : 0.f; v4.z = (i < j0 + 2) ? v4.z : 0.f; v4.w = (i < j0 + 3) ? v4.w : 0.f; ST4S(10, i, j0, v4);
                    f32x4 t4 = v4; if (i == j0) t4.x += 1.f; if (i == j0 + 1) t4.y += 1.f; if (i == j0 + 2) t4.z += 1.f; if (i == j0 + 3) t4.w += 1.f; ST4S(14, i, j0, t4); });
    MM_ZERO(acc); MMT(acc, SLOT(0), SLOT(2));
    MM4_EACH(acc, { v4.x = (j0 < i) ? v4.x : 0.f; v4.y = (j0 + 1 < i) ? v4.y : 0.f; v4.z = (j0 + 2 < i) ? v4.z : 0.f; v4.w = (j0 + 3 < i) ? v4.w : 0.f; ST4S(11, i, j0, v4); });
    MM_ZERO(acc); MMT(acc, SLOT(3), SLOT(0));
    MM4_EACH(acc, { v4.x = (i < j0) ? v4.x : 0.f; v4.y = (i < j0 + 1) ? v4.y : 0.f; v4.z = (i < j0 + 2) ? v4.z : 0.f; v4.w = (i < j0 + 3) ? v4.w : 0.f; ST4S(8, i, j0, v4); });
    MM_ZERO(acc); MMT(acc, SLOT(1), SLOT(2));
    MM4_EACH(acc, { v4.x = (j0 <= i) ? v4.x : 0.f; v4.y = (j0 + 1 <= i) ? v4.y : 0.f; v4.z = (j0 + 2 <= i) ? v4.z : 0.f; v4.w = (j0 + 3 <= i) ? v4.w : 0.f; ST4S(9, i, j0, v4); });
    LBAR();
    if (stg == 2) return;
    {
        int pc_ = 10, pn_ = 12, tc_ = 14, tn_ = 15;
        MM_ZERO(acc); MMT(acc, SLOT(pc_), SLOT(pc_ + 1)); MM4_EACH(acc, { ST4S(pn_, i, j0, v4); });
        MM_ZERO(acc); MMT(acc, SLOT(pc_ + 1), SLOT(pc_)); MM4_EACH(acc, { ST4S(pn_ + 1, i, j0, v4); });
        LBAR();
        { const int t_ = pc_; pc_ = pn_; pn_ = t_; }
#pragma unroll 1
        for (int j = 0; j < 5; ++j) {
            if (j < 4) {
                MM_ZERO(acc); MMT(acc, SLOT(pc_), SLOT(pc_ + 1)); MM4_EACH(acc, { ST4S(pn_, i, j0, v4); });
                MM_ZERO(acc); MMT(acc, SLOT(pc_ + 1), SLOT(pc_)); MM4_EACH(acc, { ST4S(pn_ + 1, i, j0, v4); });
            }
            MM_ZERO(acc); MMT(acc, SLOT(tc_), SLOT(pc_ + 1));
            MM4_EACH(acc, { v4 = v4 + ld4s(SLOT(tc_) + SIDX(i, j0)); ST4S(tn_, i, j0, v4); });
            LBAR();
            { const int t_ = pc_; pc_ = pn_; pn_ = t_; } { const int t_ = tc_; tc_ = tn_; tn_ = t_; }
        }
    }
    if (stg == 3) return;
    MM_ZERO(acc); MMT(acc, SLOT(9), SLOT(15));
    MM4_EACH(acc, { ST4S(0, i, j0, v4); });
    MM_ZERO(acc); MMT(acc, SLOT(5), SLOT(15));
    MM4_EACH(acc, { ST4S(2, i, j0, v4); });
    LBAR();
    if (stg == 4) return;
    bf16_t* gbase = pre + ((size_t)tile * 64) * 512 + h * 64;
#define GST4(arr, ii, jj, v) do { u32x2 w_; w_.x = pk2h((v).x, (v).y); w_.y = pk2h((v).z, (v).w); if (!dry) *(u32x2*)(gbase + (size_t)(arr) * PREP_STRIDE + (size_t)(ii) * 512 + (jj)) = w_; else { KEEP1(w_.x); KEEP1(w_.y); } } while (0)
    MM_ZERO(acc); MMT(acc, SLOT(0), SLOT(4));
    MM4_EACH(acc, { v4 = v4 + ld4s(SLOT(1) + SIDX(i, j0)); GST4(0, i, j0, v4); });
    MM_ZERO(acc); MMT(acc, SLOT(1), SLOT(3));
    MM4_EACH(acc, { v4.x = (j0 <= i) ? v4.x : 0.f; v4.y = (j0 + 1 <= i) ? v4.y : 0.f; v4.z = (j0 + 2 <= i) ? v4.z : 0.f; v4.w = (j0 + 3 <= i) ? v4.w : 0.f; });
    MMT(acc, SLOT(0), SLOT(8));
    MM4_EACH(acc, { GST4(1, i, j0, v4); });
    MM_ZERO(acc); MMT(acc, SLOT(2), SLOT(4));
    MM4_EACH(acc, { const float gc_ = GCv[i]; if (i == j0) v4.x += gc_; if (i == j0 + 1) v4.y += gc_; if (i == j0 + 2) v4.z += gc_; if (i == j0 + 3) v4.w += gc_; GST4(2, i, j0, v4); });
    MM_ZERO(acc); MMT(acc, SLOT(2), SLOT(8));
    MM4_EACH(acc, { v4 = v4 + ld4s(SLOT(6) + SIDX(i, j0)); ST4S(5, i, j0, v4); });
    LBAR();
    MM_ZERO(acc); MMT(acc, SLOT(7), SLOT(5));
    MM4_EACH(acc, { GST4(3, i, j0, v4); });
#undef GST4
    LBAR();
}
__device__ __forceinline__ void up8(const u32x4 w, f32x4& a, f32x4& b) { a = (f32x4){bflo(w.x), bfhi(w.x), bflo(w.y), bfhi(w.y)}; b = (f32x4){bflo(w.z), bfhi(w.z), bflo(w.w), bfhi(w.w)}; }
__device__ __forceinline__ void rwkv_state_out_pass(const Params& p, LAS unsigned char* lds, int b, int h) {
    const int tid = threadIdx.x, lane = tid & 63, wid = tid >> 6;
    const bf16_t* zrkv = (const bf16_t*)(p.ws + WS_ZRKV); const bf16_t* pre = (const bf16_t*)p.out; const bf16_t* gin = (const bf16_t*)(p.ws + WS_RG); const float* rkg = (const float*)(p.ws + WS_RKG);
    bf16_t* ya = (bf16_t*)(p.ws + WS_YA);
    LAS bf16_t* SL = (LAS bf16_t*)lds; LAS bf16_t* VT = (LAS bf16_t*)(lds + 8192);
    LAS float* V = (LAS float*)(lds + RL_V); LAS float* Y = (LAS float*)(lds + RL_Y); LAS float* RK = (LAS float*)(lds + RL_RK); LAS bf16_t* G = (LAS bf16_t*)(lds + RL_G);
    const int pt = tid >> 3, pc = (tid & 7) * 8, hc = h * 64 + pc;
    const int mi = wid >> 1, l15 = lane & 15, g = lane >> 4;
    const f32x4 muv0 = *(const f32x4*)(p.rw_mu + 1024 + hc), muv1 = *(const f32x4*)(p.rw_mu + 1024 + hc + 4);
    *(LAS u32x4*)(SL + tid * 8) = (u32x4){0u, 0u, 0u, 0u};
    bf16x8 gt[2][2], pa[2], qa[2]; unsigned short hm[2][4]; u32x4 vcq, vpq, gq; float rkq;
#define SO_LOAD(cc) do { const size_t r0_ = (size_t)b * S + (cc) * 64; const bf16_t* gb_ = pre + r0_ * 512 + h * 64; \
        _Pragma("unroll") for (int ks = 0; ks < 2; ++ks) { pa[ks] = *(const bf16x8*)(gb_ + (size_t)(16 * mi + l15) * 512 + 32 * ks + 8 * g); qa[ks] = *(const bf16x8*)(gb_ + PREP_STRIDE + (size_t)(16 * mi + l15) * 512 + 32 * ks + 8 * g); } \
        _Pragma("unroll") for (int nn = 0; nn < 2; ++nn) { const int ni = 2 * (wid & 1) + nn; \
            _Pragma("unroll") for (int ks = 0; ks < 2; ++ks) gt[nn][ks] = *(const bf16x8*)(gb_ + 2 * PREP_STRIDE + (size_t)(16 * ni + l15) * 512 + 32 * ks + 8 * g); \
            _Pragma("unroll") for (int r = 0; r < 4; ++r) hm[nn][r] = gb_[3 * PREP_STRIDE + (size_t)(16 * mi + 4 * g + r) * 512 + 16 * ni + l15]; } \
        const bf16_t* zr_ = zrkv + (r0_ + pt) * 1536 + 1024 + hc; vcq = *(const u32x4*)zr_; vpq = ((cc) * 64 + pt > 0) ? *(const u32x4*)(zr_ - 1536) : (u32x4){0u, 0u, 0u, 0u}; \
        gq = *(const u32x4*)(gin + (r0_ + pt) * 512 + hc); rkq = rkg[(r0_ + pt) * 8 + h]; } while (0)
    SO_LOAD(0);
    for (int c = 0; c < S / 64; ++c) {
        { f32x4 a0, a1, b0, b1; up8(vcq, a0, a1); up8(vpq, b0, b1);
          const f32x4 v0 = mix4(a0, b0, muv0), v1 = mix4(a1, b1, muv1);
          *(LAS f32x4*)(V + pt * 64 + pc) = v0; *(LAS f32x4*)(V + pt * 64 + pc + 4) = v1;
          const float vv[8] = {v0.x, v0.y, v0.z, v0.w, v1.x, v1.y, v1.z, v1.w};
#pragma unroll
          for (int j = 0; j < 8; ++j) VT[(pc + j) * 64 + pt] = (bf16_t)f2bf(vv[j]);
          *(LAS u32x4*)(G + pt * 64 + pc) = gq; if ((tid & 7) == 0) RK[pt] = rkq; }
        LBAR();
        f32x4 ay[2], as[2];
#pragma unroll
        for (int nn = 0; nn < 2; ++nn) { const int ni = 2 * (wid & 1) + nn;
            ay[nn] = (f32x4){0.f, 0.f, 0.f, 0.f}; as[nn] = (f32x4){bf2f(hm[nn][0]), bf2f(hm[nn][1]), bf2f(hm[nn][2]), bf2f(hm[nn][3])};
#pragma unroll
            for (int ks = 0; ks < 2; ++ks) {
                const bf16x8 sb = *(const LAS bf16x8*)(SL + (16 * ni + l15) * 64 + 32 * ks + 8 * g);
                ay[nn] = __builtin_amdgcn_mfma_f32_16x16x32_bf16(pa[ks], sb, ay[nn], 0, 0, 0);
                ay[nn] = __builtin_amdgcn_mfma_f32_16x16x32_bf16(qa[ks], *(const LAS bf16x8*)(VT + (16 * ni + l15) * 64 + 32 * ks + 8 * g), ay[nn], 0, 0, 0);
                as[nn] = __builtin_amdgcn_mfma_f32_16x16x32_bf16(*(const LAS bf16x8*)(SL + (16 * mi + l15) * 64 + 32 * ks + 8 * g), gt[nn][ks], as[nn], 0, 0, 0); } }
        MM_EACH(ay, { Y[row * 64 + col] = val; });
        if (c + 1 < S / 64) SO_LOAD(c + 1);
        LBAR();
        MM_EACH(as, { SL[row * 64 + col] = (bf16_t)f2bf(val); });
        {
            float yv[8]; float sm = 0.f;
#pragma unroll
            for (int j = 0; j < 8; ++j) { yv[j] = Y[pt * 64 + pc + j]; sm += yv[j]; }
            const float mean = red8(sm) * (1.f / 64.f); float qq = 0.f;
#pragma unroll
            for (int j = 0; j < 8; ++j) { yv[j] -= mean; qq += yv[j] * yv[j]; }
            const float rstd = rsqrtf(red8(qq) * (1.f / 64.f) + RW_GN_EPS);
            const float rk = RK[pt]; float o[8];
#pragma unroll
            for (int j = 0; j < 8; ++j) { const int gc = hc + j;
                o[j] = (yv[j] * rstd * p.rw_gn_g[gc] + p.rw_gn_b[gc] + rk * V[pt * 64 + pc + j]) * bf2f(G[pt * 64 + pc + j]); }
            u32x4 w; w.x = pk2(o[0], o[1]); w.y = pk2(o[2], o[3]); w.z = pk2(o[4], o[5]); w.w = pk2(o[6], o[7]);
            *(u32x4*)(ya + ((size_t)b * S + c * 64 + pt) * 512 + hc) = w;
        }
        LBAR();
    }
#undef SO_LOAD
}

__device__ __forceinline__ int mbcnt64(unsigned long long m) { return (int)__builtin_amdgcn_mbcnt_hi((unsigned)(m >> 32), __builtin_amdgcn_mbcnt_lo((unsigned)m, 0u)); }
template <int NV> __device__ __forceinline__ int wave_count_ge(const unsigned (&u)[NV], unsigned cand) {
    if (NV <= 8) { int c = 0;
#pragma unroll
        for (int i = 0; i < NV; ++i) c += (int)__builtin_popcountll(__ballot(u[i] >= cand));
        return c; }
    else { int c = 0;
#pragma unroll
        for (int i = 0; i < NV; ++i) c += (u[i] >= cand) ? 1 : 0;
        c += __builtin_amdgcn_update_dpp(0, c, 0xB1, 0xf, 0xf, true); c += __builtin_amdgcn_update_dpp(0, c, 0x4E, 0xf, 0xf, true);
        c += __builtin_amdgcn_update_dpp(0, c, 0x141, 0xf, 0xf, true); c += __builtin_amdgcn_update_dpp(0, c, 0x140, 0xf, 0xf, true);
        return __builtin_amdgcn_readlane(c, 0) + __builtin_amdgcn_readlane(c, 16) + __builtin_amdgcn_readlane(c, 32) + __builtin_amdgcn_readlane(c, 48); }
}
template <int NV, int K> __device__ __forceinline__ unsigned wave_kth(const unsigned (&u)[NV]) {
    unsigned Tt = 0u;
    for (int bit = 31; bit >= 0; --bit) {
        const unsigned cand = Tt | (1u << bit);
        const int c = wave_count_ge<NV>(u, cand);
        if (c >= K) Tt = cand;
        if (c == K) break;
    }
    return Tt;
}

__device__ __forceinline__ int cnt4_ge(int c, unsigned a, unsigned b, unsigned d, unsigned e, unsigned x) {
    asm volatile("v_cmp_ge_u32_e64 s[20:21], %1, %5\n\tv_cmp_ge_u32_e64 s[22:23], %2, %5\n\tv_cmp_ge_u32_e64 s[24:25], %3, %5\n\tv_cmp_ge_u32_e64 s[26:27], %4, %5\n\t"
                 "v_addc_co_u32_e64 %0, s[28:29], %0, 0, s[20:21]\n\tv_addc_co_u32_e64 %0, s[28:29], %0, 0, s[22:23]\n\tv_addc_co_u32_e64 %0, s[28:29], %0, 0, s[24:25]\n\tv_addc_co_u32_e64 %0, s[28:29], %0, 0, s[26:27]"
                 : "+v"(c) : "v"(a), "v"(b), "v"(d), "v"(e), "v"(x) : "s20", "s21", "s22", "s23", "s24", "s25", "s26", "s27", "s28", "s29");
    return c;
}
__device__ __forceinline__ int wave_count_ge64(const unsigned (&u)[64], unsigned cand, int ngrp) {
    int c = 0;
#pragma unroll
    for (int gq = 0; gq < 4; ++gq) if (gq < ngrp) {
#pragma unroll
        for (int i = 0; i < 16; i += 4) c = cnt4_ge(c, u[gq * 16 + i], u[gq * 16 + i + 1], u[gq * 16 + i + 2], u[gq * 16 + i + 3], cand);
    }
    c += __builtin_amdgcn_update_dpp(0, c, 0xB1, 0xf, 0xf, true); c += __builtin_amdgcn_update_dpp(0, c, 0x4E, 0xf, 0xf, true);
    c += __builtin_amdgcn_update_dpp(0, c, 0x141, 0xf, 0xf, true); c += __builtin_amdgcn_update_dpp(0, c, 0x140, 0xf, 0xf, true);
    return __builtin_amdgcn_readlane(c, 0) + __builtin_amdgcn_readlane(c, 16) + __builtin_amdgcn_readlane(c, 32) + __builtin_amdgcn_readlane(c, 48);
}
template <int K> __device__ __forceinline__ unsigned wave_kth_interp(const unsigned (&u)[64], int ngrp, bool& allge, int& cgt) {
    unsigned mx = 0u;
#pragma unroll
    for (int gq = 0; gq < 4; ++gq) if (gq < ngrp) {
#pragma unroll
        for (int i = 0; i < 16; ++i) mx = umax_(mx, u[gq * 16 + i]);
    }
    { int m = (int)mx;
      unsigned o;
      o = (unsigned)__builtin_amdgcn_update_dpp(0, m, 0xB1, 0xf, 0xf, true); mx = umax_(mx, o); m = (int)mx;
      o = (unsigned)__builtin_amdgcn_update_dpp(0, m, 0x4E, 0xf, 0xf, true); mx = umax_(mx, o); m = (int)mx;
      o = (unsigned)__builtin_amdgcn_update_dpp(0, m, 0x141, 0xf, 0xf, true); mx = umax_(mx, o); m = (int)mx;
      o = (unsigned)__builtin_amdgcn_update_dpp(0, m, 0x140, 0xf, 0xf, true); mx = umax_(mx, o); m = (int)mx;
      mx = umax_(umax_((unsigned)__builtin_amdgcn_readlane(m, 0), (unsigned)__builtin_amdgcn_readlane(m, 16)), umax_((unsigned)__builtin_amdgcn_readlane(m, 32), (unsigned)__builtin_amdgcn_readlane(m, 48))); }
    unsigned Tt = 0u; allge = false; int startbit = 31 - __builtin_clz(mx | 1u);
    {
        unsigned P = mx & 0xff800000u;
        for (int j = 0; j < 4; ++j) {
            const int c = wave_count_ge64(u, P | (P == 0u ? 1u : 0u), ngrp);
            if (c >= K) { Tt = P; startbit = 22; if (c == K && P != 0u) allge = true; break; }
            if (P < 0x00800000u) break;
            P -= 0x00800000u;
        }
    }
    if (!allge) {
        for (int bit = startbit; bit >= 0; --bit) {
            const unsigned cand = Tt | (1u << bit);
            const int c = wave_count_ge64(u, cand, ngrp);
            if (c >= K) { Tt = cand; if (c == K) { allge = true; break; } }
        }
    }
    cgt = allge ? 0 : wave_count_ge64(u, Tt + 1u, ngrp);
    return Tt;
}

constexpr int IX_LD = 4112;
constexpr int IX_LUT = 8 * IX_LD * 4, IX_FAR = IX_LUT + 4096;
typedef short v4i16_t __attribute__((ext_vector_type(4)));
__device__ __forceinline__ void attn_query(int lane, int t, int cnt, LAS unsigned char* WL, const LAS float* LUT, const LAS float* FAR, bf16_t* zq, const bf16_t* ckv, bool dry, int fake = 0) {
    const int b = t / S, tp = t % S;
    LAS unsigned short* SEL = (LAS unsigned short*)WL; LAS bf16_t* PT = (LAS bf16_t*)(WL + 512); LAS unsigned char* VI = WL + 2048;
    const int l15 = lane & 15, g = lane >> 4;
    bf16x8 qf[4];
#pragma unroll
    for (int ks = 0; ks < 4; ++ks) { if (l15 < 8) qf[ks] = *(const bf16x8*)(zq + (size_t)t * 1024 + l15 * 128 + 32 * ks + 8 * g); else qf[ks] = (bf16x8){0, 0, 0, 0, 0, 0, 0, 0}; }
    const bf16_t* kb = ckv + (size_t)b * S * 128 + 8 * l15;
    const int nch = (cnt + 31) >> 5;
    u32x4 pre[8];
#pragma unroll
    for (int i = 0; i < 8; ++i) pre[i] = *(const u32x4*)(kb + (size_t)(fake ? (SEL[4 * i + g] & 31) : SEL[4 * i + g]) * 128);
    f32x4 O[8];
#pragma unroll
    for (int nt = 0; nt < 8; ++nt) O[nt] = (f32x4){0.f, 0.f, 0.f, 0.f};
    float mrun[4], lrun[4];
#pragma unroll
    for (int r = 0; r < 4; ++r) { mrun[r] = -INFINITY; lrun[r] = 0.f; }
    for (int ch = 0; ch < nch; ++ch) {
#pragma unroll
        for (int i = 0; i < 8; ++i) { const int r = 4 * i + g; *(LAS u32x4*)(VI + r * 256 + ((l15 ^ (r & 15)) << 4)) = pre[i]; }
        if (ch + 1 < nch) {
#pragma unroll
            for (int i = 0; i < 8; ++i) pre[i] = *(const u32x4*)(kb + (size_t)(fake ? (SEL[(ch + 1) * 32 + 4 * i + g] & 31) : SEL[(ch + 1) * 32 + 4 * i + g]) * 128);
        }
        asm volatile("s_waitcnt lgkmcnt(0)" ::: "memory");
        f32x4 sc[2];
#pragma unroll
        for (int nt2 = 0; nt2 < 2; ++nt2) {
            const int row = 16 * nt2 + l15; f32x4 acc = (f32x4){0.f, 0.f, 0.f, 0.f};
#pragma unroll
            for (int ks = 0; ks < 4; ++ks) acc = __builtin_amdgcn_mfma_f32_16x16x32_bf16(qf[ks], *(const LAS bf16x8*)(VI + row * 256 + (((4 * ks + g) ^ l15) << 4)), acc, 0, 0, 0);
            const int slot = ch * 32 + row; const int key = SEL[slot]; const int n = tp - key; const bool ok = slot < cnt;
            const f32x4 bias = (n < 128) ? *(const LAS f32x4*)(LUT + n * 8 + ((4 * g) & 7)) : *(const LAS f32x4*)(FAR + ((4 * g) & 7));
#pragma unroll
            for (int r = 0; r < 4; ++r) acc[r] = ok ? acc[r] + bias[r] : -INFINITY;
            sc[nt2] = acc;
        }
        float alpha[4];
#pragma unroll
        for (int r = 0; r < 4; ++r) {
            const float cm = red16_max(fmaxf(sc[0][r], sc[1][r]));
            const float mn = fmaxf(mrun[r], cm);
            alpha[r] = __builtin_amdgcn_exp2f(mrun[r] - mn); mrun[r] = mn;
            sc[0][r] = __builtin_amdgcn_exp2f(sc[0][r] - mn); sc[1][r] = __builtin_amdgcn_exp2f(sc[1][r] - mn);
            lrun[r] = lrun[r] * alpha[r] + red16_sum(sc[0][r] + sc[1][r]);
        }
        if (!__all(alpha[0] == 1.f && alpha[1] == 1.f && alpha[2] == 1.f && alpha[3] == 1.f)) {
#pragma unroll
            for (int nt = 0; nt < 8; ++nt) { O[nt].x *= alpha[0]; O[nt].y *= alpha[1]; O[nt].z *= alpha[2]; O[nt].w *= alpha[3]; }
        }
        if (g < 2) {
#pragma unroll
            for (int nt2 = 0; nt2 < 2; ++nt2)
#pragma unroll
                for (int r = 0; r < 4; ++r) PT[(4 * g + r) * 32 + 16 * nt2 + l15] = (bf16_t)(pk2h(sc[nt2][r], sc[nt2][r]) & 0xffffu);
        }
        asm volatile("s_waitcnt lgkmcnt(0)" ::: "memory");
        const bf16x8 pa = *(const LAS bf16x8*)(PT + l15 * 32 + 8 * g);
        const int q4 = l15 >> 2, p4 = l15 & 3;
#pragma unroll
        for (int nt = 0; nt < 8; ++nt) {
            const int r0 = 8 * g + q4, r1 = r0 + 4, chn = 2 * nt + (p4 >> 1);
            const v4i16_t lo = __builtin_amdgcn_ds_read_tr16_b64_v4i16((LAS v4i16_t*)(VI + r0 * 256 + ((chn ^ (r0 & 15)) << 4) + (p4 & 1) * 8));
            const v4i16_t hi = __builtin_amdgcn_ds_read_tr16_b64_v4i16((LAS v4i16_t*)(VI + r1 * 256 + ((chn ^ (r1 & 15)) << 4) + (p4 & 1) * 8));
            const bf16x8 vb = (bf16x8){lo[0], lo[1], lo[2], lo[3], hi[0], hi[1], hi[2], hi[3]};
            O[nt] = __builtin_amdgcn_mfma_f32_16x16x32_bf16(pa, vb, O[nt], 0, 0, 0);
        }
        asm volatile("s_waitcnt lgkmcnt(0)" ::: "memory");
    }
    if (g < 2) {
        float inv[4];
#pragma unroll
        for (int r = 0; r < 4; ++r) inv[r] = 1.f / lrun[r];
#pragma unroll
        for (int nt = 0; nt < 8; ++nt)
#pragma unroll
            for (int r = 0; r < 4; ++r) { const float ov = O[nt][r] * inv[r]; const bf16_t o = (bf16_t)(pk2h(ov, ov) & 0xffffu); if (!dry) zq[(size_t)t * 1024 + (4 * g + r) * 128 + 16 * nt + l15] = o; else KEEP1(o); }
    }
}
__device__ __forceinline__ void dsa_tables(const Params& p, LAS unsigned char* lds) {
    LAS float* LUT = (LAS float*)(lds + IX_LUT); LAS float* FAR = (LAS float*)(lds + IX_FAR);
    for (int i = threadIdx.x; i < 1024; i += NTHR) { const int n = i >> 3, hh = i & 7; int bk;
        if (n < 16) bk = n; else { bk = 16 + (int)(logf((float)n / 16.f) / 2.0794415416798357f * 16.f); bk = bk < 31 ? bk : 31; }
        LUT[i] = p.rel_bias[bk * 8 + hh] * 1.4426950408889634f; }
    if (threadIdx.x < 8) FAR[threadIdx.x] = p.rel_bias[31 * 8 + threadIdx.x] * 1.4426950408889634f;
    __syncthreads();
}
__device__ __forceinline__ void dsa_unit(const Params& p, LAS unsigned char* lds, int unit, bool dry, int fake = 0) {
    const int tid = threadIdx.x, lane = tid & 63, wid = tid >> 6;
    const int b = unit >> 9, t0 = (unit & 511) * 8;
    const bf16_t* qidx = (const bf16_t*)(p.ws + WS_QIDX); const bf16_t* kidx = (const bf16_t*)(p.ws + WS_KIDX); const float* widx = (const float*)(p.ws + WS_WIDX);
    bf16_t* zq = (bf16_t*)(p.ws + WS_ZQ); const bf16_t* ckv = (const bf16_t*)(p.ws + WS_CKV);
    LAS float* SC = (LAS float*)lds;
    const LAS float* LUT = (const LAS float*)(lds + IX_LUT); const LAS float* FAR = (const LAS float*)(lds + IX_FAR);
    LAS unsigned char* WL = (LAS unsigned char*)(SC + wid * IX_LD);
    LAS unsigned short* SEL = (LAS unsigned short*)WL;
    const int t = t0 + wid;
    int cnt;
    if (t0 < TOPK) {
#pragma unroll
        for (int i = 0; i < 4; ++i) { const int idx = i * 64 + lane; SEL[idx] = (unsigned short)(idx <= t ? idx : 0); }
        cnt = t + 1;
    } else {
        bf16x8 afr[2][2]; f32x4 wv[2];
#pragma unroll
        for (int rt = 0; rt < 2; ++rt) {
            const size_t row = (size_t)b * S + t0 + 4 * rt + ((lane & 15) >> 2);
#pragma unroll
            for (int ks = 0; ks < 2; ++ks) afr[rt][ks] = *(const bf16x8*)(qidx + row * 256 + (lane & 3) * 64 + 32 * ks + 8 * (lane >> 4));
            wv[rt] = *(const f32x4*)(widx + ((size_t)b * S + t0 + 4 * rt + (lane >> 4)) * 4);
        }
        const int ntiles = (t0 + 8 + 15) >> 4;
        for (int kt0 = wid; kt0 < ntiles; kt0 += 4 * NWAVE) {
            bf16x8 kb0[4], kb1[4];
#pragma unroll
            for (int q = 0; q < 4; ++q) { const int kt = kt0 + q * NWAVE; const int ktc = kt < ntiles ? kt : kt0;
                const bf16_t* kp = kidx + ((size_t)b * S + ktc * 16 + (lane & 15)) * 64 + 8 * (lane >> 4); kb0[q] = *(const bf16x8*)kp; kb1[q] = *(const bf16x8*)(kp + 32); }
#pragma unroll
            for (int q = 0; q < 4; ++q) { const int kt = kt0 + q * NWAVE;
#pragma unroll
                for (int rt = 0; rt < 2; ++rt) {
                    f32x4 acc = (f32x4){0.f, 0.f, 0.f, 0.f};
                    acc = __builtin_amdgcn_mfma_f32_16x16x32_bf16(afr[rt][0], kb0[q], acc, 0, 0, 0);
                    acc = __builtin_amdgcn_mfma_f32_16x16x32_bf16(afr[rt][1], kb1[q], acc, 0, 0, 0);
                    const float sv = wv[rt].x * fmaxf(acc.x, 0.f) + wv[rt].y * fmaxf(acc.y, 0.f) + wv[rt].z * fmaxf(acc.z, 0.f) + wv[rt].w * fmaxf(acc.w, 0.f);
                    if (kt < ntiles) SC[(4 * rt + (lane >> 4)) * IX_LD + kt * 16 + (lane & 15)] = sv;
                }
            }
        }
        __syncthreads();
        const int n = t + 1;
        unsigned u[64];
#pragma unroll
        for (int i = 0; i < 64; ++i) { const int idx = i * 64 + lane; u[i] = (idx < n) ? sortable(SC[wid * IX_LD + idx]) : 0u; }
        asm volatile("s_waitcnt lgkmcnt(0)" ::: "memory");
        const int ngrp = (n + 1023) >> 10;
        bool allge = true; int cgt = 0;
        unsigned Tt = u[0];
        if (fake != 3) Tt = wave_kth_interp<TOPK>(u, ngrp, allge, cgt);
        int base = 0;
        if (fake >= 3) { KEEP1(Tt); KEEP1(cgt); }
        else if (allge) {
#pragma unroll
            for (int i = 0; i < 64; ++i) {
                if (i * 64 < n) {
                    const bool take = u[i] >= Tt;
                    const unsigned long long mt = __ballot(take);
                    if (take) SEL[base + mbcnt64(mt)] = (unsigned short)(i * 64 + lane);
                    base += (int)__builtin_popcountll(mt);
                }
            }
        } else {
            const int need_eq = TOPK - cgt; int eqb = 0;
#pragma unroll
            for (int i = 0; i < 64; ++i) {
                if (i * 64 < n) {
                    const bool gt = u[i] > Tt, eq = u[i] == Tt;
                    const unsigned long long meq = __ballot(eq);
                    const bool take = gt || (eq && (eqb + mbcnt64(meq)) < need_eq);
                    const unsigned long long mt = __ballot(take);
                    if (take) SEL[base + mbcnt64(mt)] = (unsigned short)(i * 64 + lane);
                    base += (int)__builtin_popcountll(mt); eqb += (int)__builtin_popcountll(meq);
                }
            }
        }
        cnt = TOPK;
    }
    asm volatile("s_waitcnt lgkmcnt(0)" ::: "memory");
    if (fake < 2) attn_query(lane, b * S + t, cnt, WL, LUT, FAR, zq, ckv, dry, fake);
    __syncthreads();
}

__device__ __forceinline__ void phase_ln1(const Params& p, int bid, int nblk) {
    const int lane = threadIdx.x & 63, wid = threadIdx.x >> 6;
    const float* mod = (const float*)(p.ws + WS_MOD); bf16_t* h2 = (bf16_t*)(p.ws + WS_H2);
    for (int m = bid * NWAVE + wid; m < T; m += nblk * NWAVE) {
        const int b = m / S; float* row = p.out + (size_t)m * D;
        f32x4 v[4]; float s = 0.f;
#pragma unroll
        for (int j = 0; j < 4; ++j) { v[j] = *(const f32x4*)(row + 4 * lane + 256 * j); s += (v[j].x + v[j].y) + (v[j].z + v[j].w); }
        const float mean = wave_sum(s) * (1.f / D); float q = 0.f;
#pragma unroll
        for (int j = 0; j < 4; ++j) { v[j] = v[j] - mean; q += (v[j].x * v[j].x + v[j].y * v[j].y) + (v[j].z * v[j].z + v[j].w * v[j].w); }
        const float rstd = rsqrtf(wave_sum(q) * (1.f / D) + LN_EPS);
#pragma unroll
        for (int j = 0; j < 4; ++j) { const int c = 4 * lane + 256 * j;
            const f32x4 x1 = v[j] * rstd * *(const f32x4*)(p.ln1_g + c) + *(const f32x4*)(p.ln1_b + c);
            *(f32x4*)(row + c) = x1;
            st_bf16x4(h2 + (size_t)m * D + c, x1 * (1.f + *(const f32x4*)(mod + b * 6144 + 4096 + c)) + *(const f32x4*)(mod + b * 6144 + 3072 + c)); }
    }
}

__device__ __forceinline__ float unsortable(unsigned u) { return __uint_as_float((u & 0x80000000u) ? (u & 0x7fffffffu) : ~u); }
template <int N> __device__ __forceinline__ void bitonic_sort_desc(unsigned (&v)[N]) {
#pragma unroll
    for (int k = 2; k <= N; k <<= 1)
#pragma unroll
        for (int j = k >> 1; j > 0; j >>= 1)
#pragma unroll
            for (int i = 0; i < N; ++i) { const int l = i ^ j; if (l > i) { const unsigned hi = umax_(v[i], v[l]), lo = umin_(v[i], v[l]); if ((i & k) == 0) { v[i] = hi; v[l] = lo; } else { v[i] = lo; v[l] = hi; } } }
}
__device__ __forceinline__ void bitonic_merge16_desc(unsigned (&m)[16]) {
#pragma unroll
    for (int j = 8; j > 0; j >>= 1)
#pragma unroll
        for (int i = 0; i < 16; ++i) { const int l = i ^ j; if (l > i) { const unsigned hi = umax_(m[i], m[l]), lo = umin_(m[i], m[l]); m[i] = hi; m[l] = lo; } }
}
constexpr int RT2_WSZ = (4 * 32 * 16 + 64) * 4;
__device__ __forceinline__ void route_phase(const Params& p, LAS unsigned char* lds, int bid, int nblk, bool dry) {
    const int tid = threadIdx.x, lane = tid & 63, wid = tid >> 6;
    const bf16_t* pq = (const bf16_t*)(p.ws + WS_PQ); const bf16_t* keys = (const bf16_t*)(p.ws + WS_KEYS);
    unsigned short* eidx = (unsigned short*)(p.ws + WS_EIDX); float* gate = (float*)(p.ws + WS_GATE);
    LAS unsigned* LST = (LAS unsigned*)(lds + wid * RT2_WSZ);
    const int tok = lane & 15, grp = lane >> 4;
    for (int task = bid * NWAVE + wid; task < (T / 16) * 2; task += nblk * NWAVE) {
        const int t0 = (task >> 1) * 16, hq = task & 1;
#pragma unroll 1
        for (int hl = 0; hl < 4; ++hl) {
            const int h = hq * 4 + hl;
#pragma unroll 1
            for (int c = 0; c < 2; ++c) {
                const bf16_t* qp = pq + (size_t)(t0 + tok) * D + h * 128 + c * 64 + 8 * grp;
                bf16x8 bq[2];
#pragma unroll
                for (int ks = 0; ks < 2; ++ks) bq[ks] = *(const bf16x8*)(qp + 32 * ks);
                unsigned v[32];
#pragma unroll
                for (int mt = 0; mt < 8; ++mt) {
                    const bf16_t* kp = keys + ((size_t)(h * 2 + c) * 128 + 16 * mt + tok) * 64 + 8 * grp;
                    f32x4 acc = (f32x4){0.f, 0.f, 0.f, 0.f};
                    acc = __builtin_amdgcn_mfma_f32_16x16x32_bf16(*(const bf16x8*)kp, bq[0], acc, 0, 0, 0);
                    acc = __builtin_amdgcn_mfma_f32_16x16x32_bf16(*(const bf16x8*)(kp + 32), bq[1], acc, 0, 0, 0);
#pragma unroll
                    for (int r = 0; r < 4; ++r) { const int n = 16 * mt + 4 * grp + r; v[4 * mt + r] = (sortable(acc[r]) & 0xffffff80u) | (unsigned)(127 - n); }
                }
                bitonic_sort_desc<32>(v);
                unsigned m[16];
#pragma unroll
                for (int i = 0; i < 16; ++i) m[i] = umax_(v[i], (unsigned)__shfl_xor((int)v[15 - i], 16));
                bitonic_merge16_desc(m);
                unsigned m2[16];
#pragma unroll
                for (int i = 0; i < 16; ++i) m2[i] = umax_(m[i], (unsigned)__shfl_xor((int)m[15 - i], 32));
                bitonic_merge16_desc(m2);
                if (grp == 0) {
#pragma unroll
                    for (int i = 0; i < 16; ++i) LST[(hl * 32 + c * 16 + i) * 16 + hl * 16 + tok] = m2[i];
                }
            }
        }
        asm volatile("s_waitcnt lgkmcnt(0)" ::: "memory");
        {
            const int lb = grp * 32 * 16 + grp * 16 + tok;
            float av[16], bv[16];
#pragma unroll
            for (int i = 0; i < 16; ++i) { av[i] = unsortable(LST[lb + i * 16] & 0xffffff80u); bv[i] = unsortable(LST[lb + (16 + i) * 16] & 0xffffff80u); }
            unsigned top[16];
#pragma unroll
            for (int i = 0; i < 16; ++i) top[i] = 0u;
#pragma unroll
            for (int i = 0; i < 16; ++i)
#pragma unroll
                for (int j = 0; j < 16; ++j) if ((i + 1) * (j + 1) <= 16) {
                    unsigned x = (sortable(av[i] + bv[j]) & 0xffffff00u) | (unsigned)(255 - (i * 16 + j));
#pragma unroll
                    for (int q = 0; q < 16; ++q) { const unsigned hi = umax_(top[q], x); x = umin_(top[q], x); top[q] = hi; }
                }
            float val[16]; int ex[16]; float mx = -INFINITY;
#pragma unroll
            for (int q = 0; q < 16; ++q) { const int code = 255 - (int)(top[q] & 0xffu); val[q] = unsortable(top[q] & 0xffffff00u); mx = fmaxf(mx, val[q]);
                const int i1 = 127 - (int)(LST[lb + (code >> 4) * 16] & 0x7fu), i2 = 127 - (int)(LST[lb + (16 + (code & 15)) * 16] & 0x7fu); ex[q] = i1 * 128 + i2; }
            float sum = 0.f;
#pragma unroll
            for (int q = 0; q < 16; ++q) { val[q] = __expf(val[q] - mx); sum += val[q]; }
            const float inv = 1.f / sum;
            const size_t o = (size_t)(t0 + tok) * 128 + (hq * 4 + grp) * 16;
            u32x4 e0, e1; e0.x = (unsigned)ex[0] | ((unsigned)ex[1] << 16); e0.y = (unsigned)ex[2] | ((unsigned)ex[3] << 16); e0.z = (unsigned)ex[4] | ((unsigned)ex[5] << 16); e0.w = (unsigned)ex[6] | ((unsigned)ex[7] << 16);
            e1.x = (unsigned)ex[8] | ((unsigned)ex[9] << 16); e1.y = (unsigned)ex[10] | ((unsigned)ex[11] << 16); e1.z = (unsigned)ex[12] | ((unsigned)ex[13] << 16); e1.w = (unsigned)ex[14] | ((unsigned)ex[15] << 16);
            if (!dry) { *(u32x4*)(eidx + o) = e0; *(u32x4*)(eidx + o + 8) = e1;
#pragma unroll
                for (int q = 0; q < 4; ++q) *(f32x4*)(gate + o + 4 * q) = (f32x4){val[4 * q] * inv, val[4 * q + 1] * inv, val[4 * q + 2] * inv, val[4 * q + 3] * inv}; }
            else { KEEP4(e0); KEEP4(e1); KEEP1(inv); }
        }
        asm volatile("s_waitcnt lgkmcnt(0)" ::: "memory");
    }
}

constexpr int EX_WSZ = 1024 + 512 + 512 + 8192;
__device__ __forceinline__ float gelu_exact(float x) { return 0.5f * x * (1.f + erff(x * 0.7071067811865476f)); }
__device__ __forceinline__ void expert_phase(const Params& p, LAS unsigned char* lds, int bid, int nblk, bool dry) {
    const int tid = threadIdx.x, lane = tid & 63, wid = tid >> 6;
    const bf16_t* h2 = (const bf16_t*)(p.ws + WS_H2); const unsigned char* ut = p.ws + WS_UT; const unsigned char* vt = p.ws + WS_VT;
    const unsigned short* eidx = (const unsigned short*)(p.ws + WS_EIDX); const float* gate = (const float*)(p.ws + WS_GATE); const float* mod = (const float*)(p.ws + WS_MOD);
    LAS unsigned char* H8 = lds + wid * EX_WSZ; LAS float* ACT = (LAS float*)(lds + wid * EX_WSZ + 1024); LAS int* EI = (LAS int*)(lds + wid * EX_WSZ + 1536);
    for (int t = bid * NWAVE + wid; t < T; t += nblk * NWAVE) {
        const int b = t / S;
        {
            f32x4 a0, a1, a2, a3; ld_bf16x8(h2 + (size_t)t * D + 16 * lane, a0, a1); ld_bf16x8(h2 + (size_t)t * D + 16 * lane + 8, a2, a3);
            u32x4 o; int w;
            w = __builtin_amdgcn_cvt_pk_fp8_f32(a0.x, a0.y, 0, false); w = __builtin_amdgcn_cvt_pk_fp8_f32(a0.z, a0.w, w, true); o.x = (unsigned)w;
            w = __builtin_amdgcn_cvt_pk_fp8_f32(a1.x, a1.y, 0, false); w = __builtin_amdgcn_cvt_pk_fp8_f32(a1.z, a1.w, w, true); o.y = (unsigned)w;
            w = __builtin_amdgcn_cvt_pk_fp8_f32(a2.x, a2.y, 0, false); w = __builtin_amdgcn_cvt_pk_fp8_f32(a2.z, a2.w, w, true); o.z = (unsigned)w;
            w = __builtin_amdgcn_cvt_pk_fp8_f32(a3.x, a3.y, 0, false); w = __builtin_amdgcn_cvt_pk_fp8_f32(a3.z, a3.w, w, true); o.w = (unsigned)w;
            *(LAS u32x4*)(H8 + 16 * lane) = o;
        }
        float g0v, g1v;
        {
            const unsigned short e0 = eidx[(size_t)t * 128 + lane], e1 = eidx[(size_t)t * 128 + 64 + lane];
            unsigned k0 = ((unsigned)e0 << 7) | (unsigned)lane, k1 = ((unsigned)e1 << 7) | (unsigned)(lane + 64);
#pragma unroll
            for (int k = 2; k <= 128; k <<= 1) {
#pragma unroll
                for (int j = k >> 1; j > 0; j >>= 1) {
                    if (j == 64) { const unsigned lo_ = umin_(k0, k1), hi_ = umax_(k0, k1); k0 = lo_; k1 = hi_; }
                    else {
                        const unsigned p0 = (unsigned)__shfl_xor((int)k0, j), p1 = (unsigned)__shfl_xor((int)k1, j);
                        const bool lower = (lane & j) == 0;
                        const bool asc0 = (lane & k) == 0, asc1 = ((lane + 64) & k) == 0;
                        k0 = (lower == asc0) ? umin_(k0, p0) : umax_(k0, p0);
                        k1 = (lower == asc1) ? umin_(k1, p1) : umax_(k1, p1);
                    }
                }
            }
            EI[lane] = (int)(k0 >> 7); EI[lane + 64] = (int)(k1 >> 7);
            g0v = gate[(size_t)t * 128 + (k0 & 127u)]; g1v = gate[(size_t)t * 128 + (k1 & 127u)];
        }
        asm volatile("s_waitcnt lgkmcnt(0)" ::: "memory");
        {
            LAS unsigned char* UR = lds + wid * EX_WSZ + 2048;
            u32x4 rw[8];
#pragma unroll
            for (int i = 0; i < 8; ++i) rw[i] = *(const u32x4*)(ut + (size_t)EI[i] * D + 16 * lane);
            const int rr = lane & 7, gq = lane >> 4;
#pragma unroll 1
            for (int grp = 0; grp < 16; ++grp) {
#pragma unroll
                for (int i = 0; i < 8; ++i) *(LAS u32x4*)(UR + i * 1024 + ((lane ^ i) << 4)) = rw[i];
                if (grp + 1 < 16) {
#pragma unroll
                    for (int i = 0; i < 8; ++i) rw[i] = *(const u32x4*)(ut + (size_t)EI[(grp + 1) * 8 + i] * D + 16 * lane);
                }
                asm volatile("s_waitcnt lgkmcnt(0)" ::: "memory");
                f32x4 acc = (f32x4){0.f, 0.f, 0.f, 0.f};
#pragma unroll
                for (int ks = 0; ks < 16; ++ks) {
                    const u32x4 av = *(const LAS u32x4*)(UR + rr * 1024 + (((4 * ks + gq) ^ rr) << 4)); const u32x4 bv = *(const LAS u32x4*)(H8 + 64 * ks + 16 * gq);
                    const long a0 = (long)(((unsigned long long)av.y << 32) | av.x), a1 = (long)(((unsigned long long)av.w << 32) | av.z);
                    const long b0 = (long)(((unsigned long long)bv.y << 32) | bv.x), b1 = (long)(((unsigned long long)bv.w << 32) | bv.z);
                    acc = __builtin_amdgcn_mfma_f32_16x16x32_fp8_fp8(a0, b0, acc, 0, 0, 0);
                    acc = __builtin_amdgcn_mfma_f32_16x16x32_fp8_fp8(a1, b1, acc, 0, 0, 0);
                }
                if ((lane & 15) == 0 && gq < 2) *(LAS f32x4*)(ACT + grp * 8 + gq * 4) = acc * (1.f / U_SCALE);
            }
        }
        asm volatile("s_waitcnt lgkmcnt(0)" ::: "memory");
        { const float d0 = ACT[lane], d1 = ACT[lane + 64];
          asm volatile("s_waitcnt lgkmcnt(0)" ::: "memory");
          ACT[lane] = gelu_exact(d0) * g0v * (1.f / V_SCALE); ACT[lane + 64] = gelu_exact(d1) * g1v * (1.f / V_SCALE); }
        asm volatile("s_waitcnt lgkmcnt(0)" ::: "memory");
        float y[16];
#pragma unroll
        for (int j = 0; j < 16; ++j) y[j] = 0.f;
        for (int e0 = 0; e0 < 128; e0 += 8) {
            u32x4 w[8]; float a[8];
#pragma unroll
            for (int j = 0; j < 8; ++j) { w[j] = *(const u32x4*)(vt + (size_t)EI[e0 + j] * D + 16 * lane); a[j] = ACT[e0 + j]; }
#pragma unroll
            for (int j = 0; j < 8; ++j)
#pragma unroll
                for (int q = 0; q < 4; ++q) { const f32x2 lo = __builtin_amdgcn_cvt_pk_f32_fp8((int)w[j][q], false), hi = __builtin_amdgcn_cvt_pk_f32_fp8((int)w[j][q], true);
                    y[4 * q + 0] += a[j] * lo.x; y[4 * q + 1] += a[j] * lo.y; y[4 * q + 2] += a[j] * hi.x; y[4 * q + 3] += a[j] * hi.y; }
        }
        float* row = p.out + (size_t)t * D + 16 * lane; const float* g2 = mod + b * 6144 + 5120 + 16 * lane;
        float v[16]; float s = 0.f;
#pragma unroll
        for (int q = 0; q < 4; ++q) { const f32x4 xv = *(const f32x4*)(row + 4 * q), gv = *(const f32x4*)(g2 + 4 * q);
            v[4 * q + 0] = xv.x * DN_ALPHA + gv.x * y[4 * q + 0]; v[4 * q + 1] = xv.y * DN_ALPHA + gv.y * y[4 * q + 1]; v[4 * q + 2] = xv.z * DN_ALPHA + gv.z * y[4 * q + 2]; v[4 * q + 3] = xv.w * DN_ALPHA + gv.w * y[4 * q + 3]; }
#pragma unroll
        for (int j = 0; j < 16; ++j) s += v[j];
        const float mean = wave_sum(s) * (1.f / D); float qq = 0.f;
#pragma unroll
        for (int j = 0; j < 16; ++j) { v[j] -= mean; qq += v[j] * v[j]; }
        const float rstd = rsqrtf(wave_sum(qq) * (1.f / D) + LN_EPS);
#pragma unroll
        for (int q = 0; q < 4; ++q) { const int c = 16 * lane + 4 * q; const f32x4 gv = *(const f32x4*)(p.ln2_g + c), bv = *(const f32x4*)(p.ln2_b + c);
            f32x4 o; o.x = v[4 * q + 0] * rstd * gv.x + bv.x; o.y = v[4 * q + 1] * rstd * gv.y + bv.y; o.z = v[4 * q + 2] * rstd * gv.z + bv.z; o.w = v[4 * q + 3] * rstd * gv.w + bv.w;
            if (!dry) *(f32x4*)(row + 4 * q) = o; else KEEP4(o); }
        asm volatile("s_waitcnt lgkmcnt(0)" ::: "memory");
    }
}

#define XB_TMO      128
#define XB_XCNT(j)  (256  + 64 * (j))
#define XB_XSUB(j)  (1280 + 64 * (j))
#define XB_XGEN(j)  (2304 + 64 * (j))
#define XB_TOP      3328
#define XB_TOPGEN   3392
#define XCD_BAR_WORDS 3456
#define XB_SPIN_CAP (1u << 18)
__device__ __forceinline__ unsigned xb_ld(unsigned* p)              { return __hip_atomic_load(p, __ATOMIC_RELAXED, __HIP_MEMORY_SCOPE_AGENT); }
__device__ __forceinline__ unsigned xb_add(unsigned* p, unsigned v) { return __hip_atomic_fetch_add(p, v, __ATOMIC_RELAXED, __HIP_MEMORY_SCOPE_AGENT); }
__device__ __forceinline__ unsigned xb_xcc_id() { return (unsigned)__builtin_amdgcn_s_getreg((3 << 11) | 20) & 0xFu; }
#define XB_SPIN(cond, bar) do { unsigned _sp = 0; while (cond) { __builtin_amdgcn_s_sleep(1); \
    if ((++_sp & 255u) == 0u) { if (xb_ld(&(bar)[XB_TMO])) break; if (_sp > XB_SPIN_CAP) { atomicAdd(&(bar)[XB_TMO], 1u); break; } } } } while (0)
struct XcdBarrier { unsigned* bar; unsigned x; volatile LAS unsigned* st; };
__device__ __forceinline__ XcdBarrier xcd_barrier_post(unsigned* bar, volatile LAS unsigned* st) {
    XcdBarrier b; b.bar = bar; b.x = xb_xcc_id(); b.st = st;
    if (threadIdx.x == 0) (void)xb_add(&bar[XB_XCNT(b.x)], 1u);
    return b;
}
__device__ __forceinline__ void xcd_barrier_complete(unsigned* bar, unsigned x, unsigned& nloc, unsigned& nx) {
    const unsigned G = gridDim.x * gridDim.y * gridDim.z;
    unsigned sum, cnt, mine, sp = 0u;
    for (;;) {
        sum = 0u; cnt = 0u; mine = 0u;
#pragma unroll
        for (unsigned j = 0; j < 16; ++j) { const unsigned c = xb_ld(&bar[XB_XCNT(j)]); sum += c; cnt += (c > 0u) ? 1u : 0u; mine = (j == x) ? c : mine; }
        if (sum == G) break;
        __builtin_amdgcn_s_sleep(1);
        if ((++sp & 255u) == 0u) { if (xb_ld(&bar[XB_TMO])) break; if (sp > XB_SPIN_CAP) { atomicAdd(&bar[XB_TMO], 1u); break; } }
    }
    nloc = mine > 0u ? mine : 1u; nx = cnt > 0u ? cnt : 1u;
}
__device__ __forceinline__ void xcd_barrier(const XcdBarrier& b) {
    asm volatile("s_waitcnt vmcnt(0)" ::: "memory");
    __syncthreads();
    if (threadIdx.x == 0) {
        unsigned* bar = b.bar;
        __builtin_amdgcn_s_waitcnt(0);
        unsigned nloc = b.st[0], nx = b.st[1];
        if (nloc == 0u) { xcd_barrier_complete(bar, b.x, nloc, nx); b.st[0] = nloc; b.st[1] = nx; }
        const unsigned old = xb_add(&bar[XB_XSUB(b.x)], 1u);
        const unsigned gen = old / nloc;
        if (old + 1u == (gen + 1u) * nloc) {
            __builtin_amdgcn_fence(__ATOMIC_RELEASE, "agent");
            asm volatile("s_waitcnt vmcnt(0)" ::: "memory");
            const unsigned og = xb_add(&bar[XB_TOP], 1u);
            const unsigned tg = og / nx;
            if (og + 1u == (tg + 1u) * nx) xb_add(&bar[XB_TOPGEN], 1u);
            else XB_SPIN(xb_ld(&bar[XB_TOPGEN]) == tg, bar);
            __builtin_amdgcn_fence(__ATOMIC_ACQUIRE, "agent");
            xb_add(&bar[XB_XGEN(b.x)], 1u);
            asm volatile("s_waitcnt vmcnt(0)" ::: "memory");
        } else {
            XB_SPIN(xb_ld(&bar[XB_XGEN(b.x)]) == gen, bar);
            __builtin_amdgcn_fence(__ATOMIC_ACQUIRE, "agent");
            asm volatile("s_waitcnt vmcnt(0)" ::: "memory");
        }
    }
    __syncthreads();
}

constexpr int NPHASE = 13;
__global__ void __launch_bounds__(NTHR) fwd_kernel(Params p) {
    extern __shared__ __attribute__((aligned(16))) unsigned char lds_raw[];
    LAS unsigned char* lds = (LAS unsigned char*)lds_raw;
    const int bid = blockIdx.x, nblk = gridDim.x;
    unsigned char* ws = p.ws;
#if MK_SINGLE
    volatile LAS unsigned* bst = (volatile LAS unsigned*)(lds + LDS_BYTES - 64);
    if (threadIdx.x < 2) bst[threadIdx.x] = 0u;
    __syncthreads();
    const XcdBarrier gbar = xcd_barrier_post((unsigned*)ws, bst);
#define GRID_SYNC() xcd_barrier(gbar)
#else
#define GRID_SYNC() do {} while (0)
#endif
#define PH(k) if (p.ph_lo <= (k) && (k) < p.ph_hi)
#define SEAM(k) if (p.ph_lo <= (k) && (k) + 1 < p.ph_hi) GRID_SYNC()
#define PROBE(k) if (p.probe_ph == (k))
#define PG8_RUN(Aptr, Btptr, Mm, Nn, Kk, FT, ...) PG8_RUN_G(nblk, bid, Aptr, Btptr, Mm, Nn, Kk, FT, __VA_ARGS__)
#define PG8_RUN_G(GG, CC, Aptr, Btptr, Mm, Nn, Kk, FT, ...) { pg8::Gemm g{(const pg8::bf16_t*)(Aptr), (const pg8::bf16_t*)(Btptr), Mm, Nn, Kk}; pg8::StaticOrder so; so.init(Mm, Nn, GG, CC); \
        pg8::EpiRow8<FT> e{FT{__VA_ARGS__}}; pg8::gemm_phase<pg8::EpiRow8<FT>, pg8::StaticOrder, true, true>(lds, g, so, e); }
#define RUN3(dry) PG8_RUN(ws + WS_H1, ws + WS_WIN, T, NPAD, D, FInproj, (bf16_t*)(ws + WS_ZRKV), (bf16_t*)(ws + WS_ZLORA), (bf16_t*)(ws + WS_ZQ), (bf16_t*)(ws + WS_ZMISC), (bf16_t*)(ws + WS_QIDX), (bf16_t*)(ws + WS_GA), (bf16_t*)(ws + WS_GB), dry)
#define RUN4P(dry) { dsa_norm_rows(p, bid, nblk, dry); for (int u = bid; u < (T / 64) * 8; u += nblk) rwkv_chunk_unit(p, lds, u >> 3, u & 7, dry); }
#define DSA_NS 586
#define DSA_ND 3510
#define RUN4(dry) { dsa_tables(p, lds); \
        if (bid < 64) { if (!dry) rwkv_state_out_pass(p, lds, bid >> 3, bid & 7); \
               for (int e = DSA_NS - 1 - bid; e >= 0; e -= 64) dsa_unit(p, lds, 7 * e, dry); } \
        else { for (int e = DSA_ND - 1 - (bid - 64); e >= 0; e -= (nblk - 64)) dsa_unit(p, lds, 7 * (e / 6) + (e % 6) + 1, dry); peer_tables(p, bid - 64, nblk - 64, dry); } }
#define RUN5(dry) PG8_RUN(ws + WS_ZQ, ws + WS_WB, T, D, D, FBrA, (bf16_t*)(ws + WS_GB), dry)
#define RUN6(dry) { PG8_RUN(ws + WS_YA, ws + WS_WA, T, D, 512, FBrB, (bf16_t*)(ws + WS_GA), (const bf16_t*)(ws + WS_GB), dry) }
#define RUN7(dry) PG8_RUN(ws + WS_GA, ws + WS_WO, T, D, D, FOut, p.x, (const float*)(ws + WS_MOD), p.out, dry)
#define RUN9(dry) PG8_RUN(ws + WS_H2, ws + WS_WPQ, T, D, D, FPq, (bf16_t*)(ws + WS_PQ), dry)
    PROBE(100) { phase_prep(p, lds, bid, nblk, false); GRID_SYNC(); }
    PH(0) { phase_prep(p, lds, bid, nblk, false); } SEAM(0);
    PH(1) { phase_modsum(p, bid, nblk); } SEAM(1);
    PROBE(102) { phase_h1(p, bid, nblk); GRID_SYNC(); }
    PH(2) { phase_h1(p, bid, nblk); } SEAM(2);
    PROBE(3) { RUN3(1); GRID_SYNC(); }
    PROBE(103) { RUN3(0); GRID_SYNC(); }
    PH(3) RUN3(0) SEAM(3);
    PROBE(42) { RUN4P(true); GRID_SYNC(); }
    if (p.probe_ph >= 420 && p.probe_ph < 430) { RUN4P(true); GRID_SYNC(); }
    PH(12) RUN4P(false) if (p.ph_lo <= 12 && 12 < p.ph_hi) GRID_SYNC();
    PROBE(4) { RUN4(true); GRID_SYNC(); }
    PROBE(43) { if (bid >= 64) { dsa_tables(p, lds); for (int u = (T / 8 - 1) - (bid - 64); u >= 0; u -= (nblk - 64)) dsa_unit(p, lds, u, true, 1); } GRID_SYNC(); }
    PROBE(44) { if (bid >= 64) { dsa_tables(p, lds); for (int u = (T / 8 - 1) - (bid - 64); u >= 0; u -= (nblk - 64)) dsa_unit(p, lds, u, true, 2); } GRID_SYNC(); }
    PROBE(45) { if (bid >= 64) { dsa_tables(p, lds); for (int u = (T / 8 - 1) - (bid - 64); u >= 0; u -= (nblk - 64)) dsa_unit(p, lds, u, true, 3); } GRID_SYNC(); }
    PROBE(46) { if (bid >= 64) { dsa_tables(p, lds); for (int u = (T / 8 - 1) - (bid - 64); u >= 0; u -= (nblk - 64)) dsa_unit(p, lds, u, true, 4); } GRID_SYNC(); }
    PROBE(41) { if (bid >= 64) { dsa_tables(p, lds); for (int u = (T / 8 - 1) - (bid - 64); u >= 0; u -= (nblk - 64)) dsa_unit(p, lds, u, true); } GRID_SYNC(); }
    PH(4) RUN4(false) SEAM(4);
    PROBE(5) { RUN5(1); GRID_SYNC(); }
    PH(5) RUN5(0)
    PROBE(6) { RUN6(1); GRID_SYNC(); }
    PH(6) RUN6(0) SEAM(6);
    PROBE(7) { RUN7(1); GRID_SYNC(); }
    PH(7) RUN7(0) SEAM(7);
    PH(8) { phase_ln1(p, bid, nblk); } SEAM(8);
    PROBE(9) { RUN9(1); GRID_SYNC(); }
    PH(9) RUN9(0) SEAM(9);
    PROBE(10) { route_phase(p, lds, bid, nblk, true); GRID_SYNC(); }
    PROBE(110) { route_phase(p, lds, bid, nblk, false); GRID_SYNC(); }
    PH(10) { route_phase(p, lds, bid, nblk, false); } SEAM(10);
    PROBE(11) { expert_phase(p, lds, bid, nblk, true); GRID_SYNC(); }
    PH(11) { expert_phase(p, lds, bid, nblk, false); }
}

extern "C" void kernel_launch(void* const* d_in, const int* in_sizes, int n_in, void* d_out, int out_size, void* d_ws, size_t ws_size, hipStream_t stream) {
    static int grid = 0;
    if (grid == 0) {
        if (n_in != 31 || out_size != T * D || ws_size < WS_NEED) { fprintf(stderr, "kernel_launch: unexpected shapes (n_in %d, out %d, ws %zu)\n", n_in, out_size, ws_size); grid = -1; return; }
        int dev = 0, cus = 0, per_cu = 0;
        (void)hipGetDevice(&dev); (void)hipDeviceGetAttribute(&cus, hipDeviceAttributeMultiprocessorCount, dev);
        if (hipFuncSetAttribute((const void*)fwd_kernel, hipFuncAttributeMaxDynamicSharedMemorySize, LDS_BYTES) != hipSuccess) { fprintf(stderr, "kernel_launch: hipFuncSetAttribute failed\n"); grid = -1; return; }
        if (hipOccupancyMaxActiveBlocksPerMultiprocessor(&per_cu, (const void*)fwd_kernel, NTHR, LDS_BYTES) != hipSuccess || per_cu < 1) { fprintf(stderr, "kernel_launch: occupancy query failed (%d)\n", per_cu); grid = -1; return; }
        grid = cus * (per_cu > 1 ? 1 : per_cu);
        fprintf(stderr, "kernel_launch: %d CUs, %d blocks/CU reported, grid %d\n", cus, per_cu, grid);
    }
    if (grid < 0) return;
    if (hipMemsetAsync(d_ws, 0, 16384, stream) != hipSuccess) { fprintf(stderr, "kernel_launch: memset failed\n"); return; }
    Params p{};
    const float** f = (const float**)&p;
    for (int i = 0; i < 31; ++i) f[i] = (const float*)d_in[i];
    p.out = (float*)d_out; p.ws = (unsigned char*)d_ws; p.probe_ph = PROBE_PHASE;
#if MK_SINGLE
    p.ph_lo = 0; p.ph_hi = NPHASE;
    void* args[] = {&p};
    hipError_t e = hipLaunchCooperativeKernel((const void*)fwd_kernel, dim3(grid), dim3(NTHR), args, LDS_BYTES, stream);
    if (e != hipSuccess) fprintf(stderr, "kernel_launch: cooperative launch failed: %s (grid %d)\n", hipGetErrorString(e), grid);
#else
    for (int ph = 0; ph < NPHASE; ++ph) { p.ph_lo = ph; p.ph_hi = ph + 1; hipLaunchKernelGGL(fwd_kernel, dim3(grid), dim3(NTHR), LDS_BYTES, stream, p); }
#endif
}
```
